# Optimizing an MI355X kernel written in HIP

```python
import math
import jax, jax.numpy as jnp
from jax import lax
import numpy as np

D_MODEL = 2048
BATCH = 8
SEQ = 4096
DEPTH = 2
DEC_BATCH = 2
DEC_SEQ = 16384
PAST_LEN = 128

MIX_WIDTH = D_MODEL
DIFF_WIDTH = MIX_WIDTH // 2
NA_WIDTH = MIX_WIDTH - DIFF_WIDTH
DIFF_HEAD_DIM = 64
DIFF_HEADS = DIFF_WIDTH // (2 * DIFF_HEAD_DIM)
NA_HEAD_DIM = 128
NA_HEADS = NA_WIDTH // NA_HEAD_DIM
D_FF = 5632
GRID_W = 64
NA_KH_MAX = 8
NA_KW = 16
Q_BLOCK = 128
ROPE_THETA = 10000.0
LN_EPS = 1e-5
RMS_EPS = 1e-5
DEEPNORM_ALPHA = (2.0 * DEPTH) ** 0.25
DEEPNORM_BETA = (8.0 * DEPTH) ** -0.25
DQ_COLS = DIFF_HEADS * 2 * DIFF_HEAD_DIM
DK_COLS = DIFF_HEADS * 2 * DIFF_HEAD_DIM
DV_COLS = DIFF_HEADS * 2 * DIFF_HEAD_DIM
NQ_COLS = NA_HEADS * NA_HEAD_DIM
NK_COLS = NA_HEADS * NA_HEAD_DIM
NV_COLS = NA_HEADS * NA_HEAD_DIM
IN_COLS = DQ_COLS + DK_COLS + DV_COLS + NQ_COLS + NK_COLS + NV_COLS

kernel_name = "hybrid_diffattn_natten_macaron_encoder"


def layer_norm(x, g, b):
    xf = x.astype(jnp.float32)
    mu = jnp.mean(xf, axis=-1, keepdims=True)
    var = jnp.mean(jnp.square(xf - mu), axis=-1, keepdims=True)
    y = (xf - mu) * lax.rsqrt(var + LN_EPS) * g.astype(jnp.float32) + b.astype(jnp.float32)
    return y.astype(x.dtype)


def modulate(x, shift, scale):
    return x * (1 + scale[:, None, :]) + shift[:, None, :]


def swiglu(h, w_gu, w_down):
    gate, up = jnp.split(h @ w_gu, 2, axis=-1)
    return (jax.nn.silu(gate) * up) @ w_down


def rotary_tables(seq_len, dim):
    inv_freq = ROPE_THETA ** (-jnp.arange(0, dim, 2, dtype=jnp.float32) / dim)
    ang = jnp.arange(seq_len, dtype=jnp.float32)[:, None] * inv_freq[None, :]
    ang = jnp.concatenate([ang, ang], axis=-1)
    return jnp.cos(ang), jnp.sin(ang)


def apply_rotary(x, cos, sin):
    c = cos[None, :, None, None, :]
    s = sin[None, :, None, None, :]
    x1, x2 = jnp.split(x, 2, axis=-1)
    rot = jnp.concatenate([-x2, x1], axis=-1)
    return (x * c + rot * s).astype(x.dtype)


def diff_attention(q, k, v, lam, norm_g, lam_init):
    B, T, H, _, dh = q.shape
    nqb = T // Q_BLOCK
    qb = q.reshape(B, nqb, Q_BLOCK, H, 2, dh).transpose(1, 0, 2, 3, 4, 5)
    scale = dh ** -0.5

    def one_block(q_blk):
        s = jnp.einsum('bqhcd,bkhcd->bhcqk', q_blk, k).astype(jnp.float32) * scale
        p = jax.nn.softmax(s, axis=-1)
        a = p[:, :, 0] - lam * p[:, :, 1]
        return jnp.einsum('bhqk,bkhe->bqhe', a.astype(v.dtype), v)

    o = lax.map(one_block, qb)
    o = o.transpose(1, 0, 2, 3, 4).reshape(B, T, H, 2 * dh)
    of = o.astype(jnp.float32)
    of = of * lax.rsqrt(jnp.mean(jnp.square(of), axis=-1, keepdims=True) + RMS_EPS)
    of = of * norm_g.astype(jnp.float32) * (1.0 - lam_init)
    return of.astype(v.dtype).reshape(B, T, H * 2 * dh)


def neighborhood_attention(q, k, v, rpb):
    B, T, H, d = q.shape
    rows = T // GRID_W
    kh = min(NA_KH_MAX, rows)
    kg = k.reshape(B, rows, GRID_W, H, d)
    vg = v.reshape(B, rows, GRID_W, H, d)
    qg = q.reshape(B, rows, GRID_W, H, d).transpose(1, 0, 2, 3, 4)
    qc = jnp.arange(GRID_W)
    kc = jnp.arange(GRID_W)
    cs = jnp.clip(qc - NA_KW // 2, 0, GRID_W - NA_KW)
    col_valid = (kc[None, :] >= cs[:, None]) & (kc[None, :] < cs[:, None] + NA_KW)
    col_idx = jnp.clip(kc[None, :] - qc[:, None], -(NA_KW - 1), NA_KW - 1) + (NA_KW - 1)
    rpb_cols = rpb[:, :, col_idx]
    scale = d ** -0.5

    def one_row(args):
        r, q_row = args
        rs = jnp.clip(r - kh // 2, 0, rows - kh)
        k_rows = lax.dynamic_slice_in_dim(kg, rs, kh, axis=1)
        v_rows = lax.dynamic_slice_in_dim(vg, rs, kh, axis=1)
        row_idx = rs + jnp.arange(kh) - r + (NA_KH_MAX - 1)
        bias = jnp.take(rpb_cols, row_idx, axis=1).transpose(0, 2, 1, 3)
        s = jnp.einsum('bqhd,bjkhd->bhqjk', q_row, k_rows).astype(jnp.float32) * scale
        s = s + bias.astype(jnp.float32)[None]
        s = jnp.where(col_valid[None, None, :, None, :], s, -jnp.inf)
        p = jax.nn.softmax(s.reshape(B, H, GRID_W, kh * GRID_W), axis=-1)
        p = p.reshape(B, H, GRID_W, kh, GRID_W)
        return jnp.einsum('bhqjk,bjkhd->bqhd', p.astype(v.dtype), v_rows)

    o = lax.map(one_row, (jnp.arange(rows), qg))
    return o.transpose(1, 0, 2, 3, 4).reshape(B, T, H * d)


def encoder_layer(x, c, layer, w_ada, b_ada, ln_g, ln_b, ffn1_w_gu, ffn1_w_down,
                  w_in, w_out, lam_q1, lam_k1, lam_q2, lam_k2, diff_norm_g, rpb,
                  ffn2_w_gu, ffn2_w_down):
    B, T, _ = x.shape
    mod = jax.nn.silu(c) @ w_ada + b_ada
    s1, m1, g1, s2, m2, g2, s3, m3, g3 = jnp.split(mod, 9, axis=-1)

    h = modulate(x, s1, m1)
    f = swiglu(h, ffn1_w_gu, ffn1_w_down)
    x = layer_norm(DEEPNORM_ALPHA * x + (1 + g1[:, None, :]) * 0.5 * f, ln_g[0], ln_b[0])

    h = modulate(x, s2, m2)
    proj = h @ w_in
    splits = np.cumsum([DQ_COLS, DK_COLS, DV_COLS, NQ_COLS, NK_COLS])
    dq, dk, dv, nq, nk, nv = jnp.split(proj, splits, axis=-1)
    dq = dq.reshape(B, T, DIFF_HEADS, 2, DIFF_HEAD_DIM)
    dk = dk.reshape(B, T, DIFF_HEADS, 2, DIFF_HEAD_DIM)
    dv = dv.reshape(B, T, DIFF_HEADS, 2 * DIFF_HEAD_DIM)
    cos, sin = rotary_tables(T, DIFF_HEAD_DIM)
    dq = apply_rotary(dq, cos, sin)
    dk = apply_rotary(dk, cos, sin)
    lam_init = 0.8 - 0.6 * math.exp(-0.3 * layer)
    lam = (jnp.exp(jnp.sum(lam_q1.astype(jnp.float32) * lam_k1.astype(jnp.float32)))
           - jnp.exp(jnp.sum(lam_q2.astype(jnp.float32) * lam_k2.astype(jnp.float32)))
           + lam_init)
    o_diff = diff_attention(dq, dk, dv, lam, diff_norm_g, lam_init)
    nq = nq.reshape(B, T, NA_HEADS, NA_HEAD_DIM)
    nk = nk.reshape(B, T, NA_HEADS, NA_HEAD_DIM)
    nv = nv.reshape(B, T, NA_HEADS, NA_HEAD_DIM)
    o_na = neighborhood_attention(nq, nk, nv, rpb)
    a = jnp.concatenate([o_diff, o_na], axis=-1) @ w_out
    x = layer_norm(DEEPNORM_ALPHA * x + (1 + g2[:, None, :]) * a, ln_g[1], ln_b[1])

    h = modulate(x, s3, m3)
    f = swiglu(h, ffn2_w_gu, ffn2_w_down)
    x = layer_norm(DEEPNORM_ALPHA * x + (1 + g3[:, None, :]) * 0.5 * f, ln_g[2], ln_b[2])
    return x


def setup_inputs(seed: int = 0) -> dict:
    key = jax.random.key(seed)
    ks = jax.random.split(key, 24)
    f32 = jnp.float32
    n = lambda k, shape, s: (jax.random.normal(k, shape, f32) * s)
    return {
        "x_prompt": n(ks[0], (BATCH, SEQ, D_MODEL), 1.0),
        "x_sample": n(ks[1], (DEC_BATCH, DEC_SEQ, D_MODEL), 1.0),
        "c_prompt": n(ks[2], (BATCH, D_MODEL), 1.0),
        "c_sample": n(ks[3], (DEC_BATCH, D_MODEL), 1.0),
        "w_ada": n(ks[4], (DEPTH, D_MODEL, 9 * D_MODEL), 0.1 * D_MODEL ** -0.5),
        "b_ada": n(ks[5], (DEPTH, 9 * D_MODEL), 0.01),
        "ln_g": 1.0 + n(ks[6], (DEPTH, 3, D_MODEL), 0.02),
        "ln_b": n(ks[7], (DEPTH, 3, D_MODEL), 0.02),
        "ffn1_w_gu": n(ks[8], (DEPTH, D_MODEL, 2 * D_FF), D_MODEL ** -0.5),
        "ffn1_w_down": n(ks[9], (DEPTH, D_FF, D_MODEL), DEEPNORM_BETA * D_FF ** -0.5),
        "w_in": n(ks[10], (DEPTH, D_MODEL, IN_COLS), D_MODEL ** -0.5),
        "w_out": n(ks[11], (DEPTH, MIX_WIDTH, D_MODEL), DEEPNORM_BETA * MIX_WIDTH ** -0.5),
        "lam_q1": n(ks[12], (DEPTH, DIFF_HEAD_DIM), 0.1),
        "lam_k1": n(ks[13], (DEPTH, DIFF_HEAD_DIM), 0.1),
        "lam_q2": n(ks[14], (DEPTH, DIFF_HEAD_DIM), 0.1),
        "lam_k2": n(ks[15], (DEPTH, DIFF_HEAD_DIM), 0.1),
        "diff_norm_g": 1.0 + n(ks[16], (DEPTH, 2 * DIFF_HEAD_DIM), 0.02),
        "rpb": n(ks[17], (DEPTH, NA_HEADS, 2 * NA_KH_MAX - 1, 2 * NA_KW - 1), 0.1),
        "ffn2_w_gu": n(ks[18], (DEPTH, D_MODEL, 2 * D_FF), D_MODEL ** -0.5),
        "ffn2_w_down": n(ks[19], (DEPTH, D_FF, D_MODEL), DEEPNORM_BETA * D_FF ** -0.5),
    }


def reference(x_prompt, x_sample, c_prompt, c_sample, w_ada, b_ada, ln_g, ln_b,
              ffn1_w_gu, ffn1_w_down, w_in, w_out, lam_q1, lam_k1, lam_q2, lam_k2,
              diff_norm_g, rpb, ffn2_w_gu, ffn2_w_down):
    def run(x, c):
        for l in range(DEPTH):
            x = encoder_layer(x, c, l, w_ada[l], b_ada[l], ln_g[l], ln_b[l],
                              ffn1_w_gu[l], ffn1_w_down[l], w_in[l], w_out[l],
                              lam_q1[l], lam_k1[l], lam_q2[l], lam_k2[l],
                              diff_norm_g[l], rpb[l], ffn2_w_gu[l], ffn2_w_down[l])
        return x

    y_prompt = run(x_prompt, c_prompt)
    y_sample = run(x_sample, c_sample)
    return (y_prompt, y_sample)
```

```cpp
#include <hip/hip_runtime.h>
#include <cstdio>
#include <cstdint>
namespace pg8 {
#define PG8_LAS __attribute__((address_space(3)))
typedef unsigned short bf16_t;
typedef short bf16x8 __attribute__((ext_vector_type(8)));
typedef float f32x4 __attribute__((ext_vector_type(4)));
typedef unsigned u32x4 __attribute__((ext_vector_type(4)));
constexpr int BM = 256, BK = 64, HALF = 128, HTB = HALF * BK * 2  , STAGE_BYTES = 8 * HTB, NXCD = 8, WGM = 8;

__host__ __device__ __forceinline__ int lds_byte(int r, int c) { const int st = (r >> 4) * 2 + (c >> 5), rr = r & 15, cc = c & 31, ob = rr * 64 + cc * 2; return st * 1024 + (ob ^ (((ob >> 9) & 1) << 5)); }
__host__ __device__ __forceinline__ void stage_rc(int b, int& R, int& C) { const int st = b / 1024, sb = b % 1024, swz = sb ^ (((sb >> 9) & 1) << 5); R = (st >> 1) * 16 + swz / 64; C = (st & 1) * 32 + (swz % 64) / 2; }
__host__ __device__ __forceinline__ int perm32(int rho) { const int n = rho >> 4, i = rho & 15; return 8 * (i >> 2) + 4 * n + (i & 3); }

struct Unit { int pm, pn; };
struct Gemm { const bf16_t* A; const bf16_t* Bt; int M, N, K; };

struct StaticOrder {
    int nM, nN, nwg, G, c;
    __host__ __device__ void init(int M, int N, int G_, int c_) { nM = M / BM; nN = N / BM; nwg = nM * nN; G = G_; c = c_; }
    __host__ __device__ bool next(int i, Unit& u) const {
        const long L = (long)i * G + c; if (L >= nwg) return false;
        int wgid = (int)L; { const int q = nwg / NXCD, r = nwg % NXCD, xcd = wgid % NXCD, off = wgid / NXCD; wgid = (xcd < r ? xcd * (q + 1) : r * (q + 1) + (xcd - r) * q) + off; }
        const int nig = WGM * nN, gid = wgid / nig, fm = gid * WGM, gsz = (nM - fm) < WGM ? (nM - fm) : WGM;
        u.pm = fm + ((wgid % nig) % gsz); u.pn = (wgid % nig) / gsz; return true;
    }
    __device__ __forceinline__ void a_ready(const Unit&) const {}
    __device__ __forceinline__ void done(const Unit&) const {}
};

__device__ __forceinline__ unsigned cvt_pk_bf16(float lo, float hi) { unsigned r; asm volatile("v_cvt_pk_bf16_f32 %0, %1, %2" : "=v"(r) : "v"(lo), "v"(hi)); return r; }
typedef float f32x2 __attribute__((ext_vector_type(2)));
__device__ __forceinline__ float silu_f(float g) { return g * __builtin_amdgcn_rcpf(1.0f + __builtin_amdgcn_exp2f(-1.4426950408889634f * g)); }
struct EpiSwiGLU {
    static constexpr bool PERM = true, AFTER_DRAIN = false;
    bf16_t* O; int ldc;
    __device__ __forceinline__ void operator()(const f32x4 (&acc)[2][2][4][2], const Unit& u, int wr, int wc, int fr, int fq) const {
        const int row0 = u.pm * BM + wr * 64 + fr, col0 = u.pn * HALF + wc * 32 + 8 * fq;
#pragma unroll
        for (int ai = 0; ai < 2; ++ai)
#pragma unroll
            for (int m = 0; m < 4; ++m) { bf16_t* rowp = O + (size_t)(row0 + ai * HALF + m * 16) * ldc + col0;
                const f32x4 g0 = acc[ai][0][m][0], g1 = acc[ai][0][m][1], u0 = acc[ai][1][m][0], u1 = acc[ai][1][m][1];
                u32x4 w;
                w.x = cvt_pk_bf16(silu_f(g0[0]) * u0[0], silu_f(g0[1]) * u0[1]); w.y = cvt_pk_bf16(silu_f(g0[2]) * u0[2], silu_f(g0[3]) * u0[3]);
                w.z = cvt_pk_bf16(silu_f(g1[0]) * u1[0], silu_f(g1[1]) * u1[1]); w.w = cvt_pk_bf16(silu_f(g1[2]) * u1[2], silu_f(g1[3]) * u1[3]);
                *(u32x4*)rowp = w; }
    }
};
struct EpiResid {
    static constexpr bool PERM = false, AFTER_DRAIN = false;
    const float* xp; const float* xs;
    float* y; int ldc; const float* gate;
    float coef, alpha;
    __device__ __forceinline__ void operator()(const f32x4 (&acc)[2][2][4][2], const Unit& u, int wr, int wc, int fr, int fq) const {
        const int trow = u.pm * BM; const bool samp = trow >= 32768;
        const int bidx = samp ? 8 + ((trow - 32768) >> 14) : (trow >> 12);
        const float* xb = samp ? xs + (size_t)(trow - 32768) * ldc : xp + (size_t)trow * ldc;
        float* yb = y + (size_t)trow * ldc;
        const int col0 = u.pn * BM + wc * 32 + 4 * fq;
        const float* gp = gate + (size_t)bidx * 18432 + col0;
        f32x4 gv[2][2];
#pragma unroll
        for (int bj = 0; bj < 2; ++bj)
#pragma unroll
            for (int n = 0; n < 2; ++n) gv[bj][n] = (*(const f32x4*)(gp + bj * HALF + n * 16) + 1.0f) * coef;
#pragma unroll
        for (int ai = 0; ai < 2; ++ai)
#pragma unroll
            for (int m = 0; m < 4; ++m) { const size_t off = (size_t)(ai * HALF + wr * 64 + m * 16 + fr) * ldc + col0;
#pragma unroll
                for (int bj = 0; bj < 2; ++bj)
#pragma unroll
                    for (int n = 0; n < 2; ++n) { const f32x4 xv = *(const f32x4*)(xb + off + bj * HALF + n * 16);
                        const f32x4 o = xv * alpha + gv[bj][n] * acc[ai][bj][m][n]; *(f32x4*)(yb + off + bj * HALF + n * 16) = o; }
                if (m & 1) asm volatile("" ::: "memory"); }
    }
};
struct EpiRope {
    static constexpr bool PERM = true, AFTER_DRAIN = false;
    bf16_t* O; int ldc; const float* ropeC; const float* ropeS;
    __device__ __forceinline__ void operator()(const f32x4 (&acc)[2][2][4][2], const Unit& u, int wr, int wc, int fr, int fq) const {
        const int row0 = u.pm * BM + wr * 64 + fr, col0 = u.pn * BM + wc * 32 + 8 * fq;
        const bool rot = u.pn < 8; const int i0 = (wc & 1) * 16 + 4 * fq;
#pragma unroll
        for (int ai = 0; ai < 2; ++ai)
#pragma unroll
            for (int m = 0; m < 4; ++m) { const int row = row0 + ai * HALF + m * 16; const int t = row < 32768 ? (row & 4095) : (row & 16383);
                f32x4 cs = (f32x4){1.f, 1.f, 1.f, 1.f}, sn = (f32x4){0.f, 0.f, 0.f, 0.f};
                if (rot) { cs = *(const f32x4*)(ropeC + (size_t)t * 32 + i0); sn = *(const f32x4*)(ropeS + (size_t)t * 32 + i0); }
                bf16_t* rowp = O + (size_t)row * ldc + col0;
#pragma unroll
                for (int bj = 0; bj < 2; ++bj) { const f32x4 v0 = acc[ai][bj][m][0], v1 = acc[ai][bj][m][1];
                    const float a0 = v0[0] * cs[0] - v0[1] * sn[0], b0 = v0[1] * cs[0] + v0[0] * sn[0];
                    const float a1 = v0[2] * cs[1] - v0[3] * sn[1], b1 = v0[3] * cs[1] + v0[2] * sn[1];
                    const float a2 = v1[0] * cs[2] - v1[1] * sn[2], b2 = v1[1] * cs[2] + v1[0] * sn[2];
                    const float a3 = v1[2] * cs[3] - v1[3] * sn[3], b3 = v1[3] * cs[3] + v1[2] * sn[3];
                    u32x4 w; w.x = cvt_pk_bf16(a0, b0); w.y = cvt_pk_bf16(a1, b1); w.z = cvt_pk_bf16(a2, b2); w.w = cvt_pk_bf16(a3, b3);
                    *(u32x4*)(rowp + bj * HALF) = w; } }
    }
};

template <class Epi, class Sched, bool ALIGN_EPI = false, bool SP2 = false>
__device__ __forceinline__ void gemm_phase(PG8_LAS unsigned char* lds, const Gemm g, const Sched& S, const Epi& E) {
    int tid_ = threadIdx.x; asm volatile("" : "+v"(tid_));
    const int tid = tid_, wid = __builtin_amdgcn_readfirstlane(tid >> 6), lane = tid & 63, wr = wid >> 2, wc = wid & 3, fr = lane & 15, fq = lane >> 4;
    const int K = g.K, nt = K / BK;
    unsigned voffA[2], voffB[2];
#pragma unroll
    for (int i = 0; i < 2; ++i) { int R, C; stage_rc(tid * 16 + i * 8192, R, C); const int Rb = Epi::PERM ? ((R & ~31) + perm32(R & 31)) : R;
        voffA[i] = (unsigned)(R * K + C) * 2u; voffB[i] = (unsigned)(Rb * K + C) * 2u; }
    const size_t kstep = (size_t)(BK * 2);
    const size_t hstep = (size_t)HALF * K * 2;
    const size_t tstep = 2 * hstep;
    const unsigned ldsw = (unsigned)wid * 1024u;
    const int aoff = lds_byte(wr * 64 + fr, fq * 8), boff = lds_byte(wc * 32 + fr, fq * 8);
#define PG8_SA(b, h) (((b) * 2 + (h)) * HTB)
#define PG8_SB(b, h) ((4 + (b) * 2 + (h)) * HTB)
#define PG8_STAGE(bufoff, gbase, voff) do { _Pragma("unroll") for (int _i = 0; _i < 2; ++_i) \
        __builtin_amdgcn_global_load_lds((const unsigned*)((const char*)(gbase) + (voff)[_i]), (PG8_LAS unsigned*)(lds + (bufoff) + ldsw + _i * 8192), 16, 0, 0); } while (0)
#define PG8_LDA(dst, b, h) do { _Pragma("unroll") for (int m = 0; m < 4; ++m) _Pragma("unroll") for (int k = 0; k < 2; ++k) dst[m][k] = *(const PG8_LAS bf16x8*)(lds + PG8_SA(b, h) + aoff + m * 2048 + k * 1024); } while (0)
#define PG8_LDB(dst, b, h) do { _Pragma("unroll") for (int n = 0; n < 2; ++n) _Pragma("unroll") for (int k = 0; k < 2; ++k) dst[n][k] = *(const PG8_LAS bf16x8*)(lds + PG8_SB(b, h) + boff + n * 2048 + k * 1024); } while (0)
#define PG8_MMA(ai, bj, At, Bt) do { __builtin_amdgcn_s_setprio(1); _Pragma("unroll") for (int m = 0; m < 4; ++m) _Pragma("unroll") for (int n = 0; n < 2; ++n) _Pragma("unroll") for (int k = 0; k < 2; ++k) \
        acc[ai][bj][m][n] = __builtin_amdgcn_mfma_f32_16x16x32_bf16(Bt[n][k], At[m][k], acc[ai][bj][m][n], 0, 0, 0); __builtin_amdgcn_s_setprio(0); } while (0)
#define PG8_WAIT_V(n) asm volatile("s_waitcnt vmcnt(" #n ")" ::: "memory")
#define PG8_WAIT_L(n) asm volatile("s_waitcnt lgkmcnt(" #n ")" ::: "memory")
#define PG8_BAR __builtin_amdgcn_s_barrier()
#define PG8_SCHED __builtin_amdgcn_sched_barrier(0)
    Unit cur, nxt; int ui = 0;
    if (!S.next(0, cur)) return;
    f32x4 acc[2][2][4][2];
#pragma unroll
    for (int a = 0; a < 2; ++a)
#pragma unroll
        for (int b = 0; b < 2; ++b)
#pragma unroll
            for (int m = 0; m < 4; ++m)
#pragma unroll
                for (int n = 0; n < 2; ++n) acc[a][b][m][n] = (f32x4){0.f, 0.f, 0.f, 0.f};
    bf16x8 At[4][2], B0[2][2], B1[2][2];
    const char* cA = (const char*)g.A + (size_t)cur.pm * tstep; const char* cB = (const char*)g.Bt + (size_t)cur.pn * tstep;
    S.a_ready(cur);
    if constexpr (SP2) {
        PG8_STAGE(PG8_SB(0, 0), cB, voffB); PG8_STAGE(PG8_SB(0, 1), cB + hstep, voffB); PG8_STAGE(PG8_SA(0, 0), cA, voffA); PG8_STAGE(PG8_SA(0, 1), cA + hstep, voffA);
        if (wr == 1) PG8_BAR;
        PG8_WAIT_V(2); PG8_BAR;
        PG8_STAGE(PG8_SB(1, 0), cB + kstep, voffB); PG8_STAGE(PG8_SA(1, 0), cA + kstep, voffA); PG8_STAGE(PG8_SB(1, 1), cB + hstep + kstep, voffB);
        PG8_WAIT_V(6); PG8_BAR;
    } else {
        PG8_STAGE(PG8_SB(0, 0), cB, voffB); PG8_STAGE(PG8_SA(0, 0), cA, voffA); PG8_STAGE(PG8_SB(0, 1), cB + hstep, voffB); PG8_STAGE(PG8_SA(0, 1), cA + hstep, voffA);
        if (wr == 1) PG8_BAR;
        PG8_WAIT_V(4); PG8_BAR;
        PG8_STAGE(PG8_SB(1, 0), cB + kstep, voffB); PG8_STAGE(PG8_SA(1, 0), cA + kstep, voffA); PG8_STAGE(PG8_SB(1, 1), cB + hstep + kstep, voffB);
        PG8_WAIT_V(6); PG8_BAR;
    }
    for (;;) {
        const bool has_next = S.next(ui + 1, nxt);
        const char* nA = has_next ? (const char*)g.A + (size_t)nxt.pm * tstep : cA; const char* nB = has_next ? (const char*)g.Bt + (size_t)nxt.pn * tstep : cB;
        for (int t = 0; t < nt; t += 2) {
            const bool last = (t == nt - 2);
            const char* a1 = cA + (size_t)(t + 1) * kstep;
            const char* a2 = last ? nA : cA + (size_t)(t + 2) * kstep; const char* b2 = last ? nB : cB + (size_t)(t + 2) * kstep;
            const char* a3 = a2 + kstep; const char* b3 = b2 + kstep;
            if (last && has_next) S.a_ready(nxt);
            if constexpr (SP2) {
            PG8_LDB(B0, 0, 0); PG8_LDB(B1, 0, 1); PG8_SCHED; PG8_LDA(At, 0, 0); PG8_STAGE(PG8_SA(1, 1), a1 + hstep, voffA);
            PG8_WAIT_V(8); PG8_WAIT_L(0); PG8_BAR; PG8_MMA(0, 0, At, B0); PG8_MMA(0, 1, At, B1); PG8_BAR; PG8_SCHED;
            PG8_LDA(At, 0, 1); PG8_STAGE(PG8_SB(0, 0), b2, voffB); PG8_STAGE(PG8_SB(0, 1), b2 + hstep, voffB); PG8_STAGE(PG8_SA(0, 0), a2, voffA);
            PG8_WAIT_V(8); PG8_WAIT_L(0); PG8_BAR; PG8_MMA(1, 0, At, B0); PG8_MMA(1, 1, At, B1); PG8_BAR; PG8_SCHED;
            PG8_LDB(B0, 1, 0); PG8_LDB(B1, 1, 1); PG8_SCHED; PG8_LDA(At, 1, 0); PG8_STAGE(PG8_SA(0, 1), a2 + hstep, voffA);
            PG8_WAIT_V(8); PG8_WAIT_L(0); PG8_BAR; PG8_MMA(0, 0, At, B0); PG8_MMA(0, 1, At, B1); PG8_BAR; PG8_SCHED;
            PG8_LDA(At, 1, 1); PG8_STAGE(PG8_SB(1, 0), b3, voffB); PG8_STAGE(PG8_SB(1, 1), b3 + hstep, voffB); PG8_STAGE(PG8_SA(1, 0), a3, voffA);
            PG8_WAIT_V(8); PG8_WAIT_L(0); PG8_BAR; PG8_MMA(1, 0, At, B0); PG8_MMA(1, 1, At, B1); PG8_BAR; PG8_SCHED;
            } else {
            PG8_LDB(B0, 0, 0); PG8_SCHED; PG8_LDA(At, 0, 0); PG8_STAGE(PG8_SA(1, 1), a1 + hstep, voffA);
            PG8_WAIT_L(8); PG8_BAR; PG8_WAIT_L(0); PG8_MMA(0, 0, At, B0); PG8_BAR; PG8_SCHED;
            PG8_LDB(B1, 0, 1); PG8_STAGE(PG8_SB(0, 0), b2, voffB);
            PG8_BAR; PG8_WAIT_L(0); PG8_MMA(0, 1, At, B1); PG8_BAR;
            PG8_LDA(At, 0, 1); PG8_STAGE(PG8_SA(0, 0), a2, voffA);
            PG8_BAR; PG8_WAIT_L(0); PG8_MMA(1, 0, At, B0); PG8_BAR; PG8_SCHED;
            PG8_STAGE(PG8_SB(0, 1), b2 + hstep, voffB);
            PG8_WAIT_V(6); PG8_BAR; PG8_MMA(1, 1, At, B1); PG8_BAR;
            PG8_LDB(B0, 1, 0); PG8_SCHED; PG8_LDA(At, 1, 0); PG8_STAGE(PG8_SA(0, 1), a2 + hstep, voffA);
            PG8_WAIT_L(8); PG8_BAR; PG8_WAIT_L(0); PG8_MMA(0, 0, At, B0); PG8_BAR; PG8_SCHED;
            PG8_LDB(B1, 1, 1); PG8_STAGE(PG8_SB(1, 0), b3, voffB);
            PG8_BAR; PG8_WAIT_L(0); PG8_MMA(0, 1, At, B1); PG8_BAR;
            PG8_LDA(At, 1, 1); PG8_STAGE(PG8_SA(1, 0), a3, voffA);
            PG8_BAR; PG8_WAIT_L(0); PG8_MMA(1, 0, At, B0); PG8_BAR; PG8_SCHED;
            PG8_STAGE(PG8_SB(1, 1), b3 + hstep, voffB);
            PG8_WAIT_V(6); PG8_BAR; PG8_MMA(1, 1, At, B1); PG8_BAR;
            }
        }
        if constexpr (ALIGN_EPI) { if (wr == 0) PG8_BAR; }
        if constexpr (!Epi::AFTER_DRAIN) { E(acc, cur, wr, wc, fr, fq); S.done(cur); }
        if (!has_next) break;
#pragma unroll
        for (int a = 0; a < 2; ++a)
#pragma unroll
            for (int b = 0; b < 2; ++b)
#pragma unroll
                for (int m = 0; m < 4; ++m)
#pragma unroll
                    for (int n = 0; n < 2; ++n) acc[a][b][m][n] = (f32x4){0.f, 0.f, 0.f, 0.f};
        cur = nxt; cA = nA; cB = nB; ++ui;
        if constexpr (ALIGN_EPI) { if (wr == 1) PG8_BAR; }
    }
    PG8_WAIT_V(0);
    if constexpr (!ALIGN_EPI) { if (wr == 0) PG8_BAR; }
    PG8_BAR;
    if constexpr (Epi::AFTER_DRAIN) { E.fused(acc, cur, wr, wc, fr, fq, lds, wid, lane); S.done(cur); }
#undef PG8_SA
#undef PG8_SB
#undef PG8_STAGE
#undef PG8_LDA
#undef PG8_LDB
#undef PG8_MMA
#undef PG8_WAIT_V
#undef PG8_WAIT_L
#undef PG8_BAR
#undef PG8_SCHED
}
}
namespace att {
#define AGAS __attribute__((address_space(1)))
typedef unsigned short bf16;
using bf16x8 = __attribute__((ext_vector_type(8))) short;
using s16x4  = __attribute__((ext_vector_type(4))) short;
using f32x16 = __attribute__((ext_vector_type(16))) float;
using u32x4  = __attribute__((ext_vector_type(4))) unsigned;
constexpr int LDP = 6144, LDO = 2048;
constexpr int SHM_V = 64 * 128 * 2, SHM_K = 64 * 128 * 2;
constexpr int OFF_V = 0, OFF_K = 2 * SHM_V, OFF_WS = 2 * SHM_V + 2 * SHM_K, OFF_BT = OFF_WS + 8 * 64 * 4, ATT_LDS = OFF_BT + 2048;
constexpr float LOG2E = 1.4426950408889634f;
#define KSWZ128(row, colB) ((row) * 256 + ((colB) ^ (((row) & 7) << 4)))
#define KSWZ64(row, colB)  ((row) * 128 + ((colB) ^ ((((row) >> 1) & 7) << 4)))
#define SBAR() __builtin_amdgcn_sched_barrier(0)
__device__ __forceinline__ int crow(int r, int hi) { return (r & 3) + 8 * (r >> 2) + 4 * hi; }
__device__ __forceinline__ unsigned cvtpk(float lo, float hi) { unsigned r; asm volatile("v_cvt_pk_bf16_f32 %0, %1, %2" : "=v"(r) : "v"(lo), "v"(hi)); return r; }
__device__ __forceinline__ bf16x8 ld8(const AGAS bf16* p) { return *(const AGAS bf16x8*)(p); }
__device__ __forceinline__ unsigned short f2bf1(float f) { return (unsigned short)(cvtpk(f, 0.f) & 0xffffu); }

__device__ __forceinline__ int v_st(int k, int c) { const int kk = (k & ~0xC) | ((k & 4) << 1) | ((k & 8) >> 1); return ((kk >> 3) * 4 + (c >> 5)) * 512 + ((kk & 7) * 32 + (c & 31)) * 2; }
__device__ __forceinline__ int v_rd_base(int lane) { return ((lane & 3) << 3) | (((lane >> 2) & 3) << 6) | (((lane >> 4) & 1) << 5) | (((lane >> 5) & 1) << 8); }
constexpr int v_rd_off(int d0, int ks, int half) { return d0 * 512 + ks * 4096 + half * 2048; }
template <int OFF> __device__ __forceinline__ s16x4 tr_read(int vb) {
  s16x4 r; asm volatile("ds_read_b64_tr_b16 %0, %1 offset:%2" : "=&v"(r) : "v"(vb), "i"(OFF) : "memory"); return r;
}
template <int D0> __device__ __forceinline__ void pv_one(f32x16& od, int vb, bf16x8 pa0, bf16x8 pa1, bf16x8 pa2, bf16x8 pa3) {
  const s16x4 l0 = tr_read<v_rd_off(D0, 0, 0)>(vb), h0 = tr_read<v_rd_off(D0, 0, 1)>(vb), l1 = tr_read<v_rd_off(D0, 1, 0)>(vb), h1 = tr_read<v_rd_off(D0, 1, 1)>(vb);
  const s16x4 l2 = tr_read<v_rd_off(D0, 2, 0)>(vb), h2 = tr_read<v_rd_off(D0, 2, 1)>(vb), l3 = tr_read<v_rd_off(D0, 3, 0)>(vb), h3 = tr_read<v_rd_off(D0, 3, 1)>(vb);
  asm volatile("s_waitcnt lgkmcnt(0)" ::: "memory"); SBAR();
#define PK(L, H) (bf16x8){L[0], L[1], L[2], L[3], H[0], H[1], H[2], H[3]}
  od = __builtin_amdgcn_mfma_f32_32x32x16_bf16(pa0, PK(l0, h0), od, 0, 0, 0);
  od = __builtin_amdgcn_mfma_f32_32x32x16_bf16(pa1, PK(l1, h1), od, 0, 0, 0);
  od = __builtin_amdgcn_mfma_f32_32x32x16_bf16(pa2, PK(l2, h2), od, 0, 0, 0);
  od = __builtin_amdgcn_mfma_f32_32x32x16_bf16(pa3, PK(l3, h3), od, 0, 0, 0);
#undef PK
}
__device__ __forceinline__ void pv_d0(f32x16* o, int vb, bf16x8 pa0, bf16x8 pa1, bf16x8 pa2, bf16x8 pa3) {
  pv_one<0>(o[0], vb, pa0, pa1, pa2, pa3); pv_one<1>(o[1], vb, pa0, pa1, pa2, pa3); pv_one<2>(o[2], vb, pa0, pa1, pa2, pa3); pv_one<3>(o[3], vb, pa0, pa1, pa2, pa3);
}
#define ATT_PK4(P, BASE, OUT) do { unsigned a0_ = cvtpk(P[BASE + 0], P[BASE + 1]), a1_ = cvtpk(P[BASE + 2], P[BASE + 3]);   \
    unsigned b0_ = cvtpk(P[BASE + 4], P[BASE + 5]), b1_ = cvtpk(P[BASE + 6], P[BASE + 7]);                              \
    auto r0_ = __builtin_amdgcn_permlane32_swap(a0_, b0_, false, false); auto r1_ = __builtin_amdgcn_permlane32_swap(a1_, b1_, false, false); \
    u32x4 w_ = {r0_[0], r1_[0], r0_[1], r1_[1]}; OUT = *reinterpret_cast<bf16x8*>(&w_); } while (0)

constexpr float DSCALE = 0.125f, DTHR = 8.f;
__device__ __forceinline__ void d_partialSM(f32x16& p0, f32x16& p1, float& m_reg, float& mn, float& alpha) {
  constexpr float C = DSCALE * LOG2E;
  float pmax = p0[0];
#pragma unroll
  for (int r = 1; r < 16; ++r) pmax = fmaxf(pmax, p0[r]);
#pragma unroll
  for (int r = 0; r < 16; ++r) pmax = fmaxf(pmax, p1[r]);
  { auto rr = __builtin_amdgcn_permlane32_swap(__float_as_uint(pmax), __float_as_uint(pmax), false, false);
    pmax = fmaxf(__uint_as_float(rr[0]), __uint_as_float(rr[1])); }
  if (__builtin_expect(__all(pmax - m_reg <= DTHR / DSCALE), 1)) { mn = m_reg; alpha = 1.f; }
  else { mn = fmaxf(m_reg, pmax); alpha = __builtin_amdgcn_exp2f((m_reg - mn) * C); m_reg = mn; }
  const float mnC = -mn * C;
#pragma unroll
  for (int r = 0; r < 16; ++r) p0[r] = fmaf(p0[r], C, mnC);
#pragma unroll
  for (int r = 0; r < 16; ++r) p1[r] = fmaf(p1[r], C, mnC);
#pragma unroll
  for (int r = 0; r < 16; ++r) p0[r] = __builtin_amdgcn_exp2f(p0[r]);
}
__device__ __forceinline__ void d_finishSM(f32x16& p0, f32x16& p1, float alpha, float& l_reg, bf16x8& pa0, bf16x8& pa1, bf16x8& pa2, bf16x8& pa3) {
#pragma unroll
  for (int r = 0; r < 16; ++r) p1[r] = __builtin_amdgcn_exp2f(p1[r]);
  float ps = 0;
#pragma unroll
  for (int r = 0; r < 16; ++r) ps += p0[r];
#pragma unroll
  for (int r = 0; r < 16; ++r) ps += p1[r];
  { auto rr = __builtin_amdgcn_permlane32_swap(__float_as_uint(ps), __float_as_uint(ps), false, false);
    ps = __uint_as_float(rr[0]) + __uint_as_float(rr[1]); }
  l_reg = l_reg * alpha + ps;
  ATT_PK4(p0, 0, pa0); ATT_PK4(p0, 8, pa1); ATT_PK4(p1, 0, pa2); ATT_PK4(p1, 8, pa3);
}
__device__ __forceinline__ void d_qkt(f32x16& p0, f32x16& p1, const char* Ks, const bf16x8* qr, int r32, int hi) {
  p0 = f32x16{}; p1 = f32x16{};
#pragma unroll
  for (int d0 = 0; d0 < 4; ++d0) { const int cb = (d0 * 16 + hi * 8) * 2;
    const bf16x8 b0 = *reinterpret_cast<const bf16x8*>(Ks + KSWZ64(r32, cb));
    const bf16x8 b1 = *reinterpret_cast<const bf16x8*>(Ks + KSWZ64(32 + r32, cb));
    p0 = __builtin_amdgcn_mfma_f32_32x32x16_bf16(b0, qr[d0], p0, 0, 0, 0);
    p1 = __builtin_amdgcn_mfma_f32_32x32x16_bf16(b1, qr[d0], p1, 0, 0, 0); }
}
__device__ __forceinline__ void diff_unit(const AGAS bf16* __restrict__ proj, long row0, int T, int h, int q0, float lam, float gscale,
                                          const AGAS float* __restrict__ ng, AGAS bf16* __restrict__ out, AGAS float* __restrict__ stash, char* lds) {
  int tid_ = threadIdx.x; asm volatile("" : "+v"(tid_));
  const int tid = tid_, wid = __builtin_amdgcn_readfirstlane(tid >> 6), lane = tid & 63, r32 = lane & 31, hi = lane >> 5;
  char* V_lds = lds + OFF_V; char* K_lds = lds + OFF_K;
  float* ws = (float*)(lds + OFF_WS) + wid * 64; float* li_l = ws; float* al_l = ws + 32;
  const int ksr = tid >> 3, ksc = (tid & 7) * 8;
  const int sr = tid >> 4, sc = (tid & 15) * 8, vst0 = v_st(sr, sc), vst1 = v_st(32 + sr, sc);
  const int kst = KSWZ64(ksr, ksc * 2);
  const int vb0 = (int)(uintptr_t)V_lds + v_rd_base(lane);
  const int NT = T / 64;
  typedef float f32x4v __attribute__((ext_vector_type(4)));
#pragma unroll 1
  for (int c = 0; c < 2; ++c) {
    const AGAS bf16* pj = proj; asm volatile("" : "+s"(pj));
    const AGAS bf16* Qw = pj + (row0 + q0 + wid * 32 + r32) * LDP + h * 128 + c * 64 + hi * 8;
    const AGAS bf16* Kh = pj + row0 * LDP + 1024 + h * 128 + c * 64;
    const AGAS bf16* Vh = pj + row0 * LDP + 2048 + h * 128;
    float m_reg = -1e30f, l_reg = 0.f; f32x16 o[4] = {}; bf16x8 qr[4];
#pragma unroll
    for (int d0 = 0; d0 < 4; ++d0) qr[d0] = ld8(Qw + d0 * 16);
    struct { bf16x8 vs0, vs1, ks0; } sr_[2];
#define SLOAD(i, k0) do { sr_[i].vs0 = ld8(&Vh[(long)((k0) + sr) * LDP + sc]); sr_[i].vs1 = ld8(&Vh[(long)((k0) + 32 + sr) * LDP + sc]); \
      sr_[i].ks0 = ld8(&Kh[(long)((k0) + ksr) * LDP + ksc]); } while (0)
#define SWRITE(b, i) do { *(bf16x8*)(V_lds + (b) * SHM_V + vst0) = sr_[i].vs0; *(bf16x8*)(V_lds + (b) * SHM_V + vst1) = sr_[i].vs1; \
      *(bf16x8*)(K_lds + (b) * SHM_K + kst) = sr_[i].ks0; } while (0)
#define SWAIT() asm volatile("s_waitcnt vmcnt(3)" ::: "memory")
#define RESC(a) do { if (__any((a) < 1.f)) { if (hi == 0) al_l[r32] = (a); asm volatile("s_waitcnt lgkmcnt(0)" ::: "memory"); \
      _Pragma("unroll") for (int d = 0; d < 4; ++d) _Pragma("unroll") for (int r = 0; r < 16; ++r) o[d][r] *= al_l[crow(r, hi)]; } } while (0)
    f32x16 pA0, pA1, pB0, pB1; float mnA, mnB, alA, alB; bf16x8 pa0, pa1, pa2, pa3;
    __syncthreads();
    SLOAD(0, 0); asm volatile("s_waitcnt vmcnt(0)" ::: "memory"); SWRITE(0, 0); __syncthreads();
    d_qkt(pA0, pA1, K_lds, qr, r32, hi); d_partialSM(pA0, pA1, m_reg, mnA, alA);
    SLOAD(1, 64); if (2 < NT) SLOAD(0, 128);
    SWAIT(); SWRITE(1, 1); __syncthreads();
    for (int j = 1; j + 1 < NT; j += 2) {
      SBAR(); d_qkt(pB0, pB1, K_lds + SHM_K, qr, r32, hi);
      d_finishSM(pA0, pA1, alA, l_reg, pa0, pa1, pa2, pa3); SBAR();
      SLOAD(1, (j + 2) * 64); SBAR();
      pv_d0(o, vb0, pa0, pa1, pa2, pa3); d_partialSM(pB0, pB1, m_reg, mnB, alB);
      __syncthreads(); SWAIT(); SWRITE(0, 0);
      RESC(alB); __syncthreads();
      SBAR(); d_qkt(pA0, pA1, K_lds, qr, r32, hi);
      d_finishSM(pB0, pB1, alB, l_reg, pa0, pa1, pa2, pa3); SBAR();
      if (j + 3 < NT) SLOAD(0, (j + 3) * 64); SBAR();
      pv_d0(o, vb0 + SHM_V, pa0, pa1, pa2, pa3); d_partialSM(pA0, pA1, m_reg, mnA, alA);
      __syncthreads(); SWAIT(); SWRITE(1, 1);
      RESC(alA); __syncthreads();
    }
    SBAR(); d_qkt(pB0, pB1, K_lds + SHM_K, qr, r32, hi);
    d_finishSM(pA0, pA1, alA, l_reg, pa0, pa1, pa2, pa3); SBAR();
    pv_d0(o, vb0, pa0, pa1, pa2, pa3); d_partialSM(pB0, pB1, m_reg, mnB, alB);
    __syncthreads(); RESC(alB);
    d_finishSM(pB0, pB1, alB, l_reg, pa0, pa1, pa2, pa3); SBAR();
    pv_d0(o, vb0 + SHM_V, pa0, pa1, pa2, pa3);
#undef SLOAD
#undef SWRITE
#undef SWAIT
#undef RESC
    if (hi == 0) li_l[r32] = l_reg; asm volatile("s_waitcnt lgkmcnt(0)" ::: "memory");
    float rli[16];
#pragma unroll
    for (int r = 0; r < 16; ++r) rli[r] = __builtin_amdgcn_rcpf(li_l[crow(r, hi)]);
    AGAS float* stash_l = stash; asm volatile("" : "+s"(stash_l));
    AGAS f32x4v* st4 = (AGAS f32x4v*)(stash_l + ((size_t)wid * 64 + lane) * 64);
    if (c == 0) {
#pragma unroll
      for (int d0 = 0; d0 < 4; ++d0)
#pragma unroll
        for (int r4 = 0; r4 < 4; ++r4) st4[d0 * 4 + r4] = (f32x4v){o[d0][4 * r4] * rli[4 * r4], o[d0][4 * r4 + 1] * rli[4 * r4 + 1], o[d0][4 * r4 + 2] * rli[4 * r4 + 2], o[d0][4 * r4 + 3] * rli[4 * r4 + 3]};
    } else {
      AGAS bf16* out_l = out; asm volatile("" : "+s"(out_l));
      AGAS bf16* Ow = out_l + (row0 + q0 + wid * 32) * LDO + h * 128 + r32;
      float gv[4];
#pragma unroll
      for (int d0 = 0; d0 < 4; ++d0) gv[d0] = ng[d0 * 32 + r32] * gscale;
#pragma unroll
      for (int r4 = 0; r4 < 4; ++r4) {
        f32x4v s4[4];
#pragma unroll
        for (int d0 = 0; d0 < 4; ++d0) s4[d0] = st4[d0 * 4 + r4];
#pragma unroll
        for (int e = 0; e < 4; ++e) { const int r = 4 * r4 + e;
          float v[4]; float ss = 0.f;
#pragma unroll
          for (int d0 = 0; d0 < 4; ++d0) { v[d0] = s4[d0][e] - lam * (o[d0][r] * rli[r]); ss += v[d0] * v[d0]; }
          ss += __shfl_xor(ss, 1); ss += __shfl_xor(ss, 2); ss += __shfl_xor(ss, 4); ss += __shfl_xor(ss, 8); ss += __shfl_xor(ss, 16);
          const float rstd = 1.0f / sqrtf(ss * (1.0f / 128.0f) + 1e-5f);
          AGAS bf16* ob = Ow; asm volatile("" : "+v"(ob)); AGAS bf16* op = ob + (long)crow(r, hi) * LDO;
#pragma unroll
          for (int d0 = 0; d0 < 4; ++d0) op[d0 * 32] = f2bf1(v[d0] * rstd * gv[d0]);
        }
      }
    }
  }
}

__device__ __forceinline__ void na_qkt(f32x16& p0, f32x16& p1, const char* Ks, const bf16x8* qr, int r32, int hi) {
  p0 = f32x16{}; p1 = f32x16{};
#pragma unroll
  for (int d0 = 0; d0 < 8; ++d0) { const int cb = (d0 * 16 + hi * 8) * 2;
    const bf16x8 b0 = *reinterpret_cast<const bf16x8*>(Ks + KSWZ128(r32, cb));
    const bf16x8 b1 = *reinterpret_cast<const bf16x8*>(Ks + KSWZ128(32 + r32, cb));
    p0 = __builtin_amdgcn_mfma_f32_32x32x16_bf16(b0, qr[d0], p0, 0, 0, 0);
    p1 = __builtin_amdgcn_mfma_f32_32x32x16_bf16(b1, qr[d0], p1, 0, 0, 0); }
}
__device__ __forceinline__ void na_unit(const AGAS bf16* __restrict__ proj, long row0, int rows, int h, int r0, const AGAS float* __restrict__ rpb_h,
                                        AGAS bf16* __restrict__ out, char* lds) {
  int tid_ = threadIdx.x; asm volatile("" : "+v"(tid_));
  const int tid = tid_, wid = __builtin_amdgcn_readfirstlane(tid >> 6), lane = tid & 63, r32 = lane & 31, hi = lane >> 5;
  char* V_lds = lds + OFF_V; char* K_lds = lds + OFF_K;
  float* ws = (float*)(lds + OFF_WS) + wid * 64; float* li_l = ws; float* al_l = ws + 32;
  float* bt = (float*)(lds + OFF_BT);
  constexpr float C = 0.08838834764831845f * LOG2E;
  __syncthreads();
  for (int i = tid; i < 15 * 31; i += 512) bt[i] = rpb_h[i] * LOG2E;
  const int r = r0 + (wid >> 1), cq = (wid & 1) * 32 + r32;
  const int cs = min(max(cq - 8, 0), 48);
  const int rs_w = min(max(r - 4, 0), rows - 8);
  const int kr_lo = min(max(r0 - 4, 0), rows - 8), kr_hi = min(max(r0 - 1, 0), rows - 8) + 8;
  const AGAS bf16* Qw = proj + (row0 + (long)r * 64 + cq) * LDP + 3072 + h * 128 + hi * 8;
  bf16x8 qr[8];
#pragma unroll
  for (int d0 = 0; d0 < 8; ++d0) qr[d0] = ld8(Qw + d0 * 16);
  const int sr = tid >> 4, sc = (tid & 15) * 8, vst0 = v_st(sr, sc), vst1 = v_st(32 + sr, sc);
  const int kst0 = KSWZ128(sr, sc * 2), kst1 = KSWZ128(32 + sr, sc * 2);
  const int vb0 = (int)(uintptr_t)V_lds + v_rd_base(lane);
  const AGAS bf16* Kh = proj + row0 * LDP + 4096 + h * 128; const AGAS bf16* Vh = proj + row0 * LDP + 5120 + h * 128;
  float m_reg = -1e30f, l_reg = 0.f; f32x16 o[4] = {};
  for (int kr = kr_lo; kr < kr_hi; ++kr) {
    const long kb = (long)kr * 64;
    const bf16x8 vs0 = ld8(&Vh[(kb + sr) * LDP + sc]), vs1 = ld8(&Vh[(kb + 32 + sr) * LDP + sc]);
    const bf16x8 ks0 = ld8(&Kh[(kb + sr) * LDP + sc]), ks1 = ld8(&Kh[(kb + 32 + sr) * LDP + sc]);
    __syncthreads();
    *(bf16x8*)(V_lds + vst0) = vs0; *(bf16x8*)(V_lds + vst1) = vs1; *(bf16x8*)(K_lds + kst0) = ks0; *(bf16x8*)(K_lds + kst1) = ks1;
    __syncthreads();
    if (kr >= rs_w && kr < rs_w + 8) {
      f32x16 p0, p1; na_qkt(p0, p1, K_lds, qr, r32, hi);
      const float* btr = bt + (kr - r + 7) * 31;
      float pmax = -INFINITY;
#pragma unroll
      for (int rr = 0; rr < 16; ++rr) {
        const int ck0 = crow(rr, hi), ck1 = ck0 + 32;
        const int ci0 = min(max(ck0 - cq, -15), 15) + 15, ci1 = min(max(ck1 - cq, -15), 15) + 15;
        const float s0 = fmaf(p0[rr], C, btr[ci0]), s1 = fmaf(p1[rr], C, btr[ci1]);
        p0[rr] = (ck0 >= cs && ck0 < cs + 16) ? s0 : -INFINITY; p1[rr] = (ck1 >= cs && ck1 < cs + 16) ? s1 : -INFINITY;
        pmax = fmaxf(pmax, fmaxf(p0[rr], p1[rr]));
      }
      { auto rr = __builtin_amdgcn_permlane32_swap(__float_as_uint(pmax), __float_as_uint(pmax), false, false);
        pmax = fmaxf(__uint_as_float(rr[0]), __uint_as_float(rr[1])); }
      const float mn = fmaxf(m_reg, pmax); const float alpha = __builtin_amdgcn_exp2f(m_reg - mn); m_reg = mn;
      float ps = 0.f;
#pragma unroll
      for (int rr = 0; rr < 16; ++rr) { p0[rr] = __builtin_amdgcn_exp2f(p0[rr] - mn); p1[rr] = __builtin_amdgcn_exp2f(p1[rr] - mn); ps += p0[rr] + p1[rr]; }
      { auto rr = __builtin_amdgcn_permlane32_swap(__float_as_uint(ps), __float_as_uint(ps), false, false);
        ps = __uint_as_float(rr[0]) + __uint_as_float(rr[1]); }
      l_reg = l_reg * alpha + ps;
      if (hi == 0) al_l[r32] = alpha; asm volatile("s_waitcnt lgkmcnt(0)" ::: "memory");
#pragma unroll
      for (int d = 0; d < 4; ++d)
#pragma unroll
        for (int rr = 0; rr < 16; ++rr) o[d][rr] *= al_l[crow(rr, hi)];
      bf16x8 pa0, pa1, pa2, pa3;
      ATT_PK4(p0, 0, pa0); ATT_PK4(p0, 8, pa1); ATT_PK4(p1, 0, pa2); ATT_PK4(p1, 8, pa3);
      SBAR(); pv_d0(o, vb0, pa0, pa1, pa2, pa3);
    }
  }
  if (hi == 0) li_l[r32] = l_reg; asm volatile("s_waitcnt lgkmcnt(0)" ::: "memory");
  float rli[16];
#pragma unroll
  for (int rr = 0; rr < 16; ++rr) rli[rr] = __builtin_amdgcn_rcpf(li_l[crow(rr, hi)]);
  AGAS bf16* out_l = out; asm volatile("" : "+s"(out_l));
  AGAS bf16* Ow = out_l + (row0 + (long)r * 64 + (wid & 1) * 32) * LDO + 1024 + h * 128 + r32;
#pragma unroll
  for (int rr = 0; rr < 16; ++rr) { AGAS bf16* ob = Ow; asm volatile("" : "+v"(ob)); AGAS bf16* op = ob + (long)crow(rr, hi) * LDO;
#pragma unroll
    for (int d0 = 0; d0 < 4; ++d0) op[d0 * 32] = f2bf1(o[d0][rr] * rli[rr]); }
}
#undef SBAR
}

#define GAS __attribute__((address_space(1)))
#define LAS __attribute__((address_space(3)))
typedef unsigned short bf16;
typedef unsigned v4u __attribute__((ext_vector_type(4)));
typedef float f32x4 __attribute__((ext_vector_type(4)));
typedef short bf16x8 __attribute__((ext_vector_type(8)));
typedef GAS unsigned gu32;
typedef GAS unsigned long long gu64;
#define RLX_AGENT __ATOMIC_RELAXED, __HIP_MEMORY_SCOPE_AGENT
#define LDS_WAIT() asm volatile("s_waitcnt lgkmcnt(0)" ::: "memory")
#define VM_WAIT() asm volatile("s_waitcnt vmcnt(0)" ::: "memory")
__device__ __forceinline__ unsigned long long rt() { return __builtin_amdgcn_s_memrealtime(); }
__device__ __forceinline__ unsigned f2bf(float f) { unsigned u = __builtin_bit_cast(unsigned, f); return (u + 0x7fffu + ((u >> 16) & 1u)) >> 16; }
__device__ __forceinline__ unsigned pk2(float lo, float hi) { return f2bf(lo) | (f2bf(hi) << 16); }
#define XB_TMO      128
#define XB_XCNT(j)  (256  + 64 * (j))
#define XB_XSUB(j)  (1280 + 64 * (j))
#define XB_XGEN(j)  (2304 + 64 * (j))
#define XB_TOP      3328
#define XB_TOPGEN   3392
#define XCD_BAR_WORDS 3456
#define XB_SPIN_CAP (1u << 18)

__device__ __forceinline__ unsigned xb_ld(unsigned* p)              { return __hip_atomic_load(p, __ATOMIC_RELAXED, __HIP_MEMORY_SCOPE_AGENT); }
__device__ __forceinline__ unsigned xb_add(unsigned* p, unsigned v) { return __hip_atomic_fetch_add(p, v, __ATOMIC_RELAXED, __HIP_MEMORY_SCOPE_AGENT); }
__device__ __forceinline__ unsigned xb_xcc_id() { return (unsigned)__builtin_amdgcn_s_getreg((3 << 11) | 20) & 0xFu; }
#define XB_SPIN(cond, bar) do { unsigned _sp = 0; while (cond) { __builtin_amdgcn_s_sleep(1); \
    if ((++_sp & 255u) == 0u) { if (xb_ld(&(bar)[XB_TMO])) break; if (_sp > XB_SPIN_CAP) { atomicAdd(&(bar)[XB_TMO], 1u); break; } } } } while (0)

struct XcdBarrier {
    unsigned* bar; unsigned x;
    volatile LAS unsigned* st;
};

__device__ __forceinline__ XcdBarrier xcd_barrier_post(unsigned* bar, volatile LAS unsigned* st) {
    XcdBarrier b; b.bar = bar; b.x = xb_xcc_id(); b.st = st;
    if (threadIdx.x == 0) (void)xb_add(&bar[XB_XCNT(b.x)], 1u);
    return b;
}
__device__ __forceinline__ void xcd_barrier_complete(unsigned* bar, unsigned x, unsigned& nloc, unsigned& nx) {
    const unsigned G = gridDim.x * gridDim.y * gridDim.z;
    unsigned sum, cnt, mine, sp = 0u;
    for (;;) {
        sum = 0u; cnt = 0u; mine = 0u;
#pragma unroll
        for (unsigned j = 0; j < 16; ++j) { const unsigned c = xb_ld(&bar[XB_XCNT(j)]); sum += c; cnt += (c > 0u) ? 1u : 0u; mine = (j == x) ? c : mine; }
        if (sum == G) break;
        __builtin_amdgcn_s_sleep(1);
        if ((++sp & 255u) == 0u) { if (xb_ld(&bar[XB_TMO])) break; if (sp > XB_SPIN_CAP) { atomicAdd(&bar[XB_TMO], 1u); break; } }
    }
    nloc = mine > 0u ? mine : 1u; nx = cnt > 0u ? cnt : 1u;
}

__device__ __forceinline__ void xcd_barrier(const XcdBarrier& b) {
    asm volatile("s_waitcnt vmcnt(0)" ::: "memory");
    __syncthreads();
    unsigned bx_ = b.x; asm volatile("" : "+s"(bx_));
    if (threadIdx.x == 0) {
        unsigned* bar = b.bar; asm volatile("" : "+s"(bar));
        __builtin_amdgcn_s_waitcnt(0);
        unsigned nloc = b.st[0], nx = b.st[1];
        if (nloc == 0u) { xcd_barrier_complete(bar, bx_, nloc, nx); b.st[0] = nloc; b.st[1] = nx; }
        const unsigned old = xb_add(&bar[XB_XSUB(bx_)], 1u);
        const unsigned gen = old / nloc;
        if (old + 1u == (gen + 1u) * nloc) {
            __builtin_amdgcn_fence(__ATOMIC_RELEASE, "agent");
            asm volatile("s_waitcnt vmcnt(0)" ::: "memory");
            const unsigned og = xb_add(&bar[XB_TOP], 1u);
            const unsigned tg = og / nx;
            if (og + 1u == (tg + 1u) * nx) xb_add(&bar[XB_TOPGEN], 1u);
            else XB_SPIN(xb_ld(&bar[XB_TOPGEN]) == tg, bar);
            __builtin_amdgcn_fence(__ATOMIC_ACQUIRE, "agent");
            xb_add(&bar[XB_XGEN(bx_)], 1u);
            asm volatile("s_waitcnt vmcnt(0)" ::: "memory");
        } else {
            XB_SPIN(xb_ld(&bar[XB_XGEN(bx_)]) == gen, bar);
            __builtin_amdgcn_fence(__ATOMIC_ACQUIRE, "agent");
            asm volatile("s_waitcnt vmcnt(0)" ::: "memory");
        }
    }
    __syncthreads();
}
constexpr int NWAVES = 8;
constexpr int DM = 2048, DFF = 5632, NGU = 2 * DFF, NIN = 6144, NLAYER = 2;
constexpr int MP = 8 * 4096, MS = 2 * 16384, M = MP + MS;
constexpr int NB = 10, MODW = 9 * DM;
constexpr float LN_EPS = 1e-5f;
constexpr float DN_ALPHA = 1.4142135623730951f;

constexpr size_t MiB = 1u << 20;
constexpr size_t WS_CTL = 0, CTL_ZERO_BYTES = 1 * MiB;
constexpr size_t WS_MODV = 1 * MiB;
constexpr size_t WS_ROPE = 3 * MiB;
constexpr size_t WS_MISC = 7 * MiB;
constexpr size_t WS_W = 8 * MiB;
constexpr size_t WO_GU1 = 0, WO_D1 = 44 * MiB, WO_IN = 66 * MiB, WO_OUT = 90 * MiB, WO_GU2 = 98 * MiB, WO_D2 = 142 * MiB, W_BYTES = 164 * MiB;
constexpr size_t WS_HA = WS_W + W_BYTES;
constexpr size_t WS_HB = WS_HA + 256 * MiB;
constexpr size_t WS_BIG = WS_HB + 256 * MiB;
constexpr size_t WS_END = WS_BIG + 768 * MiB;
static_assert((size_t)NGU * DM * 2 == 44 * MiB && (size_t)DM * DFF * 2 == 22 * MiB && (size_t)NIN * DM * 2 == 24 * MiB && (size_t)DM * DM * 2 == 8 * MiB, "weight map");
static_assert((size_t)M * NIN * 2 == 768 * MiB && (size_t)M * DM * 2 == 256 * MiB, "activation map");
constexpr int CW_BAR = 4096;

constexpr int RING_OFF = 0, RING_BYTES = 131072;
constexpr int LDSCTL_OFF = RING_BYTES, MISC_OFF = LDSCTL_OFF + 320;
constexpr int LDS_BYTES = 147456;

__device__ __forceinline__ float wave_sum(float v) {
#pragma unroll
    for (int o = 1; o < 64; o <<= 1) v += __shfl_xor(v, o);
    return v;
}
template <int MODE> __device__ __forceinline__ int dest_row(int s) {
    if (MODE == 1) { const int half = s >= DFF ? 1 : 0; const int j = s - half * DFF; return 256 * (j >> 7) + 128 * half + (j & 127); }
    if (MODE == 2) { if (s < 2048) { const int d = s & 63; const int p = d < 32 ? 2 * d : 2 * (d - 32) + 1; return (s & ~63) + p; } return s; }
    return s;
}
template <int MODE> __device__ __forceinline__ void transpose_item(const float* W, int K, int N, bf16* WT, LAS float* scr, int item, int lane) {
    const int nblk = N / 32, kb = item / nblk, nb = item % nblk, k0 = 64 * kb, n0 = 32 * nb;
#pragma unroll 8
    for (int i = 0; i < 32; ++i) { const int kk = 2 * i + (lane >> 5); scr[kk * 33 + (lane & 31)] = W[(size_t)(k0 + kk) * N + n0 + (lane & 31)]; }
    LDS_WAIT(); asm volatile("" ::: "memory");
    const int c = lane & 7;
#pragma unroll
    for (int j = 0; j < 4; ++j) { const int n = (lane >> 3) + 8 * j; const LAS float* s = scr + (8 * c) * 33 + n;
        v4u o; o.x = pk2(s[0 * 33], s[1 * 33]); o.y = pk2(s[2 * 33], s[3 * 33]); o.z = pk2(s[4 * 33], s[5 * 33]); o.w = pk2(s[6 * 33], s[7 * 33]);
        *(GAS v4u*)(WT + (size_t)dest_row<MODE>(n0 + n) * K + k0 + 8 * c) = o; }
    LDS_WAIT(); asm volatile("" ::: "memory");
}
struct Args { const GAS float* in[20]; GAS float* out; GAS unsigned char* ws; };

typedef const __attribute__((address_space(4))) Args* KArgsT;
__device__ __forceinline__ void convert_layer(KArgsT a, int l, unsigned char* wsw, LAS float* scr, int gw, int NGW, int lane) {
    constexpr int I_GU = (DM / 64) * (NGU / 32), I_D = (DFF / 64) * (DM / 32), I_IN = (DM / 64) * (NIN / 32), I_O = (DM / 64) * (DM / 32);
    constexpr int NITEMS = 2 * I_GU + 2 * I_D + I_IN + I_O;
    asm volatile("" : "+v"(lane));
    for (int it = gw; it < NITEMS; it += NGW) {
        int r = it;
        if (r < I_GU) { transpose_item<1>(((const float*)a->in[8]) + (size_t)l * DM * NGU, DM, NGU, (bf16*)(wsw + WO_GU1), scr, r, lane); continue; } r -= I_GU;
        if (r < I_D)  { transpose_item<0>(((const float*)a->in[9]) + (size_t)l * DFF * DM, DFF, DM, (bf16*)(wsw + WO_D1), scr, r, lane); continue; } r -= I_D;
        if (r < I_IN) { transpose_item<2>(((const float*)a->in[10]) + (size_t)l * DM * NIN, DM, NIN, (bf16*)(wsw + WO_IN), scr, r, lane); continue; } r -= I_IN;
        if (r < I_O)  { transpose_item<0>(((const float*)a->in[11]) + (size_t)l * DM * DM, DM, DM, (bf16*)(wsw + WO_OUT), scr, r, lane); continue; } r -= I_O;
        if (r < I_GU) { transpose_item<1>(((const float*)a->in[18]) + (size_t)l * DM * NGU, DM, NGU, (bf16*)(wsw + WO_GU2), scr, r, lane); continue; } r -= I_GU;
        transpose_item<0>(((const float*)a->in[19]) + (size_t)l * DFF * DM, DFF, DM, (bf16*)(wsw + WO_D2), scr, r, lane);
    }
}
__device__ __forceinline__ int batch_of_row(int m) { return m < MP ? (m >> 12) : 8 + ((m - MP) >> 14); }
__device__ __forceinline__ void mod_rows(const float* xp, const float* xs, bf16* hout, const float* modl, int sh_idx, int gw, int NGW, int lane) {
    asm volatile("" : "+v"(lane));
    for (int m = gw; m < M; m += NGW) {
        const float* xr = m < MP ? xp + (size_t)m * DM : xs + (size_t)(m - MP) * DM;
        const float* mb = modl + (size_t)batch_of_row(m) * MODW;
        GAS unsigned long long* o8 = (GAS unsigned long long*)(hout + (size_t)m * DM) + lane;
#pragma unroll
        for (int j = 0; j < 8; ++j) { const int col = 4 * lane + 256 * j;
            const f32x4 v = *(const GAS f32x4*)(xr + col), sh = *(const GAS f32x4*)(mb + sh_idx * DM + col), sc = *(const GAS f32x4*)(mb + (sh_idx + 1) * DM + col);
            const f32x4 hv = v * (sc + 1.0f) + sh;
            o8[64 * j] = (unsigned long long)pk2(hv.x, hv.y) | ((unsigned long long)pk2(hv.z, hv.w) << 32); }
    }
}
__device__ __forceinline__ void ln_rows(float* y, bf16* hout, const float* lng, const float* lnb, const float* modl, int sh_idx, int gw, int NGW, int lane) {
    asm volatile("" : "+v"(lane));
    for (int m = gw; m < M; m += NGW) {
        GAS f32x4* yr = (GAS f32x4*)(y + (size_t)m * DM) + lane;
        f32x4 v[8]; float s = 0.f;
#pragma unroll
        for (int j = 0; j < 8; ++j) { v[j] = yr[64 * j]; s += (v[j].x + v[j].y) + (v[j].z + v[j].w); }
        const float mean = wave_sum(s) * (1.f / DM); float s2 = 0.f;
#pragma unroll
        for (int j = 0; j < 8; ++j) { v[j] = v[j] - mean; s2 += (v[j].x * v[j].x + v[j].y * v[j].y) + (v[j].z * v[j].z + v[j].w * v[j].w); }
        const float rstd = 1.f / sqrtf(wave_sum(s2) * (1.f / DM) + LN_EPS);
        const float* mb = modl + (size_t)batch_of_row(m) * MODW;
        GAS unsigned long long* o8 = (GAS unsigned long long*)(hout + (size_t)m * DM) + lane;
#pragma unroll
        for (int j = 0; j < 8; ++j) { const int col = 4 * lane + 256 * j;
            const f32x4 g = *(const GAS f32x4*)(lng + col), b = *(const GAS f32x4*)(lnb + col);
            const f32x4 xv = v[j] * rstd * g + b;
            yr[64 * j] = xv;
            if (hout) { const f32x4 sh = *(const GAS f32x4*)(mb + sh_idx * DM + col), sc = *(const GAS f32x4*)(mb + (sh_idx + 1) * DM + col);
                const f32x4 hv = xv * (sc + 1.0f) + sh;
                o8[64 * j] = (unsigned long long)pk2(hv.x, hv.y) | ((unsigned long long)pk2(hv.z, hv.w) << 32); } }
    }
}
__device__ __forceinline__ void modv_phase(KArgsT a, float* modv, LAS unsigned char* lds, int G, int tid, int wave, int lane) {
    LAS float* sc = (LAS float*)lds;
    LAS float* red = (LAS float*)(lds + NB * DM * 4);
    constexpr int NCH = MODW / 128, NIT = NLAYER * NCH;
    if ((int)blockIdx.x >= NIT) return;
    for (int i = tid; i < NB * DM; i += NWAVES * 64) { const int b = i / DM, k = i % DM; const float cv = b < 8 ? ((const float*)a->in[2])[b * DM + k] : ((const float*)a->in[3])[(b - 8) * DM + k];
        sc[i] = cv / (1.0f + __expf(-cv)); }
    __syncthreads();
    for (int it = blockIdx.x; it < NIT; it += G) {
        const int l = it / NCH, ch = it % NCH;
        const float* wp = ((const float*)a->in[4]) + ((size_t)l * DM + wave * 256) * MODW + ch * 128 + 2 * lane;
        float ax[NB], ay[NB];
#pragma unroll
        for (int b = 0; b < NB; ++b) { ax[b] = 0.f; ay[b] = 0.f; }
        for (int k = 0; k < 256; k += 4) {
            typedef float f32x2v __attribute__((ext_vector_type(2)));
            const f32x2v w0 = *(const GAS f32x2v*)(wp + (size_t)(k + 0) * MODW), w1 = *(const GAS f32x2v*)(wp + (size_t)(k + 1) * MODW);
            const f32x2v w2 = *(const GAS f32x2v*)(wp + (size_t)(k + 2) * MODW), w3 = *(const GAS f32x2v*)(wp + (size_t)(k + 3) * MODW);
#pragma unroll
            for (int b = 0; b < NB; ++b) { const f32x4 s4 = *(const LAS f32x4*)(sc + b * DM + wave * 256 + k);
                ax[b] += s4.x * w0.x + s4.y * w1.x + s4.z * w2.x + s4.w * w3.x; ay[b] += s4.x * w0.y + s4.y * w1.y + s4.z * w2.y + s4.w * w3.y; }
        }
#pragma unroll
        for (int b = 0; b < NB; ++b) { red[(wave * NB + b) * 128 + 2 * lane] = ax[b]; red[(wave * NB + b) * 128 + 2 * lane + 1] = ay[b]; }
        __syncthreads();
        for (int o = tid; o < NB * 128; o += NWAVES * 64) { const int b = o / 128, cc = o % 128; float s = 0.f;
#pragma unroll
            for (int w = 0; w < NWAVES; ++w) s += red[(w * NB + b) * 128 + cc];
            modv[((size_t)l * NB + b) * MODW + ch * 128 + cc] = s + ((const float*)a->in[5])[(size_t)l * MODW + ch * 128 + cc]; }
        __syncthreads();
    }
}
__device__ const double ROPE_INVF[32] = {1.0,0.7498942093324559,0.5623413251903491,0.4216965034285822,0.31622776601683794,0.23713737056616552,0.1778279410038923,0.1333521432163324,0.1,0.07498942093324558,0.05623413251903491,0.042169650342858224,0.03162277660168379,0.023713737056616554,0.01778279410038923,0.01333521432163324,0.01,0.007498942093324558,0.005623413251903491,0.004216965034285823,0.0031622776601683794,0.0023713737056616554,0.0017782794100389228,0.001333521432163324,0.001,0.0007498942093324559,0.0005623413251903491,0.00042169650342858224,0.00031622776601683794,0.00023713737056616554,0.00017782794100389227,0.0001333521432163324};
__device__ __forceinline__ void rope_tables(float* ropeC, float* ropeS, int gtid, int nthr) {
    for (int idx = gtid; idx < 16384 * 32; idx += nthr) {
        const int t = idx >> 5, i = idx & 31; const double x = (double)t * ROPE_INVF[i];
        const double q = __builtin_rint(x * 0.63661977236758134308);
        double r = __builtin_fma(-q, 1.57079632679489655800e+00, x); r = __builtin_fma(-q, 6.12323399573676603587e-17, r);
        const double r2 = r * r;
        const double sp = r + r * r2 * (-1.0 / 6 + r2 * (1.0 / 120 + r2 * (-1.0 / 5040 + r2 * (1.0 / 362880 + r2 * (-1.0 / 39916800 + r2 * (1.0 / 6227020800.0))))));
        const double cp = 1.0 + r2 * (-0.5 + r2 * (1.0 / 24 + r2 * (-1.0 / 720 + r2 * (1.0 / 40320 + r2 * (-1.0 / 3628800 + r2 * (1.0 / 479001600.0 + r2 * (-1.0 / 87178291200.0)))))));
        const int qi = ((int)q) & 3;
        const double sv = qi == 0 ? sp : qi == 1 ? cp : qi == 2 ? -sp : -cp;
        const double cv = qi == 0 ? cp : qi == 1 ? -sp : qi == 2 ? -cp : sp;
        ropeC[idx] = (float)cv; ropeS[idx] = (float)sv;
    }
}

#ifndef PH
#define PH 0xFFFF
#endif
#define LAUNDER_S(p) asm volatile("" : "+s"(p))
typedef const __attribute__((address_space(4))) Args* KArgs;
__device__ __forceinline__ KArgs kargs() { KArgs p = (KArgs)__builtin_amdgcn_kernarg_segment_ptr(); LAUNDER_S(p); return p; }
constexpr float LAM_INIT0 = 0.2f, LAM_INIT1 = 0.35550906759096926f;

__global__ void __launch_bounds__(NWAVES * 64, 2) mega_fwd(Args args_unused) {
    extern __shared__ __attribute__((aligned(16))) unsigned char lds[];
    LAS unsigned char* L = (LAS unsigned char*)lds;
    volatile LAS unsigned* MISC = (volatile LAS unsigned*)(L + MISC_OFF);
    const int tid = threadIdx.x, lane = tid & 63, wave = __builtin_amdgcn_readfirstlane(tid >> 6);
    const int G = gridDim.x; const int bx = blockIdx.x; const int vcu = (G % 8 == 0) ? (bx % 8) * (G / 8) + bx / 8 : bx;
    const int gw = vcu * NWAVES + wave, NGW = G * NWAVES;
    for (int u = tid; u < (LDS_BYTES - LDSCTL_OFF) / 4; u += NWAVES * 64) ((LAS unsigned*)(L + LDSCTL_OFF))[u] = 0u;
    __syncthreads();
    XcdBarrier bar;
    { KArgs ap = kargs(); bar = xcd_barrier_post((unsigned*)(((unsigned char*)ap->ws) + WS_CTL) + CW_BAR, MISC + 8); }
#define GRID_BAR() xcd_barrier(bar)
    LAS float* scr = (LAS float*)(L + RING_OFF + wave * 16384);

    {
        KArgs ap = kargs(); unsigned char* ws = ((unsigned char*)ap->ws);
#if PH & 1
        modv_phase(ap, (float*)(ws + WS_MODV), L, G, tid, wave, lane);
        rope_tables((float*)(ws + WS_ROPE), (float*)(ws + WS_ROPE) + 16384 * 32, bx * (NWAVES * 64) + tid, G * NWAVES * 64);
#endif
        if (bx == 0 && wave == 0) {
            float* lamv = (float*)(ws + WS_MISC);
#pragma unroll
            for (int l = 0; l < NLAYER; ++l) {
                const float s1 = wave_sum(((const float*)ap->in[12])[l * 64 + lane] * ((const float*)ap->in[13])[l * 64 + lane]), s2 = wave_sum(((const float*)ap->in[14])[l * 64 + lane] * ((const float*)ap->in[15])[l * 64 + lane]);
                if (lane == 0) lamv[l] = expf(s1) - expf(s2) + (l == 0 ? LAM_INIT0 : LAM_INIT1);
            }
        }
        __syncthreads();
#if PH & 2
        convert_layer(ap, 0, ws + WS_W, scr, gw, NGW, lane);
#endif
    }
    GRID_BAR();
    {
        KArgs ap = kargs(); unsigned char* ws = ((unsigned char*)ap->ws);
#if PH & 4
        mod_rows(((const float*)ap->in[0]), ((const float*)ap->in[1]), (bf16*)(ws + WS_HA), (const float*)(ws + WS_MODV), 0, gw, NGW, lane);
#endif
    }
    GRID_BAR();

#pragma unroll 1
    for (int l = 0; l < NLAYER; ++l) {
        { KArgs ap = kargs(); unsigned char* ws = ((unsigned char*)ap->ws);
          pg8::Gemm g{(const bf16*)(ws + WS_HA), (const bf16*)(ws + WS_W + WO_GU1), M, NGU, DM}; pg8::StaticOrder S; { int g_ = G, c_ = bx; LAUNDER_S(g_); LAUNDER_S(c_); S.init(M, NGU, g_, c_); }
          pg8::EpiSwiGLU E{(bf16*)(ws + WS_BIG), DFF};
#if PH & 8
          pg8::gemm_phase<pg8::EpiSwiGLU, pg8::StaticOrder, true, true>(L + RING_OFF, g, S, E);
#endif
        }
        GRID_BAR();
        { KArgs ap = kargs(); unsigned char* ws = ((unsigned char*)ap->ws); float* out = ((float*)ap->out);
          const float* xsrc_p = l == 0 ? ((const float*)ap->in[0]) : out; const float* xsrc_s = l == 0 ? ((const float*)ap->in[1]) : out + (size_t)MP * DM;
          pg8::Gemm g{(const bf16*)(ws + WS_BIG), (const bf16*)(ws + WS_W + WO_D1), M, DM, DFF}; pg8::StaticOrder S; { int g_ = G, c_ = bx; LAUNDER_S(g_); LAUNDER_S(c_); S.init(M, DM, g_, c_); }
          pg8::EpiResid E{xsrc_p, xsrc_s, out, DM, (const float*)(ws + WS_MODV) + (size_t)l * NB * MODW + 2 * DM, 0.5f, DN_ALPHA};
#if PH & 16
          pg8::gemm_phase<pg8::EpiResid, pg8::StaticOrder, true, true>(L + RING_OFF, g, S, E);
#endif
        }
        GRID_BAR();
        { KArgs ap = kargs(); unsigned char* ws = ((unsigned char*)ap->ws);
#if PH & 4
          ln_rows(((float*)ap->out), (bf16*)(ws + WS_HB), ((const float*)ap->in[6]) + (size_t)l * 3 * DM, ((const float*)ap->in[7]) + (size_t)l * 3 * DM, (const float*)(ws + WS_MODV) + (size_t)l * NB * MODW, 3, gw, NGW, lane);
#endif
        }
        GRID_BAR();
        { KArgs ap = kargs(); unsigned char* ws = ((unsigned char*)ap->ws);
          pg8::Gemm g{(const bf16*)(ws + WS_HB), (const bf16*)(ws + WS_W + WO_IN), M, NIN, DM}; pg8::StaticOrder S; { int g_ = G, c_ = bx; LAUNDER_S(g_); LAUNDER_S(c_); S.init(M, NIN, g_, c_); }
          pg8::EpiRope E{(bf16*)(ws + WS_BIG), NIN, (const float*)(ws + WS_ROPE), (const float*)(ws + WS_ROPE) + 16384 * 32};
#if PH & 32
          pg8::gemm_phase<pg8::EpiRope, pg8::StaticOrder, true, true>(L + RING_OFF, g, S, E);
#endif
        }
        GRID_BAR();
        {
            KArgs ap = kargs(); unsigned char* ws = ((unsigned char*)ap->ws);
            const GAS bf16* BIG = (const GAS bf16*)(ap->ws + WS_BIG); GAS bf16* HA = (GAS bf16*)(ap->ws + WS_HA);
            const float lam = ((const float*)(ws + WS_MISC))[l]; const float gscale = 1.0f - (l == 0 ? LAM_INIT0 : LAM_INIT1);
            const GAS float* ng = ap->in[16] + l * 128; const GAS float* rpb = ap->in[17] + (size_t)l * 8 * 15 * 31;
            GAS float* stash = (GAS float*)(ap->ws + WS_HB) + (size_t)bx * 32768;
#pragma unroll 1
            for (int i = 0;; ++i) {
                const int u = i * G + vcu; if (u >= 4096) break;
                if (u < 2048) {
                    long row0; int T, h, q0;
                    if (u < 1024) { const int bh = u >> 6, qt = u & 63; row0 = MP + (long)(bh >> 3) * 16384; T = 16384; h = bh & 7; q0 = qt * 256; }
                    else { const int v = u - 1024, bh = v >> 4, qt = v & 15; row0 = (long)(bh >> 3) * 4096; T = 4096; h = bh & 7; q0 = qt * 256; }
#if PH & 64
                    att::diff_unit(BIG, row0, T, h, q0, lam, gscale, ng, HA, stash, (char*)lds);
#endif
                } else {
                    long row0; int rows, h, r0; int v = u - 2048;
                    if (v < 1024) { const int bh = v >> 4, rg = v & 15; row0 = (long)(bh >> 3) * 4096; rows = 64; h = bh & 7; r0 = rg * 4; }
                    else { v -= 1024; const int bh = v >> 6, rg = v & 63; row0 = MP + (long)(bh >> 3) * 16384; rows = 256; h = bh & 7; r0 = rg * 4; }
#if PH & 128
                    att::na_unit(BIG, row0, rows, h, r0, rpb + h * 15 * 31, HA, (char*)lds);
#endif
                }
            }
        }
        GRID_BAR();
        { KArgs ap = kargs(); unsigned char* ws = ((unsigned char*)ap->ws); float* out = ((float*)ap->out);
          pg8::Gemm g{(const bf16*)(ws + WS_HA), (const bf16*)(ws + WS_W + WO_OUT), M, DM, DM}; pg8::StaticOrder S; { int g_ = G, c_ = bx; LAUNDER_S(g_); LAUNDER_S(c_); S.init(M, DM, g_, c_); }
          pg8::EpiResid E{out, out + (size_t)MP * DM, out, DM, (const float*)(ws + WS_MODV) + (size_t)l * NB * MODW + 5 * DM, 1.0f, DN_ALPHA};
#if PH & 16
          pg8::gemm_phase<pg8::EpiResid, pg8::StaticOrder, true, true>(L + RING_OFF, g, S, E);
#endif
        }
        GRID_BAR();
        { KArgs ap = kargs(); unsigned char* ws = ((unsigned char*)ap->ws);
#if PH & 4
          ln_rows(((float*)ap->out), (bf16*)(ws + WS_HB), ((const float*)ap->in[6]) + (size_t)l * 3 * DM + DM, ((const float*)ap->in[7]) + (size_t)l * 3 * DM + DM, (const float*)(ws + WS_MODV) + (size_t)l * NB * MODW, 6, gw, NGW, lane);
#endif
        }
        GRID_BAR();
        { KArgs ap = kargs(); unsigned char* ws = ((unsigned char*)ap->ws);
          pg8::Gemm g{(const bf16*)(ws + WS_HB), (const bf16*)(ws + WS_W + WO_GU2), M, NGU, DM}; pg8::StaticOrder S; { int g_ = G, c_ = bx; LAUNDER_S(g_); LAUNDER_S(c_); S.init(M, NGU, g_, c_); }
          pg8::EpiSwiGLU E{(bf16*)(ws + WS_BIG), DFF};
#if PH & 8
          pg8::gemm_phase<pg8::EpiSwiGLU, pg8::StaticOrder, true, true>(L + RING_OFF, g, S, E);
#endif
        }
        GRID_BAR();
        { KArgs ap = kargs(); unsigned char* ws = ((unsigned char*)ap->ws); float* out = ((float*)ap->out);
          pg8::Gemm g{(const bf16*)(ws + WS_BIG), (const bf16*)(ws + WS_W + WO_D2), M, DM, DFF}; pg8::StaticOrder S; { int g_ = G, c_ = bx; LAUNDER_S(g_); LAUNDER_S(c_); S.init(M, DM, g_, c_); }
          pg8::EpiResid E{out, out + (size_t)MP * DM, out, DM, (const float*)(ws + WS_MODV) + (size_t)l * NB * MODW + 8 * DM, 0.5f, DN_ALPHA};
#if PH & 16
          pg8::gemm_phase<pg8::EpiResid, pg8::StaticOrder, true, true>(L + RING_OFF, g, S, E);
#endif
        }
        GRID_BAR();
        { KArgs ap = kargs(); unsigned char* ws = ((unsigned char*)ap->ws);
          const float* lng = ((const float*)ap->in[6]) + (size_t)l * 3 * DM + 2 * DM; const float* lnb = ((const float*)ap->in[7]) + (size_t)l * 3 * DM + 2 * DM;
          if (l + 1 < NLAYER) {
#if PH & 4
            ln_rows(((float*)ap->out), (bf16*)(ws + WS_HA), lng, lnb, (const float*)(ws + WS_MODV) + (size_t)(l + 1) * NB * MODW, 0, gw, NGW, lane);
#endif
#if PH & 2
            convert_layer(ap, l + 1, ws + WS_W, scr, gw, NGW, lane);
#endif
          } else {
#if PH & 4
            ln_rows(((float*)ap->out), nullptr, lng, lnb, (const float*)(ws + WS_MODV), 0, gw, NGW, lane);
#endif
          }
        }
        if (l + 1 < NLAYER) GRID_BAR();
    }
#undef GRID_BAR
}

extern "C" void kernel_launch(void* const* d_in, const int* in_sizes, int n_in, void* d_out, int out_size, void* d_ws, size_t ws_size, hipStream_t stream) {
    static int grid = 0;
    if (grid == 0) {
        if (n_in != 20 || out_size != M * DM || ws_size < WS_END) { fprintf(stderr, "kernel_launch: unexpected shapes: n_in %d out %d ws %zu (need %zu)\n", n_in, out_size, ws_size, (size_t)WS_END); grid = -1; return; }
        int dev = 0, cus = 0, per_cu = 0;
        if (hipGetDevice(&dev) != hipSuccess || hipDeviceGetAttribute(&cus, hipDeviceAttributeMultiprocessorCount, dev) != hipSuccess) { grid = -1; return; }
        if (hipFuncSetAttribute((const void*)mega_fwd, hipFuncAttributeMaxDynamicSharedMemorySize, LDS_BYTES) != hipSuccess) { fprintf(stderr, "kernel_launch: hipFuncSetAttribute failed\n"); grid = -1; return; }
        if (hipOccupancyMaxActiveBlocksPerMultiprocessor(&per_cu, (const void*)mega_fwd, NWAVES * 64, LDS_BYTES) != hipSuccess || per_cu < 1)
            fprintf(stderr, "kernel_launch: note: occupancy query reports %d workgroups per CU\n", per_cu);
        (void)hipGetLastError();
        grid = cus;
    }
    if (grid < 0) return;
    if (hipMemsetAsync((char*)d_ws + WS_CTL, 0, CTL_ZERO_BYTES, stream) != hipSuccess) return;
    Args a{};
    for (int i = 0; i < 20; ++i) a.in[i] = (const GAS float*)d_in[i];
    a.out = (GAS float*)d_out; a.ws = (GAS unsigned char*)d_ws;
    hipLaunchKernelGGL(mega_fwd, dim3(grid), dim3(NWAVES * 64), LDS_BYTES, stream, a);
    const hipError_t le = hipPeekAtLastError();
    if (le != hipSuccess) fprintf(stderr, "kernel_launch: launch failed: %s\n", hipGetErrorName(le));
}
```

```cpp
#include <hip/hip_runtime.h>
#include <cstdio>
#include <cstdint>
namespace pg8 {
#define PG8_LAS __attribute__((address_space(3)))
typedef unsigned short bf16_t;
typedef short bf16x8 __attribute__((ext_vector_type(8)));
typedef float f32x4 __attribute__((ext_vector_type(4)));
typedef unsigned u32x4 __attribute__((ext_vector_type(4)));
constexpr int BM = 256, BK = 64, HALF = 128, HTB = HALF * BK * 2  , STAGE_BYTES = 8 * HTB, NXCD = 8, WGM = 8;

__host__ __device__ __forceinline__ int lds_byte(int r, int c) { const int st = (r >> 4) * 2 + (c >> 5), rr = r & 15, cc = c & 31, ob = rr * 64 + cc * 2; return st * 1024 + (ob ^ (((ob >> 9) & 1) << 5)); }
__host__ __device__ __forceinline__ void stage_rc(int b, int& R, int& C) { const int st = b / 1024, sb = b % 1024, swz = sb ^ (((sb >> 9) & 1) << 5); R = (st >> 1) * 16 + swz / 64; C = (st & 1) * 32 + (swz % 64) / 2; }
__host__ __device__ __forceinline__ int perm32(int rho) { const int n = rho >> 4, i = rho & 15; return 8 * (i >> 2) + 4 * n + (i & 3); }

struct Unit { int pm, pn; };
struct Gemm { const bf16_t* A; const bf16_t* Bt; int M, N, K; };

struct StaticOrder {
    int nM, nN, nwg, G, c;
    __host__ __device__ void init(int M, int N, int G_, int c_) { nM = M / BM; nN = N / BM; nwg = nM * nN; G = G_; c = c_; }
    __host__ __device__ bool next(int i, Unit& u) const {
        const long L = (long)i * G + c; if (L >= nwg) return false;
        int wgid = (int)L; { const int q = nwg / NXCD, r = nwg % NXCD, xcd = wgid % NXCD, off = wgid / NXCD; wgid = (xcd < r ? xcd * (q + 1) : r * (q + 1) + (xcd - r) * q) + off; }
        const int nig = WGM * nN, gid = wgid / nig, fm = gid * WGM, gsz = (nM - fm) < WGM ? (nM - fm) : WGM;
        u.pm = fm + ((wgid % nig) % gsz); u.pn = (wgid % nig) / gsz; return true;
    }
    __device__ __forceinline__ void a_ready(const Unit&) const {}
    __device__ __forceinline__ void done(const Unit&) const {}
};

__device__ __forceinline__ unsigned cvt_pk_bf16(float lo, float hi) { unsigned r; asm volatile("v_cvt_pk_bf16_f32 %0, %1, %2" : "=v"(r) : "v"(lo), "v"(hi)); return r; }
typedef float f32x2 __attribute__((ext_vector_type(2)));
template <int WG> struct StaticOrderG {
    int nM, nN, nwg, G, c;
    __host__ __device__ void init(int M, int N, int G_, int c_) { nM = M / BM; nN = N / BM; nwg = nM * nN; G = G_; c = c_; }
    __host__ __device__ bool next(int i, Unit& u) const {
        const long L = (long)i * G + c; if (L >= nwg) return false;
        int wgid = (int)L; { const int q = nwg / NXCD, r = nwg % NXCD, xcd = wgid % NXCD, off = wgid / NXCD; wgid = (xcd < r ? xcd * (q + 1) : r * (q + 1) + (xcd - r) * q) + off; }
        const int nig = WG * nN, gid = wgid / nig, fm = gid * WG, gsz = (nM - fm) < WG ? (nM - fm) : WG;
        u.pm = fm + ((wgid % nig) % gsz); u.pn = (wgid % nig) / gsz; return true;
    }
    __device__ __forceinline__ void a_ready(const Unit&) const {}
    __device__ __forceinline__ void done(const Unit&) const {}
};
__device__ __forceinline__ float silu_f(float g) { return g * __builtin_amdgcn_rcpf(1.0f + __builtin_amdgcn_exp2f(-1.4426950408889634f * g)); }
struct EpiSwiGLU {
    static constexpr bool PERM = true, AFTER_DRAIN = false;
    bf16_t* O; int ldc;
    __device__ __forceinline__ void operator()(const f32x4 (&acc)[2][2][4][2], const Unit& u, int wr, int wc, int fr, int fq) const {
        const int row0 = u.pm * BM + wr * 64 + fr, col0 = u.pn * HALF + wc * 32 + 8 * fq;
#pragma unroll
        for (int ai = 0; ai < 2; ++ai)
#pragma unroll
            for (int m = 0; m < 4; ++m) { bf16_t* rowp = O + (size_t)(row0 + ai * HALF + m * 16) * ldc + col0;
                const f32x4 g0 = acc[ai][0][m][0], g1 = acc[ai][0][m][1], u0 = acc[ai][1][m][0], u1 = acc[ai][1][m][1];
                u32x4 w;
                w.x = cvt_pk_bf16(silu_f(g0[0]) * u0[0], silu_f(g0[1]) * u0[1]); w.y = cvt_pk_bf16(silu_f(g0[2]) * u0[2], silu_f(g0[3]) * u0[3]);
                w.z = cvt_pk_bf16(silu_f(g1[0]) * u1[0], silu_f(g1[1]) * u1[1]); w.w = cvt_pk_bf16(silu_f(g1[2]) * u1[2], silu_f(g1[3]) * u1[3]);
                *(u32x4*)rowp = w; }
    }
};
struct EpiResid {
    static constexpr bool PERM = false, AFTER_DRAIN = false;
    const float* xp; const float* xs;
    float* y; int ldc; const float* gate;
    float coef, alpha;
    __device__ __forceinline__ void operator()(const f32x4 (&acc)[2][2][4][2], const Unit& u, int wr, int wc, int fr, int fq) const {
        const int trow = u.pm * BM; const bool samp = trow >= 32768;
        const int bidx = samp ? 8 + ((trow - 32768) >> 14) : (trow >> 12);
        const float* xb = samp ? xs + (size_t)(trow - 32768) * ldc : xp + (size_t)trow * ldc;
        float* yb = y + (size_t)trow * ldc;
        const int col0 = u.pn * BM + wc * 32 + 4 * fq;
        const float* gp = gate + (size_t)bidx * 18432 + col0;
        f32x4 gv[2][2];
#pragma unroll
        for (int bj = 0; bj < 2; ++bj)
#pragma unroll
            for (int n = 0; n < 2; ++n) gv[bj][n] = (*(const f32x4*)(gp + bj * HALF + n * 16) + 1.0f) * coef;
#pragma unroll
        for (int ai = 0; ai < 2; ++ai) {
            f32x4 xv[4][2][2];
#pragma unroll
            for (int m = 0; m < 4; ++m) { const size_t off = (size_t)(ai * HALF + wr * 64 + m * 16 + fr) * ldc + col0;
#pragma unroll
                for (int bj = 0; bj < 2; ++bj)
#pragma unroll
                    for (int n = 0; n < 2; ++n) xv[m][bj][n] = *(const f32x4*)(xb + off + bj * HALF + n * 16); }
#pragma unroll
            for (int m = 0; m < 4; ++m) { const size_t off = (size_t)(ai * HALF + wr * 64 + m * 16 + fr) * ldc + col0;
#pragma unroll
                for (int bj = 0; bj < 2; ++bj)
#pragma unroll
                    for (int n = 0; n < 2; ++n) { const f32x4 o = xv[m][bj][n] * alpha + gv[bj][n] * acc[ai][bj][m][n]; *(f32x4*)(yb + off + bj * HALF + n * 16) = o; } }
            asm volatile("" ::: "memory");
        }
    }
};
struct EpiRope {
    static constexpr bool PERM = true, AFTER_DRAIN = false;
    bf16_t* O; int ldc; const float* ropeC; const float* ropeS;
    __device__ __forceinline__ void operator()(const f32x4 (&acc)[2][2][4][2], const Unit& u, int wr, int wc, int fr, int fq) const {
        const int row0 = u.pm * BM + wr * 64 + fr, col0 = u.pn * BM + wc * 32 + 8 * fq;
        const bool rot = u.pn < 8; const int i0 = (wc & 1) * 16 + 4 * fq;
        f32x4 cs[2][4], sn[2][4];
#pragma unroll
        for (int ai = 0; ai < 2; ++ai)
#pragma unroll
            for (int m = 0; m < 4; ++m) { const int row = row0 + ai * HALF + m * 16; const int t = row < 32768 ? (row & 4095) : (row & 16383);
                cs[ai][m] = (f32x4){1.f, 1.f, 1.f, 1.f}; sn[ai][m] = (f32x4){0.f, 0.f, 0.f, 0.f};
                if (rot) { cs[ai][m] = *(const f32x4*)(ropeC + (size_t)t * 32 + i0); sn[ai][m] = *(const f32x4*)(ropeS + (size_t)t * 32 + i0); } }
#pragma unroll
        for (int ai = 0; ai < 2; ++ai)
#pragma unroll
            for (int m = 0; m < 4; ++m) { const int row = row0 + ai * HALF + m * 16;
                const f32x4 c4 = cs[ai][m], s4 = sn[ai][m];
                bf16_t* rowp = O + (size_t)row * ldc + col0;
#pragma unroll
                for (int bj = 0; bj < 2; ++bj) { const f32x4 v0 = acc[ai][bj][m][0], v1 = acc[ai][bj][m][1];
                    const float a0 = v0[0] * c4[0] - v0[1] * s4[0], b0 = v0[1] * c4[0] + v0[0] * s4[0];
                    const float a1 = v0[2] * c4[1] - v0[3] * s4[1], b1 = v0[3] * c4[1] + v0[2] * s4[1];
                    const float a2 = v1[0] * c4[2] - v1[1] * s4[2], b2 = v1[1] * c4[2] + v1[0] * s4[2];
                    const float a3 = v1[2] * c4[3] - v1[3] * s4[3], b3 = v1[3] * c4[3] + v1[2] * s4[3];
                    u32x4 w; w.x = cvt_pk_bf16(a0, b0); w.y = cvt_pk_bf16(a1, b1); w.z = cvt_pk_bf16(a2, b2); w.w = cvt_pk_bf16(a3, b3);
                    *(u32x4*)(rowp + bj * HALF) = w; } }
    }
};

template <class Epi, class Sched, bool ALIGN_EPI = false, bool SP2 = false>
__device__ __forceinline__ void gemm_phase(PG8_LAS unsigned char* lds, const Gemm g, const Sched& S, const Epi& E) {
    int tid_ = threadIdx.x; asm volatile("" : "+v"(tid_));
    const int tid = tid_, wid = __builtin_amdgcn_readfirstlane(tid >> 6), lane = tid & 63, wr = wid >> 2, wc = wid & 3, fr = lane & 15, fq = lane >> 4;
    const int K = g.K, nt = K / BK;
    unsigned voffA[2], voffB[2];
#pragma unroll
    for (int i = 0; i < 2; ++i) { int R, C; stage_rc(tid * 16 + i * 8192, R, C); const int Rb = Epi::PERM ? ((R & ~31) + perm32(R & 31)) : R;
        voffA[i] = (unsigned)(R * K + C) * 2u; voffB[i] = (unsigned)(Rb * K + C) * 2u; }
    const size_t kstep = (size_t)(BK * 2);
    const size_t hstep = (size_t)HALF * K * 2;
    const size_t tstep = 2 * hstep;
    const unsigned ldsw = (unsigned)wid * 1024u;
    const int aoff = lds_byte(wr * 64 + fr, fq * 8), boff = lds_byte(wc * 32 + fr, fq * 8);
#define PG8_SA(b, h) (((b) * 2 + (h)) * HTB)
#define PG8_SB(b, h) ((4 + (b) * 2 + (h)) * HTB)
#define PG8_STAGE(bufoff, gbase, voff) do { _Pragma("unroll") for (int _i = 0; _i < 2; ++_i) \
        __builtin_amdgcn_global_load_lds((const unsigned*)((const char*)(gbase) + (voff)[_i]), (PG8_LAS unsigned*)(lds + (bufoff) + ldsw + _i * 8192), 16, 0, 0); } while (0)
#define PG8_LDA(dst, b, h) do { _Pragma("unroll") for (int m = 0; m < 4; ++m) _Pragma("unroll") for (int k = 0; k < 2; ++k) dst[m][k] = *(const PG8_LAS bf16x8*)(lds + PG8_SA(b, h) + aoff + m * 2048 + k * 1024); } while (0)
#define PG8_LDB(dst, b, h) do { _Pragma("unroll") for (int n = 0; n < 2; ++n) _Pragma("unroll") for (int k = 0; k < 2; ++k) dst[n][k] = *(const PG8_LAS bf16x8*)(lds + PG8_SB(b, h) + boff + n * 2048 + k * 1024); } while (0)
#define PG8_MMA(ai, bj, At, Bt) do { __builtin_amdgcn_s_setprio(1); _Pragma("unroll") for (int m = 0; m < 4; ++m) _Pragma("unroll") for (int n = 0; n < 2; ++n) _Pragma("unroll") for (int k = 0; k < 2; ++k) \
        acc[ai][bj][m][n] = __builtin_amdgcn_mfma_f32_16x16x32_bf16(Bt[n][k], At[m][k], acc[ai][bj][m][n], 0, 0, 0); __builtin_amdgcn_s_setprio(0); } while (0)
#define PG8_WAIT_V(n) asm volatile("s_waitcnt vmcnt(" #n ")" ::: "memory")
#define PG8_WAIT_L(n) asm volatile("s_waitcnt lgkmcnt(" #n ")" ::: "memory")
#define PG8_BAR __builtin_amdgcn_s_barrier()
#define PG8_SCHED __builtin_amdgcn_sched_barrier(0)
    Unit cur, nxt; int ui = 0;
    if (!S.next(0, cur)) return;
    f32x4 acc[2][2][4][2];
#pragma unroll
    for (int a = 0; a < 2; ++a)
#pragma unroll
        for (int b = 0; b < 2; ++b)
#pragma unroll
            for (int m = 0; m < 4; ++m)
#pragma unroll
                for (int n = 0; n < 2; ++n) acc[a][b][m][n] = (f32x4){0.f, 0.f, 0.f, 0.f};
    bf16x8 At[4][2], B0[2][2], B1[2][2];
    const char* cA = (const char*)g.A + (size_t)cur.pm * tstep; const char* cB = (const char*)g.Bt + (size_t)cur.pn * tstep;
    S.a_ready(cur);
    if constexpr (SP2) {
        PG8_STAGE(PG8_SB(0, 0), cB, voffB); PG8_STAGE(PG8_SB(0, 1), cB + hstep, voffB); PG8_STAGE(PG8_SA(0, 0), cA, voffA); PG8_STAGE(PG8_SA(0, 1), cA + hstep, voffA);
        if (wr == 1) PG8_BAR;
        PG8_WAIT_V(2); PG8_BAR;
        PG8_STAGE(PG8_SB(1, 0), cB + kstep, voffB); PG8_STAGE(PG8_SA(1, 0), cA + kstep, voffA); PG8_STAGE(PG8_SB(1, 1), cB + hstep + kstep, voffB);
        PG8_WAIT_V(6); PG8_BAR;
    } else {
        PG8_STAGE(PG8_SB(0, 0), cB, voffB); PG8_STAGE(PG8_SA(0, 0), cA, voffA); PG8_STAGE(PG8_SB(0, 1), cB + hstep, voffB); PG8_STAGE(PG8_SA(0, 1), cA + hstep, voffA);
        if (wr == 1) PG8_BAR;
        PG8_WAIT_V(4); PG8_BAR;
        PG8_STAGE(PG8_SB(1, 0), cB + kstep, voffB); PG8_STAGE(PG8_SA(1, 0), cA + kstep, voffA); PG8_STAGE(PG8_SB(1, 1), cB + hstep + kstep, voffB);
        PG8_WAIT_V(6); PG8_BAR;
    }
    for (;;) {
        const bool has_next = S.next(ui + 1, nxt);
        const char* nA = has_next ? (const char*)g.A + (size_t)nxt.pm * tstep : cA; const char* nB = has_next ? (const char*)g.Bt + (size_t)nxt.pn * tstep : cB;
        for (int t = 0; t < nt; t += 2) {
            const bool last = (t == nt - 2);
            const char* a1 = cA + (size_t)(t + 1) * kstep;
            const char* a2 = last ? nA : cA + (size_t)(t + 2) * kstep; const char* b2 = last ? nB : cB + (size_t)(t + 2) * kstep;
            const char* a3 = a2 + kstep; const char* b3 = b2 + kstep;
            if (last && has_next) S.a_ready(nxt);
            if constexpr (SP2) {
            PG8_LDB(B0, 0, 0); PG8_LDB(B1, 0, 1); PG8_SCHED; PG8_LDA(At, 0, 0); PG8_STAGE(PG8_SA(1, 1), a1 + hstep, voffA);
            PG8_WAIT_V(8); PG8_WAIT_L(0); PG8_BAR; PG8_MMA(0, 0, At, B0); PG8_MMA(0, 1, At, B1); PG8_BAR; PG8_SCHED;
            PG8_LDA(At, 0, 1); PG8_STAGE(PG8_SB(0, 0), b2, voffB); PG8_STAGE(PG8_SB(0, 1), b2 + hstep, voffB); PG8_STAGE(PG8_SA(0, 0), a2, voffA);
            PG8_WAIT_V(8); PG8_WAIT_L(0); PG8_BAR; PG8_MMA(1, 0, At, B0); PG8_MMA(1, 1, At, B1); PG8_BAR; PG8_SCHED;
            PG8_LDB(B0, 1, 0); PG8_LDB(B1, 1, 1); PG8_SCHED; PG8_LDA(At, 1, 0); PG8_STAGE(PG8_SA(0, 1), a2 + hstep, voffA);
            PG8_WAIT_V(8); PG8_WAIT_L(0); PG8_BAR; PG8_MMA(0, 0, At, B0); PG8_MMA(0, 1, At, B1); PG8_BAR; PG8_SCHED;
            PG8_LDA(At, 1, 1); PG8_STAGE(PG8_SB(1, 0), b3, voffB); PG8_STAGE(PG8_SB(1, 1), b3 + hstep, voffB); PG8_STAGE(PG8_SA(1, 0), a3, voffA);
            PG8_WAIT_V(8); PG8_WAIT_L(0); PG8_BAR; PG8_MMA(1, 0, At, B0); PG8_MMA(1, 1, At, B1); PG8_BAR; PG8_SCHED;
            } else {
            PG8_LDB(B0, 0, 0); PG8_SCHED; PG8_LDA(At, 0, 0); PG8_STAGE(PG8_SA(1, 1), a1 + hstep, voffA);
            PG8_WAIT_L(8); PG8_BAR; PG8_WAIT_L(0); PG8_MMA(0, 0, At, B0); PG8_BAR; PG8_SCHED;
            PG8_LDB(B1, 0, 1); PG8_STAGE(PG8_SB(0, 0), b2, voffB);
            PG8_BAR; PG8_WAIT_L(0); PG8_MMA(0, 1, At, B1); PG8_BAR;
            PG8_LDA(At, 0, 1); PG8_STAGE(PG8_SA(0, 0), a2, voffA);
            PG8_BAR; PG8_WAIT_L(0); PG8_MMA(1, 0, At, B0); PG8_BAR; PG8_SCHED;
            PG8_STAGE(PG8_SB(0, 1), b2 + hstep, voffB);
            PG8_WAIT_V(6); PG8_BAR; PG8_MMA(1, 1, At, B1); PG8_BAR;
            PG8_LDB(B0, 1, 0); PG8_SCHED; PG8_LDA(At, 1, 0); PG8_STAGE(PG8_SA(0, 1), a2 + hstep, voffA);
            PG8_WAIT_L(8); PG8_BAR; PG8_WAIT_L(0); PG8_MMA(0, 0, At, B0); PG8_BAR; PG8_SCHED;
            PG8_LDB(B1, 1, 1); PG8_STAGE(PG8_SB(1, 0), b3, voffB);
            PG8_BAR; PG8_WAIT_L(0); PG8_MMA(0, 1, At, B1); PG8_BAR;
            PG8_LDA(At, 1, 1); PG8_STAGE(PG8_SA(1, 0), a3, voffA);
            PG8_BAR; PG8_WAIT_L(0); PG8_MMA(1, 0, At, B0); PG8_BAR; PG8_SCHED;
            PG8_STAGE(PG8_SB(1, 1), b3 + hstep, voffB);
            PG8_WAIT_V(6); PG8_BAR; PG8_MMA(1, 1, At, B1); PG8_BAR;
            }
        }
        if constexpr (ALIGN_EPI) { if (wr == 0) PG8_BAR; }
        if constexpr (!Epi::AFTER_DRAIN) { E(acc, cur, wr, wc, fr, fq); S.done(cur); }
        if (!has_next) break;
#pragma unroll
        for (int a = 0; a < 2; ++a)
#pragma unroll
            for (int b = 0; b < 2; ++b)
#pragma unroll
                for (int m = 0; m < 4; ++m)
#pragma unroll
                    for (int n = 0; n < 2; ++n) acc[a][b][m][n] = (f32x4){0.f, 0.f, 0.f, 0.f};
        cur = nxt; cA = nA; cB = nB; ++ui;
        if constexpr (ALIGN_EPI) { if (wr == 1) PG8_BAR; }
    }
    PG8_WAIT_V(0);
    if constexpr (!ALIGN_EPI) { if (wr == 0) PG8_BAR; }
    PG8_BAR;
    if constexpr (Epi::AFTER_DRAIN) { E.fused(acc, cur, wr, wc, fr, fq, lds, wid, lane); S.done(cur); }
#undef PG8_SA
#undef PG8_SB
#undef PG8_STAGE
#undef PG8_LDA
#undef PG8_LDB
#undef PG8_MMA
#undef PG8_WAIT_V
#undef PG8_WAIT_L
#undef PG8_BAR
#undef PG8_SCHED
}
}
namespace att {
#define AGAS __attribute__((address_space(1)))
typedef unsigned short bf16;
using bf16x8 = __attribute__((ext_vector_type(8))) short;
using s16x4  = __attribute__((ext_vector_type(4))) short;
using f32x16 = __attribute__((ext_vector_type(16))) float;
using u32x4  = __attribute__((ext_vector_type(4))) unsigned;
constexpr int LDP = 6144, LDO = 2048;
constexpr int SHM_V = 64 * 128 * 2, SHM_K = 64 * 128 * 2;
constexpr int OFF_V = 0, OFF_K = 2 * SHM_V, OFF_WS = 2 * SHM_V + 2 * SHM_K, OFF_BT = OFF_WS + 8 * 64 * 4, ATT_LDS = OFF_BT + 2048;
constexpr float LOG2E = 1.4426950408889634f;
#define KSWZ128(row, colB) ((row) * 256 + ((colB) ^ (((row) & 7) << 4)))
#define KSWZ64(row, colB)  ((row) * 128 + ((colB) ^ ((((row) >> 1) & 7) << 4)))
#define SBAR() __builtin_amdgcn_sched_barrier(0)
__device__ __forceinline__ int crow(int r, int hi) { return (r & 3) + 8 * (r >> 2) + 4 * hi; }
__device__ __forceinline__ unsigned cvtpk(float lo, float hi) { unsigned r; asm volatile("v_cvt_pk_bf16_f32 %0, %1, %2" : "=v"(r) : "v"(lo), "v"(hi)); return r; }
__device__ __forceinline__ bf16x8 ld8(const AGAS bf16* p) { return *(const AGAS bf16x8*)(p); }
__device__ __forceinline__ unsigned short f2bf1(float f) { return (unsigned short)(cvtpk(f, 0.f) & 0xffffu); }

__device__ __forceinline__ int v_st(int k, int c) { const int kk = (k & ~0xC) | ((k & 4) << 1) | ((k & 8) >> 1); return ((kk >> 3) * 4 + (c >> 5)) * 512 + ((kk & 7) * 32 + (c & 31)) * 2; }
__device__ __forceinline__ int v_rd_base(int lane) { return ((lane & 3) << 3) | (((lane >> 2) & 3) << 6) | (((lane >> 4) & 1) << 5) | (((lane >> 5) & 1) << 8); }
constexpr int v_rd_off(int d0, int ks, int half) { return d0 * 512 + ks * 4096 + half * 2048; }
template <int OFF> __device__ __forceinline__ s16x4 tr_read(int vb) {
  s16x4 r; asm volatile("ds_read_b64_tr_b16 %0, %1 offset:%2" : "=&v"(r) : "v"(vb), "i"(OFF) : "memory"); return r;
}
template <int D0> __device__ __forceinline__ void pv_one(f32x16& od, int vb, bf16x8 pa0, bf16x8 pa1, bf16x8 pa2, bf16x8 pa3) {
  const s16x4 l0 = tr_read<v_rd_off(D0, 0, 0)>(vb), h0 = tr_read<v_rd_off(D0, 0, 1)>(vb), l1 = tr_read<v_rd_off(D0, 1, 0)>(vb), h1 = tr_read<v_rd_off(D0, 1, 1)>(vb);
  const s16x4 l2 = tr_read<v_rd_off(D0, 2, 0)>(vb), h2 = tr_read<v_rd_off(D0, 2, 1)>(vb), l3 = tr_read<v_rd_off(D0, 3, 0)>(vb), h3 = tr_read<v_rd_off(D0, 3, 1)>(vb);
  asm volatile("s_waitcnt lgkmcnt(0)" ::: "memory"); SBAR();
#define PK(L, H) (bf16x8){L[0], L[1], L[2], L[3], H[0], H[1], H[2], H[3]}
  od = __builtin_amdgcn_mfma_f32_32x32x16_bf16(pa0, PK(l0, h0), od, 0, 0, 0);
  od = __builtin_amdgcn_mfma_f32_32x32x16_bf16(pa1, PK(l1, h1), od, 0, 0, 0);
  od = __builtin_amdgcn_mfma_f32_32x32x16_bf16(pa2, PK(l2, h2), od, 0, 0, 0);
  od = __builtin_amdgcn_mfma_f32_32x32x16_bf16(pa3, PK(l3, h3), od, 0, 0, 0);
#undef PK
}
__device__ __forceinline__ void pv_d0(f32x16* o, int vb, bf16x8 pa0, bf16x8 pa1, bf16x8 pa2, bf16x8 pa3) {
  pv_one<0>(o[0], vb, pa0, pa1, pa2, pa3); pv_one<1>(o[1], vb, pa0, pa1, pa2, pa3); pv_one<2>(o[2], vb, pa0, pa1, pa2, pa3); pv_one<3>(o[3], vb, pa0, pa1, pa2, pa3);
}
#define ATT_PK4(P, BASE, OUT) do { unsigned a0_ = cvtpk(P[BASE + 0], P[BASE + 1]), a1_ = cvtpk(P[BASE + 2], P[BASE + 3]);   \
    unsigned b0_ = cvtpk(P[BASE + 4], P[BASE + 5]), b1_ = cvtpk(P[BASE + 6], P[BASE + 7]);                              \
    auto r0_ = __builtin_amdgcn_permlane32_swap(a0_, b0_, false, false); auto r1_ = __builtin_amdgcn_permlane32_swap(a1_, b1_, false, false); \
    u32x4 w_ = {r0_[0], r1_[0], r0_[1], r1_[1]}; OUT = *reinterpret_cast<bf16x8*>(&w_); } while (0)

constexpr float DSCALE = 0.125f, DTHR = 8.f;
__device__ __forceinline__ void d_partialSM(f32x16& p0, f32x16& p1, float& m_reg, float& mn, float& alpha) {
  constexpr float C = DSCALE * LOG2E;
  float pmax = p0[0];
#pragma unroll
  for (int r = 1; r < 16; ++r) pmax = fmaxf(pmax, p0[r]);
#pragma unroll
  for (int r = 0; r < 16; ++r) pmax = fmaxf(pmax, p1[r]);
  { auto rr = __builtin_amdgcn_permlane32_swap(__float_as_uint(pmax), __float_as_uint(pmax), false, false);
    pmax = fmaxf(__uint_as_float(rr[0]), __uint_as_float(rr[1])); }
  if (__builtin_expect(__all(pmax - m_reg <= DTHR / DSCALE), 1)) { mn = m_reg; alpha = 1.f; }
  else { mn = fmaxf(m_reg, pmax); alpha = __builtin_amdgcn_exp2f((m_reg - mn) * C); m_reg = mn; }
  const float mnC = -mn * C;
#pragma unroll
  for (int r = 0; r < 16; ++r) p0[r] = fmaf(p0[r], C, mnC);
#pragma unroll
  for (int r = 0; r < 16; ++r) p1[r] = fmaf(p1[r], C, mnC);
#pragma unroll
  for (int r = 0; r < 16; ++r) p0[r] = __builtin_amdgcn_exp2f(p0[r]);
}
__device__ __forceinline__ void d_finishSM(f32x16& p0, f32x16& p1, float alpha, float& l_reg, bf16x8& pa0, bf16x8& pa1, bf16x8& pa2, bf16x8& pa3) {
#pragma unroll
  for (int r = 0; r < 16; ++r) p1[r] = __builtin_amdgcn_exp2f(p1[r]);
  float ps = 0;
#pragma unroll
  for (int r = 0; r < 16; ++r) ps += p0[r];
#pragma unroll
  for (int r = 0; r < 16; ++r) ps += p1[r];
  { auto rr = __builtin_amdgcn_permlane32_swap(__float_as_uint(ps), __float_as_uint(ps), false, false);
    ps = __uint_as_float(rr[0]) + __uint_as_float(rr[1]); }
  l_reg = l_reg * alpha + ps;
  ATT_PK4(p0, 0, pa0); ATT_PK4(p0, 8, pa1); ATT_PK4(p1, 0, pa2); ATT_PK4(p1, 8, pa3);
}
__device__ __forceinline__ void d_qkt(f32x16& p0, f32x16& p1, const char* Ks, const bf16x8* qr, int r32, int hi) {
  p0 = f32x16{}; p1 = f32x16{};
#pragma unroll
  for (int d0 = 0; d0 < 4; ++d0) { const int cb = (d0 * 16 + hi * 8) * 2;
    const bf16x8 b0 = *reinterpret_cast<const bf16x8*>(Ks + KSWZ64(r32, cb));
    const bf16x8 b1 = *reinterpret_cast<const bf16x8*>(Ks + KSWZ64(32 + r32, cb));
    p0 = __builtin_amdgcn_mfma_f32_32x32x16_bf16(b0, qr[d0], p0, 0, 0, 0);
    p1 = __builtin_amdgcn_mfma_f32_32x32x16_bf16(b1, qr[d0], p1, 0, 0, 0); }
}
__device__ __forceinline__ void diff_unit(const AGAS bf16* __restrict__ proj, long row0, int T, int h, int q0, float lam, float gscale,
                                          const AGAS float* __restrict__ ng, AGAS bf16* __restrict__ out, AGAS float* __restrict__ stash, char* lds) {
  int tid_ = threadIdx.x; asm volatile("" : "+v"(tid_));
  const int tid = tid_, wid = __builtin_amdgcn_readfirstlane(tid >> 6), lane = tid & 63, r32 = lane & 31, hi = lane >> 5;
  char* V_lds = lds + OFF_V; char* K_lds = lds + OFF_K;
  float* ws = (float*)(lds + OFF_WS) + wid * 64; float* li_l = ws; float* al_l = ws + 32;
  const int ksr = tid >> 3, ksc = (tid & 7) * 8;
  const int sr = tid >> 4, sc = (tid & 15) * 8, vst0 = v_st(sr, sc), vst1 = v_st(32 + sr, sc);
  const int kst = KSWZ64(ksr, ksc * 2);
  const int vb0 = (int)(uintptr_t)V_lds + v_rd_base(lane);
  const int NT = T / 64;
  typedef float f32x4v __attribute__((ext_vector_type(4)));
#pragma unroll 1
  for (int c = 0; c < 2; ++c) {
    const AGAS bf16* pj = proj; asm volatile("" : "+s"(pj));
    const AGAS bf16* Qw = pj + (row0 + q0 + wid * 32 + r32) * LDP + h * 128 + c * 64 + hi * 8;
    const AGAS bf16* Kh = pj + row0 * LDP + 1024 + h * 128 + c * 64;
    const AGAS bf16* Vh = pj + row0 * LDP + 2048 + h * 128;
    float m_reg = -1e30f, l_reg = 0.f; f32x16 o[4] = {}; bf16x8 qr[4];
#pragma unroll
    for (int d0 = 0; d0 < 4; ++d0) qr[d0] = ld8(Qw + d0 * 16);
    struct { bf16x8 vs0, vs1, ks0; } sr_[2];
#define SLOAD(i, k0) do { sr_[i].vs0 = ld8(&Vh[(long)((k0) + sr) * LDP + sc]); sr_[i].vs1 = ld8(&Vh[(long)((k0) + 32 + sr) * LDP + sc]); \
      sr_[i].ks0 = ld8(&Kh[(long)((k0) + ksr) * LDP + ksc]); } while (0)
#define SWRITE(b, i) do { *(bf16x8*)(V_lds + (b) * SHM_V + vst0) = sr_[i].vs0; *(bf16x8*)(V_lds + (b) * SHM_V + vst1) = sr_[i].vs1; \
      *(bf16x8*)(K_lds + (b) * SHM_K + kst) = sr_[i].ks0; } while (0)
#define SWAIT() asm volatile("s_waitcnt vmcnt(3)" ::: "memory")
#define RESC(a) do { if (__any((a) < 1.f)) { if (hi == 0) al_l[r32] = (a); asm volatile("s_waitcnt lgkmcnt(0)" ::: "memory"); \
      _Pragma("unroll") for (int d = 0; d < 4; ++d) _Pragma("unroll") for (int r = 0; r < 16; ++r) o[d][r] *= al_l[crow(r, hi)]; } } while (0)
    f32x16 pA0, pA1, pB0, pB1; float mnA, mnB, alA, alB; bf16x8 pa0, pa1, pa2, pa3;
    __syncthreads();
    SLOAD(0, 0); asm volatile("s_waitcnt vmcnt(0)" ::: "memory"); SWRITE(0, 0); __syncthreads();
    d_qkt(pA0, pA1, K_lds, qr, r32, hi); d_partialSM(pA0, pA1, m_reg, mnA, alA);
    SLOAD(1, 64); if (2 < NT) SLOAD(0, 128);
    SWAIT(); SWRITE(1, 1); __syncthreads();
    for (int j = 1; j + 1 < NT; j += 2) {
      SBAR(); d_qkt(pB0, pB1, K_lds + SHM_K, qr, r32, hi);
      d_finishSM(pA0, pA1, alA, l_reg, pa0, pa1, pa2, pa3); SBAR();
      SLOAD(1, (j + 2) * 64); SBAR();
      pv_d0(o, vb0, pa0, pa1, pa2, pa3); d_partialSM(pB0, pB1, m_reg, mnB, alB);
      __syncthreads(); SWAIT(); SWRITE(0, 0);
      RESC(alB); __syncthreads();
      SBAR(); d_qkt(pA0, pA1, K_lds, qr, r32, hi);
      d_finishSM(pB0, pB1, alB, l_reg, pa0, pa1, pa2, pa3); SBAR();
      if (j + 3 < NT) SLOAD(0, (j + 3) * 64); SBAR();
      pv_d0(o, vb0 + SHM_V, pa0, pa1, pa2, pa3); d_partialSM(pA0, pA1, m_reg, mnA, alA);
      __syncthreads(); SWAIT(); SWRITE(1, 1);
      RESC(alA); __syncthreads();
    }
    SBAR(); d_qkt(pB0, pB1, K_lds + SHM_K, qr, r32, hi);
    d_finishSM(pA0, pA1, alA, l_reg, pa0, pa1, pa2, pa3); SBAR();
    pv_d0(o, vb0, pa0, pa1, pa2, pa3); d_partialSM(pB0, pB1, m_reg, mnB, alB);
    __syncthreads(); RESC(alB);
    d_finishSM(pB0, pB1, alB, l_reg, pa0, pa1, pa2, pa3); SBAR();
    pv_d0(o, vb0 + SHM_V, pa0, pa1, pa2, pa3);
#undef SLOAD
#undef SWRITE
#undef SWAIT
#undef RESC
    if (hi == 0) li_l[r32] = l_reg; asm volatile("s_waitcnt lgkmcnt(0)" ::: "memory");
    float rli[16];
#pragma unroll
    for (int r = 0; r < 16; ++r) rli[r] = __builtin_amdgcn_rcpf(li_l[crow(r, hi)]);
    AGAS float* stash_l = stash; asm volatile("" : "+s"(stash_l));
    AGAS f32x4v* st4 = (AGAS f32x4v*)(stash_l + ((size_t)wid * 64 + lane) * 64);
    if (c == 0) {
#pragma unroll
      for (int d0 = 0; d0 < 4; ++d0)
#pragma unroll
        for (int r4 = 0; r4 < 4; ++r4) st4[d0 * 4 + r4] = (f32x4v){o[d0][4 * r4] * rli[4 * r4], o[d0][4 * r4 + 1] * rli[4 * r4 + 1], o[d0][4 * r4 + 2] * rli[4 * r4 + 2], o[d0][4 * r4 + 3] * rli[4 * r4 + 3]};
    } else {
      AGAS bf16* out_l = out; asm volatile("" : "+s"(out_l));
      AGAS bf16* Ow = out_l + (row0 + q0 + wid * 32) * LDO + h * 128 + r32;
      float gv[4];
#pragma unroll
      for (int d0 = 0; d0 < 4; ++d0) gv[d0] = ng[d0 * 32 + r32] * gscale;
#pragma unroll
      for (int r4 = 0; r4 < 4; ++r4) {
        f32x4v s4[4];
#pragma unroll
        for (int d0 = 0; d0 < 4; ++d0) s4[d0] = st4[d0 * 4 + r4];
#pragma unroll
        for (int e = 0; e < 4; ++e) { const int r = 4 * r4 + e;
          float v[4]; float ss = 0.f;
#pragma unroll
          for (int d0 = 0; d0 < 4; ++d0) { v[d0] = s4[d0][e] - lam * (o[d0][r] * rli[r]); ss += v[d0] * v[d0]; }
          ss += __shfl_xor(ss, 1); ss += __shfl_xor(ss, 2); ss += __shfl_xor(ss, 4); ss += __shfl_xor(ss, 8); ss += __shfl_xor(ss, 16);
          const float rstd = 1.0f / sqrtf(ss * (1.0f / 128.0f) + 1e-5f);
          AGAS bf16* ob = Ow; asm volatile("" : "+v"(ob)); AGAS bf16* op = ob + (long)crow(r, hi) * LDO;
#pragma unroll
          for (int d0 = 0; d0 < 4; ++d0) op[d0 * 32] = f2bf1(v[d0] * rstd * gv[d0]);
        }
      }
    }
  }
}

__device__ __forceinline__ void na_qkt(f32x16& p0, f32x16& p1, const char* Ks, const bf16x8* qr, int r32, int hi) {
  p0 = f32x16{}; p1 = f32x16{};
#pragma unroll
  for (int d0 = 0; d0 < 8; ++d0) { const int cb = (d0 * 16 + hi * 8) * 2;
    const bf16x8 b0 = *reinterpret_cast<const bf16x8*>(Ks + KSWZ128(r32, cb));
    const bf16x8 b1 = *reinterpret_cast<const bf16x8*>(Ks + KSWZ128(32 + r32, cb));
    p0 = __builtin_amdgcn_mfma_f32_32x32x16_bf16(b0, qr[d0], p0, 0, 0, 0);
    p1 = __builtin_amdgcn_mfma_f32_32x32x16_bf16(b1, qr[d0], p1, 0, 0, 0); }
}
__device__ __forceinline__ void na_unit(const AGAS bf16* __restrict__ proj, long row0, int rows, int h, int r0, const AGAS float* __restrict__ rpb_h,
                                        AGAS bf16* __restrict__ out, char* lds) {
  int tid_ = threadIdx.x; asm volatile("" : "+v"(tid_));
  const int tid = tid_, wid = __builtin_amdgcn_readfirstlane(tid >> 6), lane = tid & 63, r32 = lane & 31, hi = lane >> 5;
  char* V_lds = lds + OFF_V; char* K_lds = lds + OFF_K;
  float* ws = (float*)(lds + OFF_WS) + wid * 64; float* li_l = ws; float* al_l = ws + 32;
  float* bt = (float*)(lds + OFF_BT);
  constexpr float C = 0.08838834764831845f * LOG2E;
  __syncthreads();
  for (int i = tid; i < 15 * 31; i += 512) bt[i] = rpb_h[i] * LOG2E;
  const int r = r0 + (wid >> 1), cq = (wid & 1) * 32 + r32;
  const int cs = min(max(cq - 8, 0), 48);
  const int rs_w = min(max(r - 4, 0), rows - 8);
  const int kr_lo = min(max(r0 - 4, 0), rows - 8), kr_hi = min(max(r0 - 1, 0), rows - 8) + 8;
  const AGAS bf16* Qw = proj + (row0 + (long)r * 64 + cq) * LDP + 3072 + h * 128 + hi * 8;
  bf16x8 qr[8];
#pragma unroll
  for (int d0 = 0; d0 < 8; ++d0) qr[d0] = ld8(Qw + d0 * 16);
  const int sr = tid >> 4, sc = (tid & 15) * 8, vst0 = v_st(sr, sc), vst1 = v_st(32 + sr, sc);
  const int kst0 = KSWZ128(sr, sc * 2), kst1 = KSWZ128(32 + sr, sc * 2);
  const int vb0 = (int)(uintptr_t)V_lds + v_rd_base(lane);
  const AGAS bf16* Kh = proj + row0 * LDP + 4096 + h * 128; const AGAS bf16* Vh = proj + row0 * LDP + 5120 + h * 128;
  float m_reg = -1e30f, l_reg = 0.f; f32x16 o[4] = {};
  for (int kr = kr_lo; kr < kr_hi; ++kr) {
    const long kb = (long)kr * 64;
    const bf16x8 vs0 = ld8(&Vh[(kb + sr) * LDP + sc]), vs1 = ld8(&Vh[(kb + 32 + sr) * LDP + sc]);
    const bf16x8 ks0 = ld8(&Kh[(kb + sr) * LDP + sc]), ks1 = ld8(&Kh[(kb + 32 + sr) * LDP + sc]);
    __syncthreads();
    *(bf16x8*)(V_lds + vst0) = vs0; *(bf16x8*)(V_lds + vst1) = vs1; *(bf16x8*)(K_lds + kst0) = ks0; *(bf16x8*)(K_lds + kst1) = ks1;
    __syncthreads();
    if (kr >= rs_w && kr < rs_w + 8) {
      f32x16 p0, p1; na_qkt(p0, p1, K_lds, qr, r32, hi);
      const float* btr = bt + (kr - r + 7) * 31;
      float pmax = -INFINITY;
#pragma unroll
      for (int rr = 0; rr < 16; ++rr) {
        const int ck0 = crow(rr, hi), ck1 = ck0 + 32;
        const int ci0 = min(max(ck0 - cq, -15), 15) + 15, ci1 = min(max(ck1 - cq, -15), 15) + 15;
        const float s0 = fmaf(p0[rr], C, btr[ci0]), s1 = fmaf(p1[rr], C, btr[ci1]);
        p0[rr] = (ck0 >= cs && ck0 < cs + 16) ? s0 : -INFINITY; p1[rr] = (ck1 >= cs && ck1 < cs + 16) ? s1 : -INFINITY;
        pmax = fmaxf(pmax, fmaxf(p0[rr], p1[rr]));
      }
      { auto rr = __builtin_amdgcn_permlane32_swap(__float_as_uint(pmax), __float_as_uint(pmax), false, false);
        pmax = fmaxf(__uint_as_float(rr[0]), __uint_as_float(rr[1])); }
      const float mn = fmaxf(m_reg, pmax); const float alpha = __builtin_amdgcn_exp2f(m_reg - mn); m_reg = mn;
      float ps = 0.f;
#pragma unroll
      for (int rr = 0; rr < 16; ++rr) { p0[rr] = __builtin_amdgcn_exp2f(p0[rr] - mn); p1[rr] = __builtin_amdgcn_exp2f(p1[rr] - mn); ps += p0[rr] + p1[rr]; }
      { auto rr = __builtin_amdgcn_permlane32_swap(__float_as_uint(ps), __float_as_uint(ps), false, false);
        ps = __uint_as_float(rr[0]) + __uint_as_float(rr[1]); }
      l_reg = l_reg * alpha + ps;
      if (hi == 0) al_l[r32] = alpha; asm volatile("s_waitcnt lgkmcnt(0)" ::: "memory");
#pragma unroll
      for (int d = 0; d < 4; ++d)
#pragma unroll
        for (int rr = 0; rr < 16; ++rr) o[d][rr] *= al_l[crow(rr, hi)];
      bf16x8 pa0, pa1, pa2, pa3;
      ATT_PK4(p0, 0, pa0); ATT_PK4(p0, 8, pa1); ATT_PK4(p1, 0, pa2); ATT_PK4(p1, 8, pa3);
      SBAR(); pv_d0(o, vb0, pa0, pa1, pa2, pa3);
    }
  }
  if (hi == 0) li_l[r32] = l_reg; asm volatile("s_waitcnt lgkmcnt(0)" ::: "memory");
  float rli[16];
#pragma unroll
  for (int rr = 0; rr < 16; ++rr) rli[rr] = __builtin_amdgcn_rcpf(li_l[crow(rr, hi)]);
  AGAS bf16* out_l = out; asm volatile("" : "+s"(out_l));
  AGAS bf16* Ow = out_l + (row0 + (long)r * 64 + (wid & 1) * 32) * LDO + 1024 + h * 128 + r32;
#pragma unroll
  for (int rr = 0; rr < 16; ++rr) { AGAS bf16* ob = Ow; asm volatile("" : "+v"(ob)); AGAS bf16* op = ob + (long)crow(rr, hi) * LDO;
#pragma unroll
    for (int d0 = 0; d0 < 4; ++d0) op[d0 * 32] = f2bf1(o[d0][rr] * rli[rr]); }
}
#undef SBAR
}

#define GAS __attribute__((address_space(1)))
#define LAS __attribute__((address_space(3)))
typedef unsigned short bf16;
typedef unsigned v4u __attribute__((ext_vector_type(4)));
typedef float f32x4 __attribute__((ext_vector_type(4)));
typedef short bf16x8 __attribute__((ext_vector_type(8)));
typedef GAS unsigned gu32;
typedef GAS unsigned long long gu64;
#define RLX_AGENT __ATOMIC_RELAXED, __HIP_MEMORY_SCOPE_AGENT
#define LDS_WAIT() asm volatile("s_waitcnt lgkmcnt(0)" ::: "memory")
#define VM_WAIT() asm volatile("s_waitcnt vmcnt(0)" ::: "memory")
__device__ __forceinline__ unsigned long long rt() { return __builtin_amdgcn_s_memrealtime(); }
__device__ __forceinline__ unsigned f2bf(float f) { unsigned u = __builtin_bit_cast(unsigned, f); return (u + 0x7fffu + ((u >> 16) & 1u)) >> 16; }
__device__ __forceinline__ unsigned pk2(float lo, float hi) { return f2bf(lo) | (f2bf(hi) << 16); }
#define XB_TMO      128
#define XB_XCNT(j)  (256  + 64 * (j))
#define XB_XSUB(j)  (1280 + 64 * (j))
#define XB_XGEN(j)  (2304 + 64 * (j))
#define XB_TOP      3328
#define XB_TOPGEN   3392
#define XCD_BAR_WORDS 3456
#define XB_SPIN_CAP (1u << 18)

__device__ __forceinline__ unsigned xb_ld(unsigned* p)              { return __hip_atomic_load(p, __ATOMIC_RELAXED, __HIP_MEMORY_SCOPE_AGENT); }
__device__ __forceinline__ unsigned xb_add(unsigned* p, unsigned v) { return __hip_atomic_fetch_add(p, v, __ATOMIC_RELAXED, __HIP_MEMORY_SCOPE_AGENT); }
__device__ __forceinline__ unsigned xb_xcc_id() { return (unsigned)__builtin_amdgcn_s_getreg((3 << 11) | 20) & 0xFu; }
#define XB_SPIN(cond, bar) do { unsigned _sp = 0; while (cond) { __builtin_amdgcn_s_sleep(1); \
    if ((++_sp & 255u) == 0u) { if (xb_ld(&(bar)[XB_TMO])) break; if (_sp > XB_SPIN_CAP) { atomicAdd(&(bar)[XB_TMO], 1u); break; } } } } while (0)

struct XcdBarrier {
    unsigned* bar; unsigned x;
    volatile LAS unsigned* st;
};

__device__ __forceinline__ XcdBarrier xcd_barrier_post(unsigned* bar, volatile LAS unsigned* st) {
    XcdBarrier b; b.bar = bar; b.x = xb_xcc_id(); b.st = st;
    if (threadIdx.x == 0) (void)xb_add(&bar[XB_XCNT(b.x)], 1u);
    return b;
}
__device__ __forceinline__ void xcd_barrier_complete(unsigned* bar, unsigned x, unsigned& nloc, unsigned& nx) {
    const unsigned G = gridDim.x * gridDim.y * gridDim.z;
    unsigned sum, cnt, mine, sp = 0u;
    for (;;) {
        sum = 0u; cnt = 0u; mine = 0u;
#pragma unroll
        for (unsigned j = 0; j < 16; ++j) { const unsigned c = xb_ld(&bar[XB_XCNT(j)]); sum += c; cnt += (c > 0u) ? 1u : 0u; mine = (j == x) ? c : mine; }
        if (sum == G) break;
        __builtin_amdgcn_s_sleep(1);
        if ((++sp & 255u) == 0u) { if (xb_ld(&bar[XB_TMO])) break; if (sp > XB_SPIN_CAP) { atomicAdd(&bar[XB_TMO], 1u); break; } }
    }
    nloc = mine > 0u ? mine : 1u; nx = cnt > 0u ? cnt : 1u;
}

__device__ __forceinline__ void xcd_barrier(const XcdBarrier& b) {
    asm volatile("s_waitcnt vmcnt(0)" ::: "memory");
    __syncthreads();
    unsigned bx_ = b.x; asm volatile("" : "+s"(bx_));
    if (threadIdx.x == 0) {
        unsigned* bar = b.bar; asm volatile("" : "+s"(bar));
        __builtin_amdgcn_s_waitcnt(0);
        unsigned nloc = b.st[0], nx = b.st[1];
        if (nloc == 0u) { xcd_barrier_complete(bar, bx_, nloc, nx); b.st[0] = nloc; b.st[1] = nx; }
        const unsigned old = xb_add(&bar[XB_XSUB(bx_)], 1u);
        const unsigned gen = old / nloc;
        if (old + 1u == (gen + 1u) * nloc) {
            __builtin_amdgcn_fence(__ATOMIC_RELEASE, "agent");
            asm volatile("s_waitcnt vmcnt(0)" ::: "memory");
            const unsigned og = xb_add(&bar[XB_TOP], 1u);
            const unsigned tg = og / nx;
            if (og + 1u == (tg + 1u) * nx) xb_add(&bar[XB_TOPGEN], 1u);
            else XB_SPIN(xb_ld(&bar[XB_TOPGEN]) == tg, bar);
            __builtin_amdgcn_fence(__ATOMIC_ACQUIRE, "agent");
            xb_add(&bar[XB_XGEN(bx_)], 1u);
            asm volatile("s_waitcnt vmcnt(0)" ::: "memory");
        } else {
            XB_SPIN(xb_ld(&bar[XB_XGEN(bx_)]) == gen, bar);
            __builtin_amdgcn_fence(__ATOMIC_ACQUIRE, "agent");
            asm volatile("s_waitcnt vmcnt(0)" ::: "memory");
        }
    }
    __syncthreads();
}
constexpr int NWAVES = 8;
constexpr int DM = 2048, DFF = 5632, NGU = 2 * DFF, NIN = 6144, NLAYER = 2;
constexpr int MP = 8 * 4096, MS = 2 * 16384, M = MP + MS;
constexpr int NB = 10, MODW = 9 * DM;
constexpr float LN_EPS = 1e-5f;
constexpr float DN_ALPHA = 1.4142135623730951f;

constexpr size_t MiB = 1u << 20;
constexpr size_t WS_CTL = 0, CTL_ZERO_BYTES = 1 * MiB;
constexpr size_t WS_MODV = 1 * MiB;
constexpr size_t WS_ROPE = 3 * MiB;
constexpr size_t WS_MISC = 7 * MiB;
constexpr size_t WS_W = 8 * MiB;
constexpr size_t WO_GU1 = 0, WO_D1 = 44 * MiB, WO_IN = 66 * MiB, WO_OUT = 90 * MiB, WO_GU2 = 98 * MiB, WO_D2 = 142 * MiB, W_BYTES = 164 * MiB;
constexpr size_t WS_HA = WS_W + W_BYTES;
constexpr size_t WS_HB = WS_HA + 256 * MiB;
constexpr size_t WS_BIG = WS_HB + 256 * MiB;
constexpr size_t WS_END = WS_BIG + 768 * MiB;
static_assert((size_t)NGU * DM * 2 == 44 * MiB && (size_t)DM * DFF * 2 == 22 * MiB && (size_t)NIN * DM * 2 == 24 * MiB && (size_t)DM * DM * 2 == 8 * MiB, "weight map");
static_assert((size_t)M * NIN * 2 == 768 * MiB && (size_t)M * DM * 2 == 256 * MiB, "activation map");
constexpr int CW_BAR = 4096;

constexpr int RING_OFF = 0, RING_BYTES = 131072;
constexpr int LDSCTL_OFF = RING_BYTES, MISC_OFF = LDSCTL_OFF + 320;
constexpr int LDS_BYTES = 147456;

__device__ __forceinline__ float wave_sum(float v) {
#pragma unroll
    for (int o = 1; o < 64; o <<= 1) v += __shfl_xor(v, o);
    return v;
}
template <int MODE> __device__ __forceinline__ int dest_row(int s) {
    if (MODE == 1) { const int half = s >= DFF ? 1 : 0; const int j = s - half * DFF; return 256 * (j >> 7) + 128 * half + (j & 127); }
    if (MODE == 2) { if (s < 2048) { const int d = s & 63; const int p = d < 32 ? 2 * d : 2 * (d - 32) + 1; return (s & ~63) + p; } return s; }
    return s;
}
template <int MODE> __device__ __forceinline__ void transpose_item(const float* W, int K, int N, bf16* WT, LAS float* scr, int item, int lane) {
    const int nblk = N / 32, kb = item / nblk, nb = item % nblk, k0 = 64 * kb, n0 = 32 * nb;
#pragma unroll 8
    for (int i = 0; i < 32; ++i) { const int kk = 2 * i + (lane >> 5); scr[kk * 33 + (lane & 31)] = W[(size_t)(k0 + kk) * N + n0 + (lane & 31)]; }
    LDS_WAIT(); asm volatile("" ::: "memory");
    const int c = lane & 7;
#pragma unroll
    for (int j = 0; j < 4; ++j) { const int n = (lane >> 3) + 8 * j; const LAS float* s = scr + (8 * c) * 33 + n;
        v4u o; o.x = pk2(s[0 * 33], s[1 * 33]); o.y = pk2(s[2 * 33], s[3 * 33]); o.z = pk2(s[4 * 33], s[5 * 33]); o.w = pk2(s[6 * 33], s[7 * 33]);
        *(GAS v4u*)(WT + (size_t)dest_row<MODE>(n0 + n) * K + k0 + 8 * c) = o; }
    LDS_WAIT(); asm volatile("" ::: "memory");
}
struct Args { const GAS float* in[20]; GAS float* out; GAS unsigned char* ws; };

typedef const __attribute__((address_space(4))) Args* KArgsT;
__device__ __forceinline__ void convert_layer(KArgsT a, int l, unsigned char* wsw, LAS float* scr, int gw, int NGW, int lane) {
    constexpr int I_GU = (DM / 64) * (NGU / 32), I_D = (DFF / 64) * (DM / 32), I_IN = (DM / 64) * (NIN / 32), I_O = (DM / 64) * (DM / 32);
    constexpr int NITEMS = 2 * I_GU + 2 * I_D + I_IN + I_O;
    asm volatile("" : "+v"(lane));
    for (int it = gw; it < NITEMS; it += NGW) {
        int r = it;
        if (r < I_GU) { transpose_item<1>(((const float*)a->in[8]) + (size_t)l * DM * NGU, DM, NGU, (bf16*)(wsw + WO_GU1), scr, r, lane); continue; } r -= I_GU;
        if (r < I_D)  { transpose_item<0>(((const float*)a->in[9]) + (size_t)l * DFF * DM, DFF, DM, (bf16*)(wsw + WO_D1), scr, r, lane); continue; } r -= I_D;
        if (r < I_IN) { transpose_item<2>(((const float*)a->in[10]) + (size_t)l * DM * NIN, DM, NIN, (bf16*)(wsw + WO_IN), scr, r, lane); continue; } r -= I_IN;
        if (r < I_O)  { transpose_item<0>(((const float*)a->in[11]) + (size_t)l * DM * DM, DM, DM, (bf16*)(wsw + WO_OUT), scr, r, lane); continue; } r -= I_O;
        if (r < I_GU) { transpose_item<1>(((const float*)a->in[18]) + (size_t)l * DM * NGU, DM, NGU, (bf16*)(wsw + WO_GU2), scr, r, lane); continue; } r -= I_GU;
        transpose_item<0>(((const float*)a->in[19]) + (size_t)l * DFF * DM, DFF, DM, (bf16*)(wsw + WO_D2), scr, r, lane);
    }
}
__device__ __forceinline__ int batch_of_row(int m) { return m < MP ? (m >> 12) : 8 + ((m - MP) >> 14); }
__device__ __forceinline__ void mod_rows(const float* xp, const float* xs, bf16* hout, const float* modl, int sh_idx, int gw, int NGW, int lane) {
    asm volatile("" : "+v"(lane));
    for (int m = gw; m < M; m += NGW) {
        const float* xr = m < MP ? xp + (size_t)m * DM : xs + (size_t)(m - MP) * DM;
        const float* mb = modl + (size_t)batch_of_row(m) * MODW;
        GAS unsigned long long* o8 = (GAS unsigned long long*)(hout + (size_t)m * DM) + lane;
#pragma unroll
        for (int j = 0; j < 8; ++j) { const int col = 4 * lane + 256 * j;
            const f32x4 v = *(const GAS f32x4*)(xr + col), sh = *(const GAS f32x4*)(mb + sh_idx * DM + col), sc = *(const GAS f32x4*)(mb + (sh_idx + 1) * DM + col);
            const f32x4 hv = v * (sc + 1.0f) + sh;
            o8[64 * j] = (unsigned long long)pk2(hv.x, hv.y) | ((unsigned long long)pk2(hv.z, hv.w) << 32); }
    }
}
__device__ __forceinline__ void ln_rows(float* y, bf16* hout, const float* lng, const float* lnb, const float* modl, int sh_idx, int gw, int NGW, int lane) {
    asm volatile("" : "+v"(lane));
    for (int m = gw; m < M; m += NGW) {
        GAS f32x4* yr = (GAS f32x4*)(y + (size_t)m * DM) + lane;
        f32x4 v[8]; float s = 0.f;
#pragma unroll
        for (int j = 0; j < 8; ++j) { v[j] = yr[64 * j]; s += (v[j].x + v[j].y) + (v[j].z + v[j].w); }
        const float mean = wave_sum(s) * (1.f / DM); float s2 = 0.f;
#pragma unroll
        for (int j = 0; j < 8; ++j) { v[j] = v[j] - mean; s2 += (v[j].x * v[j].x + v[j].y * v[j].y) + (v[j].z * v[j].z + v[j].w * v[j].w); }
        const float rstd = 1.f / sqrtf(wave_sum(s2) * (1.f / DM) + LN_EPS);
        const float* mb = modl + (size_t)batch_of_row(m) * MODW;
        GAS unsigned long long* o8 = (GAS unsigned long long*)(hout + (size_t)m * DM) + lane;
#pragma unroll
        for (int j = 0; j < 8; ++j) { const int col = 4 * lane + 256 * j;
            const f32x4 g = *(const GAS f32x4*)(lng + col), b = *(const GAS f32x4*)(lnb + col);
            const f32x4 xv = v[j] * rstd * g + b;
            yr[64 * j] = xv;
            if (hout) { const f32x4 sh = *(const GAS f32x4*)(mb + sh_idx * DM + col), sc = *(const GAS f32x4*)(mb + (sh_idx + 1) * DM + col);
                const f32x4 hv = xv * (sc + 1.0f) + sh;
                o8[64 * j] = (unsigned long long)pk2(hv.x, hv.y) | ((unsigned long long)pk2(hv.z, hv.w) << 32); } }
    }
}
#ifdef PROBE_LN_REP
__device__ __forceinline__ void ln_dummy(float* y, bf16* hout, const float* modl, int sh_idx, int gw, int NGW, int lane) {
    asm volatile("" : "+v"(lane));
    for (int m = gw; m < M; m += NGW) {
        GAS f32x4* yr = (GAS f32x4*)(y + (size_t)m * DM) + lane;
        f32x4 v[8]; float s = 0.f;
#pragma unroll
        for (int j = 0; j < 8; ++j) { v[j] = yr[64 * j]; s += (v[j].x + v[j].y) + (v[j].z + v[j].w); }
        const float mean = wave_sum(s) * (1.f / DM); float s2 = 0.f;
#pragma unroll
        for (int j = 0; j < 8; ++j) { const f32x4 d = v[j] - mean; s2 += (d.x * d.x + d.y * d.y) + (d.z * d.z + d.w * d.w); }
        const float rstd = 1.f / sqrtf(wave_sum(s2) * (1.f / DM) + LN_EPS);
        const float keep = rstd > 1e30f ? 0.f : 1.f;
        const float* mb = modl + (size_t)batch_of_row(m) * MODW;
        GAS unsigned long long* o8 = (GAS unsigned long long*)(hout + (size_t)m * DM) + lane;
#pragma unroll
        for (int j = 0; j < 8; ++j) { const int col = 4 * lane + 256 * j;
            const f32x4 xv = v[j] * keep;
            yr[64 * j] = xv;
            const f32x4 sh = *(const GAS f32x4*)(mb + sh_idx * DM + col), sc = *(const GAS f32x4*)(mb + (sh_idx + 1) * DM + col);
            const f32x4 hv = xv * (sc + 1.0f) + sh;
            o8[64 * j] = (unsigned long long)pk2(hv.x, hv.y) | ((unsigned long long)pk2(hv.z, hv.w) << 32); }
    }
}
#endif
__device__ __forceinline__ void modv_phase(KArgsT a, float* modv, LAS unsigned char* lds, int G, int tid, int wave, int lane) {
    LAS float* sc = (LAS float*)lds;
    LAS float* red = (LAS float*)(lds + NB * DM * 4);
    constexpr int NCH = MODW / 128, NIT = NLAYER * NCH;
    if ((int)blockIdx.x >= NIT) return;
    for (int i = tid; i < NB * DM; i += NWAVES * 64) { const int b = i / DM, k = i % DM; const float cv = b < 8 ? ((const float*)a->in[2])[b * DM + k] : ((const float*)a->in[3])[(b - 8) * DM + k];
        sc[i] = cv / (1.0f + __expf(-cv)); }
    __syncthreads();
    for (int it = blockIdx.x; it < NIT; it += G) {
        const int l = it / NCH, ch = it % NCH;
        const float* wp = ((const float*)a->in[4]) + ((size_t)l * DM + wave * 256) * MODW + ch * 128 + 2 * lane;
        float ax[NB], ay[NB];
#pragma unroll
        for (int b = 0; b < NB; ++b) { ax[b] = 0.f; ay[b] = 0.f; }
        for (int k = 0; k < 256; k += 4) {
            typedef float f32x2v __attribute__((ext_vector_type(2)));
            const f32x2v w0 = *(const GAS f32x2v*)(wp + (size_t)(k + 0) * MODW), w1 = *(const GAS f32x2v*)(wp + (size_t)(k + 1) * MODW);
            const f32x2v w2 = *(const GAS f32x2v*)(wp + (size_t)(k + 2) * MODW), w3 = *(const GAS f32x2v*)(wp + (size_t)(k + 3) * MODW);
#pragma unroll
            for (int b = 0; b < NB; ++b) { const f32x4 s4 = *(const LAS f32x4*)(sc + b * DM + wave * 256 + k);
                ax[b] += s4.x * w0.x + s4.y * w1.x + s4.z * w2.x + s4.w * w3.x; ay[b] += s4.x * w0.y + s4.y * w1.y + s4.z * w2.y + s4.w * w3.y; }
        }
#pragma unroll
        for (int b = 0; b < NB; ++b) { red[(wave * NB + b) * 128 + 2 * lane] = ax[b]; red[(wave * NB + b) * 128 + 2 * lane + 1] = ay[b]; }
        __syncthreads();
        for (int o = tid; o < NB * 128; o += NWAVES * 64) { const int b = o / 128, cc = o % 128; float s = 0.f;
#pragma unroll
            for (int w = 0; w < NWAVES; ++w) s += red[(w * NB + b) * 128 + cc];
            modv[((size_t)l * NB + b) * MODW + ch * 128 + cc] = s + ((const float*)a->in[5])[(size_t)l * MODW + ch * 128 + cc]; }
        __syncthreads();
    }
}
__device__ const double ROPE_INVF[32] = {1.0,0.7498942093324559,0.5623413251903491,0.4216965034285822,0.31622776601683794,0.23713737056616552,0.1778279410038923,0.1333521432163324,0.1,0.07498942093324558,0.05623413251903491,0.042169650342858224,0.03162277660168379,0.023713737056616554,0.01778279410038923,0.01333521432163324,0.01,0.007498942093324558,0.005623413251903491,0.004216965034285823,0.0031622776601683794,0.0023713737056616554,0.0017782794100389228,0.001333521432163324,0.001,0.0007498942093324559,0.0005623413251903491,0.00042169650342858224,0.00031622776601683794,0.00023713737056616554,0.00017782794100389227,0.0001333521432163324};
__device__ __forceinline__ void rope_tables(float* ropeC, float* ropeS, int gtid, int nthr) {
    for (int idx = gtid; idx < 16384 * 32; idx += nthr) {
        const int t = idx >> 5, i = idx & 31; const double x = (double)t * ROPE_INVF[i];
        const double q = __builtin_rint(x * 0.63661977236758134308);
        double r = __builtin_fma(-q, 1.57079632679489655800e+00, x); r = __builtin_fma(-q, 6.12323399573676603587e-17, r);
        const double r2 = r * r;
        const double sp = r + r * r2 * (-1.0 / 6 + r2 * (1.0 / 120 + r2 * (-1.0 / 5040 + r2 * (1.0 / 362880 + r2 * (-1.0 / 39916800 + r2 * (1.0 / 6227020800.0))))));
        const double cp = 1.0 + r2 * (-0.5 + r2 * (1.0 / 24 + r2 * (-1.0 / 720 + r2 * (1.0 / 40320 + r2 * (-1.0 / 3628800 + r2 * (1.0 / 479001600.0 + r2 * (-1.0 / 87178291200.0)))))));
        const int qi = ((int)q) & 3;
        const double sv = qi == 0 ? sp : qi == 1 ? cp : qi == 2 ? -sp : -cp;
        const double cv = qi == 0 ? cp : qi == 1 ? -sp : qi == 2 ? -cp : sp;
        ropeC[idx] = (float)cv; ropeS[idx] = (float)sv;
    }
}

#ifndef PH
#define PH 0xFFFF
#endif
#define LAUNDER_S(p) asm volatile("" : "+s"(p))
typedef const __attribute__((address_space(4))) Args* KArgs;
__device__ __forceinline__ KArgs kargs() { KArgs p = (KArgs)__builtin_amdgcn_kernarg_segment_ptr(); LAUNDER_S(p); return p; }
constexpr float LAM_INIT0 = 0.2f, LAM_INIT1 = 0.35550906759096926f;

__global__ void __launch_bounds__(NWAVES * 64, 2) mega_fwd(Args args_unused) {
    extern __shared__ __attribute__((aligned(16))) unsigned char lds[];
    LAS unsigned char* L = (LAS unsigned char*)lds;
    volatile LAS unsigned* MISC = (volatile LAS unsigned*)(L + MISC_OFF);
    const int tid = threadIdx.x, lane = tid & 63, wave = __builtin_amdgcn_readfirstlane(tid >> 6);
    const int G = gridDim.x; const int bx = blockIdx.x; const int vcu = (G % 8 == 0) ? (bx % 8) * (G / 8) + bx / 8 : bx;
    const int gw = vcu * NWAVES + wave, NGW = G * NWAVES;
    for (int u = tid; u < (LDS_BYTES - LDSCTL_OFF) / 4; u += NWAVES * 64) ((LAS unsigned*)(L + LDSCTL_OFF))[u] = 0u;
    __syncthreads();
    XcdBarrier bar;
    { KArgs ap = kargs(); bar = xcd_barrier_post((unsigned*)(((unsigned char*)ap->ws) + WS_CTL) + CW_BAR, MISC + 8); }
#define GRID_BAR() xcd_barrier(bar)
    LAS float* scr = (LAS float*)(L + RING_OFF + wave * 16384);

    {
        KArgs ap = kargs(); unsigned char* ws = ((unsigned char*)ap->ws);
#if PH & 1
        modv_phase(ap, (float*)(ws + WS_MODV), L, G, tid, wave, lane);
        rope_tables((float*)(ws + WS_ROPE), (float*)(ws + WS_ROPE) + 16384 * 32, bx * (NWAVES * 64) + tid, G * NWAVES * 64);
#endif
        if (bx == 0 && wave == 0) {
            float* lamv = (float*)(ws + WS_MISC);
#pragma unroll
            for (int l = 0; l < NLAYER; ++l) {
                const float s1 = wave_sum(((const float*)ap->in[12])[l * 64 + lane] * ((const float*)ap->in[13])[l * 64 + lane]), s2 = wave_sum(((const float*)ap->in[14])[l * 64 + lane] * ((const float*)ap->in[15])[l * 64 + lane]);
                if (lane == 0) lamv[l] = expf(s1) - expf(s2) + (l == 0 ? LAM_INIT0 : LAM_INIT1);
            }
        }
        __syncthreads();
#if PH & 2
#ifdef PROBE_CONV_REP
#pragma unroll 1
        for (int rep = 1; rep < PROBE_CONV_REP; ++rep) convert_layer(ap, 0, ws + WS_W, scr, gw, NGW, lane);
#endif
        convert_layer(ap, 0, ws + WS_W, scr, gw, NGW, lane);
#endif
    }
    GRID_BAR();
    {
        KArgs ap = kargs(); unsigned char* ws = ((unsigned char*)ap->ws);
#if PH & 4
        mod_rows(((const float*)ap->in[0]), ((const float*)ap->in[1]), (bf16*)(ws + WS_HA), (const float*)(ws + WS_MODV), 0, gw, NGW, lane);
#endif
    }
    GRID_BAR();

#pragma unroll 1
    for (int l = 0; l < NLAYER; ++l) {
        { KArgs ap = kargs(); unsigned char* ws = ((unsigned char*)ap->ws);
          pg8::Gemm g{(const bf16*)(ws + WS_HA), (const bf16*)(ws + WS_W + WO_GU1), M, NGU, DM}; pg8::StaticOrder S; { int g_ = G, c_ = bx; LAUNDER_S(g_); LAUNDER_S(c_); S.init(M, NGU, g_, c_); }
          pg8::EpiSwiGLU E{(bf16*)(ws + WS_BIG), DFF};
#if PH & 8
#ifdef PROBE_G1_REP
#pragma unroll 1
          for (int rep = 0; rep < PROBE_G1_REP; ++rep)
#endif
          pg8::gemm_phase<pg8::EpiSwiGLU, pg8::StaticOrder, true, true>(L + RING_OFF, g, S, E);
#endif
        }
        GRID_BAR();
        { KArgs ap = kargs(); unsigned char* ws = ((unsigned char*)ap->ws); float* out = ((float*)ap->out);
          const float* xsrc_p = l == 0 ? ((const float*)ap->in[0]) : out; const float* xsrc_s = l == 0 ? ((const float*)ap->in[1]) : out + (size_t)MP * DM;
          pg8::Gemm g{(const bf16*)(ws + WS_BIG), (const bf16*)(ws + WS_W + WO_D1), M, DM, DFF}; pg8::StaticOrderG<4> S; { int g_ = G, c_ = bx; LAUNDER_S(g_); LAUNDER_S(c_); S.init(M, DM, g_, c_); }
          pg8::EpiResid E{xsrc_p, xsrc_s, out, DM, (const float*)(ws + WS_MODV) + (size_t)l * NB * MODW + 2 * DM, 0.5f, DN_ALPHA};
#if PH & 16
#ifdef PROBE_G2_REP
#pragma unroll 1
          for (int rep = 0; rep < (l == 0 ? PROBE_G2_REP : 1); ++rep)
#endif
          pg8::gemm_phase<pg8::EpiResid, pg8::StaticOrderG<4>, true, true>(L + RING_OFF, g, S, E);
#endif
        }
        GRID_BAR();
        { KArgs ap = kargs(); unsigned char* ws = ((unsigned char*)ap->ws);
#if PH & 4
          ln_rows(((float*)ap->out), (bf16*)(ws + WS_HB), ((const float*)ap->in[6]) + (size_t)l * 3 * DM, ((const float*)ap->in[7]) + (size_t)l * 3 * DM, (const float*)(ws + WS_MODV) + (size_t)l * NB * MODW, 3, gw, NGW, lane);
#ifdef PROBE_LN_REP
#pragma unroll 1
          for (int rep = 1; rep < PROBE_LN_REP; ++rep) ln_dummy(((float*)ap->out), (bf16*)(ws + WS_HB), (const float*)(ws + WS_MODV) + (size_t)l * NB * MODW, 3, gw, NGW, lane);
#endif
#endif
        }
        GRID_BAR();
        { KArgs ap = kargs(); unsigned char* ws = ((unsigned char*)ap->ws);
          pg8::Gemm g{(const bf16*)(ws + WS_HB), (const bf16*)(ws + WS_W + WO_IN), M, NIN, DM}; pg8::StaticOrder S; { int g_ = G, c_ = bx; LAUNDER_S(g_); LAUNDER_S(c_); S.init(M, NIN, g_, c_); }
          pg8::EpiRope E{(bf16*)(ws + WS_BIG), NIN, (const float*)(ws + WS_ROPE), (const float*)(ws + WS_ROPE) + 16384 * 32};
#if PH & 32
          pg8::gemm_phase<pg8::EpiRope, pg8::StaticOrder, true, true>(L + RING_OFF, g, S, E);
#endif
        }
        GRID_BAR();
        {
            KArgs ap = kargs(); unsigned char* ws = ((unsigned char*)ap->ws);
            const GAS bf16* BIG = (const GAS bf16*)(ap->ws + WS_BIG); GAS bf16* HA = (GAS bf16*)(ap->ws + WS_HA);
            const float lam = ((const float*)(ws + WS_MISC))[l]; const float gscale = 1.0f - (l == 0 ? LAM_INIT0 : LAM_INIT1);
            const GAS float* ng = ap->in[16] + l * 128; const GAS float* rpb = ap->in[17] + (size_t)l * 8 * 15 * 31;
            GAS float* stash = (GAS float*)(ap->ws + WS_HB) + (size_t)bx * 32768;
#ifndef PROBE_ATT_REP
#define PROBE_ATT_REP 1
#endif
#pragma unroll 1
            for (int rep = 0; rep < PROBE_ATT_REP; ++rep)
#pragma unroll 1
            for (int i = 0;; ++i) {
                const int u = i * G + vcu; if (u >= 4096) break;
#ifdef PROBE_NA_ONLY_REP
                if (rep > 0 && u < 2048) continue;
#endif
                if (u < 2048) {
                    long row0; int T, h, q0;
                    if (u < 1024) { const int bh = u >> 6, qt = u & 63; row0 = MP + (long)(bh >> 3) * 16384; T = 16384; h = bh & 7; q0 = qt * 256; }
                    else { const int v = u - 1024, bh = v >> 4, qt = v & 15; row0 = (long)(bh >> 3) * 4096; T = 4096; h = bh & 7; q0 = qt * 256; }
#if PH & 64
                    att::diff_unit(BIG, row0, T, h, q0, lam, gscale, ng, HA, stash, (char*)lds);
#endif
                } else {
                    long row0; int rows, h, r0; int v = u - 2048;
                    if (v < 1024) { const int bh = v >> 4, rg = v & 15; row0 = (long)(bh >> 3) * 4096; rows = 64; h = bh & 7; r0 = rg * 4; }
                    else { v -= 1024; const int bh = v >> 6, rg = v & 63; row0 = MP + (long)(bh >> 3) * 16384; rows = 256; h = bh & 7; r0 = rg * 4; }
#if PH & 128
                    att::na_unit(BIG, row0, rows, h, r0, rpb + h * 15 * 31, HA, (char*)lds);
#endif
                }
            }
        }
        GRID_BAR();
        { KArgs ap = kargs(); unsigned char* ws = ((unsigned char*)ap->ws); float* out = ((float*)ap->out);
          pg8::Gemm g{(const bf16*)(ws + WS_HA), (const bf16*)(ws + WS_W + WO_OUT), M, DM, DM}; pg8::StaticOrderG<4> S; { int g_ = G, c_ = bx; LAUNDER_S(g_); LAUNDER_S(c_); S.init(M, DM, g_, c_); }
          pg8::EpiResid E{out, out + (size_t)MP * DM, out, DM, (const float*)(ws + WS_MODV) + (size_t)l * NB * MODW + 5 * DM, 1.0f, DN_ALPHA};
#if PH & 16
          pg8::gemm_phase<pg8::EpiResid, pg8::StaticOrderG<4>, true, true>(L + RING_OFF, g, S, E);
#endif
        }
        GRID_BAR();
        { KArgs ap = kargs(); unsigned char* ws = ((unsigned char*)ap->ws);
#if PH & 4
          ln_rows(((float*)ap->out), (bf16*)(ws + WS_HB), ((const float*)ap->in[6]) + (size_t)l * 3 * DM + DM, ((const float*)ap->in[7]) + (size_t)l * 3 * DM + DM, (const float*)(ws + WS_MODV) + (size_t)l * NB * MODW, 6, gw, NGW, lane);
#endif
        }
        GRID_BAR();
        { KArgs ap = kargs(); unsigned char* ws = ((unsigned char*)ap->ws);
          pg8::Gemm g{(const bf16*)(ws + WS_HB), (const bf16*)(ws + WS_W + WO_GU2), M, NGU, DM}; pg8::StaticOrder S; { int g_ = G, c_ = bx; LAUNDER_S(g_); LAUNDER_S(c_); S.init(M, NGU, g_, c_); }
          pg8::EpiSwiGLU E{(bf16*)(ws + WS_BIG), DFF};
#if PH & 8
#ifdef PROBE_G1_REP
#pragma unroll 1
          for (int rep = 0; rep < PROBE_G1_REP; ++rep)
#endif
          pg8::gemm_phase<pg8::EpiSwiGLU, pg8::StaticOrder, true, true>(L + RING_OFF, g, S, E);
#endif
        }
        GRID_BAR();
        { KArgs ap = kargs(); unsigned char* ws = ((unsigned char*)ap->ws); float* out = ((float*)ap->out);
          pg8::Gemm g{(const bf16*)(ws + WS_BIG), (const bf16*)(ws + WS_W + WO_D2), M, DM, DFF}; pg8::StaticOrderG<4> S; { int g_ = G, c_ = bx; LAUNDER_S(g_); LAUNDER_S(c_); S.init(M, DM, g_, c_); }
          pg8::EpiResid E{out, out + (size_t)MP * DM, out, DM, (const float*)(ws + WS_MODV) + (size_t)l * NB * MODW + 8 * DM, 0.5f, DN_ALPHA};
#if PH & 16
          pg8::gemm_phase<pg8::EpiResid, pg8::StaticOrderG<4>, true, true>(L + RING_OFF, g, S, E);
#endif
        }
        GRID_BAR();
        { KArgs ap = kargs(); unsigned char* ws = ((unsigned char*)ap->ws);
          const float* lng = ((const float*)ap->in[6]) + (size_t)l * 3 * DM + 2 * DM; const float* lnb = ((const float*)ap->in[7]) + (size_t)l * 3 * DM + 2 * DM;
          if (l + 1 < NLAYER) {
#if PH & 4
            ln_rows(((float*)ap->out), (bf16*)(ws + WS_HA), lng, lnb, (const float*)(ws + WS_MODV) + (size_t)(l + 1) * NB * MODW, 0, gw, NGW, lane);
#endif
#if PH & 2
            convert_layer(ap, l + 1, ws + WS_W, scr, gw, NGW, lane);
#endif
          } else {
#if PH & 4
            ln_rows(((float*)ap->out), nullptr, lng, lnb, (const float*)(ws + WS_MODV), 0, gw, NGW, lane);
#endif
          }
        }
        if (l + 1 < NLAYER) GRID_BAR();
    }
#undef GRID_BAR
}

extern "C" void kernel_launch(void* const* d_in, const int* in_sizes, int n_in, void* d_out, int out_size, void* d_ws, size_t ws_size, hipStream_t stream) {
    static int grid = 0;
    if (grid == 0) {
        if (n_in != 20 || out_size != M * DM || ws_size < WS_END) { fprintf(stderr, "kernel_launch: unexpected shapes: n_in %d out %d ws %zu (need %zu)\n", n_in, out_size, ws_size, (size_t)WS_END); grid = -1; return; }
        int dev = 0, cus = 0, per_cu = 0;
        if (hipGetDevice(&dev) != hipSuccess || hipDeviceGetAttribute(&cus, hipDeviceAttributeMultiprocessorCount, dev) != hipSuccess) { grid = -1; return; }
        if (hipFuncSetAttribute((const void*)mega_fwd, hipFuncAttributeMaxDynamicSharedMemorySize, LDS_BYTES) != hipSuccess) { fprintf(stderr, "kernel_launch: hipFuncSetAttribute failed\n"); grid = -1; return; }
        if (hipOccupancyMaxActiveBlocksPerMultiprocessor(&per_cu, (const void*)mega_fwd, NWAVES * 64, LDS_BYTES) != hipSuccess || per_cu < 1)
            fprintf(stderr, "kernel_launch: note: occupancy query reports %d workgroups per CU\n", per_cu);
        (void)hipGetLastError();
        grid = cus;
    }
    if (grid < 0) return;
    if (hipMemsetAsync((char*)d_ws + WS_CTL, 0, CTL_ZERO_BYTES, stream) != hipSuccess) return;
    Args a{};
    for (int i = 0; i < 20; ++i) a.in[i] = (const GAS float*)d_in[i];
    a.out = (GAS float*)d_out; a.ws = (GAS unsigned char*)d_ws;
    hipLaunchKernelGGL(mega_fwd, dim3(grid), dim3(NWAVES * 64), LDS_BYTES, stream, a);
    const hipError_t le = hipPeekAtLastError();
    if (le != hipSuccess) fprintf(stderr, "kernel_launch: launch failed: %s\n", hipGetErrorName(le));
}
```

```cpp
#include <hip/hip_runtime.h>
#include <cstdio>
#include <cstdint>
namespace pg8 {
#define PG8_LAS __attribute__((address_space(3)))
typedef unsigned short bf16_t;
typedef short bf16x8 __attribute__((ext_vector_type(8)));
typedef float f32x4 __attribute__((ext_vector_type(4)));
typedef unsigned u32x4 __attribute__((ext_vector_type(4)));
constexpr int BM = 256, BK = 64, HALF = 128, HTB = HALF * BK * 2  , STAGE_BYTES = 8 * HTB, NXCD = 8, WGM = 8;

__host__ __device__ __forceinline__ int lds_byte(int r, int c) { const int st = (r >> 4) * 2 + (c >> 5), rr = r & 15, cc = c & 31, ob = rr * 64 + cc * 2; return st * 1024 + (ob ^ (((ob >> 9) & 1) << 5)); }
__host__ __device__ __forceinline__ void stage_rc(int b, int& R, int& C) { const int st = b / 1024, sb = b % 1024, swz = sb ^ (((sb >> 9) & 1) << 5); R = (st >> 1) * 16 + swz / 64; C = (st & 1) * 32 + (swz % 64) / 2; }
__host__ __device__ __forceinline__ int perm32(int rho) { const int n = rho >> 4, i = rho & 15; return 8 * (i >> 2) + 4 * n + (i & 3); }

struct Unit { int pm, pn; };
struct Gemm { const bf16_t* A; const bf16_t* Bt; int M, N, K; };

struct StaticOrder {
    int nM, nN, nwg, G, c;
    __host__ __device__ void init(int M, int N, int G_, int c_) { nM = M / BM; nN = N / BM; nwg = nM * nN; G = G_; c = c_; }
    __host__ __device__ bool next(int i, Unit& u) const {
        const long L = (long)i * G + c; if (L >= nwg) return false;
        int wgid = (int)L; { const int q = nwg / NXCD, r = nwg % NXCD, xcd = wgid % NXCD, off = wgid / NXCD; wgid = (xcd < r ? xcd * (q + 1) : r * (q + 1) + (xcd - r) * q) + off; }
        const int nig = WGM * nN, gid = wgid / nig, fm = gid * WGM, gsz = (nM - fm) < WGM ? (nM - fm) : WGM;
        u.pm = fm + ((wgid % nig) % gsz); u.pn = (wgid % nig) / gsz; return true;
    }
    __device__ __forceinline__ void a_ready(const Unit&) const {}
    __device__ __forceinline__ void done(const Unit&) const {}
};

__device__ __forceinline__ unsigned cvt_pk_bf16(float lo, float hi) { unsigned r; asm volatile("v_cvt_pk_bf16_f32 %0, %1, %2" : "=v"(r) : "v"(lo), "v"(hi)); return r; }
typedef float f32x2 __attribute__((ext_vector_type(2)));
template <int WG> struct StaticOrderG {
    int nM, nN, nwg, G, c;
    __host__ __device__ void init(int M, int N, int G_, int c_) { nM = M / BM; nN = N / BM; nwg = nM * nN; G = G_; c = c_; }
    __host__ __device__ bool next(int i, Unit& u) const {
        const long L = (long)i * G + c; if (L >= nwg) return false;
        int wgid = (int)L; { const int q = nwg / NXCD, r = nwg % NXCD, xcd = wgid % NXCD, off = wgid / NXCD; wgid = (xcd < r ? xcd * (q + 1) : r * (q + 1) + (xcd - r) * q) + off; }
        const int nig = WG * nN, gid = wgid / nig, fm = gid * WG, gsz = (nM - fm) < WG ? (nM - fm) : WG;
        u.pm = fm + ((wgid % nig) % gsz); u.pn = (wgid % nig) / gsz; return true;
    }
    __device__ __forceinline__ void a_ready(const Unit&) const {}
    __device__ __forceinline__ void done(const Unit&) const {}
};
__device__ __forceinline__ float silu_f(float g) { return g * __builtin_amdgcn_rcpf(1.0f + __builtin_amdgcn_exp2f(-1.4426950408889634f * g)); }
struct EpiSwiGLU {
    static constexpr bool PERM = true, AFTER_DRAIN = false;
    bf16_t* O; int ldc;
    __device__ __forceinline__ void operator()(const f32x4 (&acc)[2][2][4][2], const Unit& u, int wr, int wc, int fr, int fq) const {
        const int row0 = u.pm * BM + wr * 64 + fr, col0 = u.pn * HALF + wc * 32 + 8 * fq;
#pragma unroll
        for (int ai = 0; ai < 2; ++ai)
#pragma unroll
            for (int m = 0; m < 4; ++m) { bf16_t* rowp = O + (size_t)(row0 + ai * HALF + m * 16) * ldc + col0;
                const f32x4 g0 = acc[ai][0][m][0], g1 = acc[ai][0][m][1], u0 = acc[ai][1][m][0], u1 = acc[ai][1][m][1];
                u32x4 w;
                w.x = cvt_pk_bf16(silu_f(g0[0]) * u0[0], silu_f(g0[1]) * u0[1]); w.y = cvt_pk_bf16(silu_f(g0[2]) * u0[2], silu_f(g0[3]) * u0[3]);
                w.z = cvt_pk_bf16(silu_f(g1[0]) * u1[0], silu_f(g1[1]) * u1[1]); w.w = cvt_pk_bf16(silu_f(g1[2]) * u1[2], silu_f(g1[3]) * u1[3]);
                *(u32x4*)rowp = w; }
    }
};
struct EpiResid {
    static constexpr bool PERM = false, AFTER_DRAIN = false;
    const float* xp; const float* xs;
    float* y; int ldc; const float* gate;
    float coef, alpha;
    __device__ __forceinline__ void operator()(const f32x4 (&acc)[2][2][4][2], const Unit& u, int wr, int wc, int fr, int fq) const {
        const int trow = u.pm * BM; const bool samp = trow >= 32768;
        const int bidx = samp ? 8 + ((trow - 32768) >> 14) : (trow >> 12);
        const float* xb = samp ? xs + (size_t)(trow - 32768) * ldc : xp + (size_t)trow * ldc;
        float* yb = y + (size_t)trow * ldc;
        const int col0 = u.pn * BM + wc * 32 + 4 * fq;
        const float* gp = gate + (size_t)bidx * 18432 + col0;
        f32x4 gv[2][2];
#pragma unroll
        for (int bj = 0; bj < 2; ++bj)
#pragma unroll
            for (int n = 0; n < 2; ++n) gv[bj][n] = (*(const f32x4*)(gp + bj * HALF + n * 16) + 1.0f) * coef;
#pragma unroll
        for (int ai = 0; ai < 2; ++ai) {
            f32x4 xv[4][2][2];
#pragma unroll
            for (int m = 0; m < 4; ++m) { const size_t off = (size_t)(ai * HALF + wr * 64 + m * 16 + fr) * ldc + col0;
#pragma unroll
                for (int bj = 0; bj < 2; ++bj)
#pragma unroll
                    for (int n = 0; n < 2; ++n) xv[m][bj][n] = *(const f32x4*)(xb + off + bj * HALF + n * 16); }
#pragma unroll
            for (int m = 0; m < 4; ++m) { const size_t off = (size_t)(ai * HALF + wr * 64 + m * 16 + fr) * ldc + col0;
#pragma unroll
                for (int bj = 0; bj < 2; ++bj)
#pragma unroll
                    for (int n = 0; n < 2; ++n) { const f32x4 o = xv[m][bj][n] * alpha + gv[bj][n] * acc[ai][bj][m][n]; *(f32x4*)(yb + off + bj * HALF + n * 16) = o; } }
            asm volatile("" ::: "memory");
        }
    }
};
struct EpiRope {
    static constexpr bool PERM = true, AFTER_DRAIN = false;
    bf16_t* O; int ldc; const float* ropeC; const float* ropeS;
    float qscale;
    __device__ __forceinline__ void operator()(const f32x4 (&acc)[2][2][4][2], const Unit& u, int wr, int wc, int fr, int fq) const {
        const int row0 = u.pm * BM + wr * 64 + fr, col0 = u.pn * BM + wc * 32 + 8 * fq;
        const bool rot = u.pn < 8; const int i0 = (wc & 1) * 16 + 4 * fq;
        const float qs = u.pn < 4 ? qscale : 1.0f;
        f32x4 cs[2][4], sn[2][4];
#pragma unroll
        for (int ai = 0; ai < 2; ++ai)
#pragma unroll
            for (int m = 0; m < 4; ++m) { const int row = row0 + ai * HALF + m * 16; const int t = row < 32768 ? (row & 4095) : (row & 16383);
                cs[ai][m] = (f32x4){1.f, 1.f, 1.f, 1.f}; sn[ai][m] = (f32x4){0.f, 0.f, 0.f, 0.f};
                if (rot) { cs[ai][m] = *(const f32x4*)(ropeC + (size_t)t * 32 + i0); sn[ai][m] = *(const f32x4*)(ropeS + (size_t)t * 32 + i0); } }
#pragma unroll
        for (int ai = 0; ai < 2; ++ai)
#pragma unroll
            for (int m = 0; m < 4; ++m) { const int row = row0 + ai * HALF + m * 16;
                const f32x4 c4 = cs[ai][m], s4 = sn[ai][m];
                bf16_t* rowp = O + (size_t)row * ldc + col0;
#pragma unroll
                for (int bj = 0; bj < 2; ++bj) { const f32x4 v0 = acc[ai][bj][m][0], v1 = acc[ai][bj][m][1];
                    const float a0 = v0[0] * c4[0] - v0[1] * s4[0], b0 = v0[1] * c4[0] + v0[0] * s4[0];
                    const float a1 = v0[2] * c4[1] - v0[3] * s4[1], b1 = v0[3] * c4[1] + v0[2] * s4[1];
                    const float a2 = v1[0] * c4[2] - v1[1] * s4[2], b2 = v1[1] * c4[2] + v1[0] * s4[2];
                    const float a3 = v1[2] * c4[3] - v1[3] * s4[3], b3 = v1[3] * c4[3] + v1[2] * s4[3];
                    u32x4 w; w.x = cvt_pk_bf16(a0 * qs, b0 * qs); w.y = cvt_pk_bf16(a1 * qs, b1 * qs); w.z = cvt_pk_bf16(a2 * qs, b2 * qs); w.w = cvt_pk_bf16(a3 * qs, b3 * qs);
                    *(u32x4*)(rowp + bj * HALF) = w; } }
    }
};

template <class Epi, class Sched, bool ALIGN_EPI = false, bool SP2 = false>
__device__ __forceinline__ void gemm_phase(PG8_LAS unsigned char* lds, const Gemm g, const Sched& S, const Epi& E) {
    int tid_ = threadIdx.x; asm volatile("" : "+v"(tid_));
    const int tid = tid_, wid = __builtin_amdgcn_readfirstlane(tid >> 6), lane = tid & 63, wr = wid >> 2, wc = wid & 3, fr = lane & 15, fq = lane >> 4;
    const int K = g.K, nt = K / BK;
    unsigned voffA[2], voffB[2];
#pragma unroll
    for (int i = 0; i < 2; ++i) { int R, C; stage_rc(tid * 16 + i * 8192, R, C); const int Rb = Epi::PERM ? ((R & ~31) + perm32(R & 31)) : R;
        voffA[i] = (unsigned)(R * K + C) * 2u; voffB[i] = (unsigned)(Rb * K + C) * 2u; }
    const size_t kstep = (size_t)(BK * 2);
    const size_t hstep = (size_t)HALF * K * 2;
    const size_t tstep = 2 * hstep;
    const unsigned ldsw = (unsigned)wid * 1024u;
    const int aoff = lds_byte(wr * 64 + fr, fq * 8), boff = lds_byte(wc * 32 + fr, fq * 8);
#define PG8_SA(b, h) (((b) * 2 + (h)) * HTB)
#define PG8_SB(b, h) ((4 + (b) * 2 + (h)) * HTB)
#define PG8_STAGE(bufoff, gbase, voff) do { _Pragma("unroll") for (int _i = 0; _i < 2; ++_i) \
        __builtin_amdgcn_global_load_lds((const unsigned*)((const char*)(gbase) + (voff)[_i]), (PG8_LAS unsigned*)(lds + (bufoff) + ldsw + _i * 8192), 16, 0, 0); } while (0)
#define PG8_LDA(dst, b, h) do { _Pragma("unroll") for (int m = 0; m < 4; ++m) _Pragma("unroll") for (int k = 0; k < 2; ++k) dst[m][k] = *(const PG8_LAS bf16x8*)(lds + PG8_SA(b, h) + aoff + m * 2048 + k * 1024); } while (0)
#define PG8_LDB(dst, b, h) do { _Pragma("unroll") for (int n = 0; n < 2; ++n) _Pragma("unroll") for (int k = 0; k < 2; ++k) dst[n][k] = *(const PG8_LAS bf16x8*)(lds + PG8_SB(b, h) + boff + n * 2048 + k * 1024); } while (0)
#define PG8_MMA(ai, bj, At, Bt) do { __builtin_amdgcn_s_setprio(1); _Pragma("unroll") for (int m = 0; m < 4; ++m) _Pragma("unroll") for (int n = 0; n < 2; ++n) _Pragma("unroll") for (int k = 0; k < 2; ++k) \
        acc[ai][bj][m][n] = __builtin_amdgcn_mfma_f32_16x16x32_bf16(Bt[n][k], At[m][k], acc[ai][bj][m][n], 0, 0, 0); __builtin_amdgcn_s_setprio(0); } while (0)
#define PG8_WAIT_V(n) asm volatile("s_waitcnt vmcnt(" #n ")" ::: "memory")
#define PG8_WAIT_L(n) asm volatile("s_waitcnt lgkmcnt(" #n ")" ::: "memory")
#define PG8_BAR __builtin_amdgcn_s_barrier()
#define PG8_SCHED __builtin_amdgcn_sched_barrier(0)
    Unit cur, nxt; int ui = 0;
    if (!S.next(0, cur)) return;
    f32x4 acc[2][2][4][2];
#pragma unroll
    for (int a = 0; a < 2; ++a)
#pragma unroll
        for (int b = 0; b < 2; ++b)
#pragma unroll
            for (int m = 0; m < 4; ++m)
#pragma unroll
                for (int n = 0; n < 2; ++n) acc[a][b][m][n] = (f32x4){0.f, 0.f, 0.f, 0.f};
    bf16x8 At[4][2], B0[2][2], B1[2][2];
    const char* cA = (const char*)g.A + (size_t)cur.pm * tstep; const char* cB = (const char*)g.Bt + (size_t)cur.pn * tstep;
    S.a_ready(cur);
    if constexpr (SP2) {
        PG8_STAGE(PG8_SB(0, 0), cB, voffB); PG8_STAGE(PG8_SB(0, 1), cB + hstep, voffB); PG8_STAGE(PG8_SA(0, 0), cA, voffA); PG8_STAGE(PG8_SA(0, 1), cA + hstep, voffA);
        if (wr == 1) PG8_BAR;
        PG8_WAIT_V(2); PG8_BAR;
        PG8_STAGE(PG8_SB(1, 0), cB + kstep, voffB); PG8_STAGE(PG8_SA(1, 0), cA + kstep, voffA); PG8_STAGE(PG8_SB(1, 1), cB + hstep + kstep, voffB);
        PG8_WAIT_V(6); PG8_BAR;
    } else {
        PG8_STAGE(PG8_SB(0, 0), cB, voffB); PG8_STAGE(PG8_SA(0, 0), cA, voffA); PG8_STAGE(PG8_SB(0, 1), cB + hstep, voffB); PG8_STAGE(PG8_SA(0, 1), cA + hstep, voffA);
        if (wr == 1) PG8_BAR;
        PG8_WAIT_V(4); PG8_BAR;
        PG8_STAGE(PG8_SB(1, 0), cB + kstep, voffB); PG8_STAGE(PG8_SA(1, 0), cA + kstep, voffA); PG8_STAGE(PG8_SB(1, 1), cB + hstep + kstep, voffB);
        PG8_WAIT_V(6); PG8_BAR;
    }
    for (;;) {
        const bool has_next = S.next(ui + 1, nxt);
        const char* nA = has_next ? (const char*)g.A + (size_t)nxt.pm * tstep : cA; const char* nB = has_next ? (const char*)g.Bt + (size_t)nxt.pn * tstep : cB;
        for (int t = 0; t < nt; t += 2) {
            const bool last = (t == nt - 2);
            const char* a1 = cA + (size_t)(t + 1) * kstep;
            const char* a2 = last ? nA : cA + (size_t)(t + 2) * kstep; const char* b2 = last ? nB : cB + (size_t)(t + 2) * kstep;
            const char* a3 = a2 + kstep; const char* b3 = b2 + kstep;
            if (last && has_next) S.a_ready(nxt);
            if constexpr (SP2) {
            PG8_LDB(B0, 0, 0); PG8_LDB(B1, 0, 1); PG8_SCHED; PG8_LDA(At, 0, 0); PG8_STAGE(PG8_SA(1, 1), a1 + hstep, voffA);
            PG8_WAIT_V(8); PG8_WAIT_L(0); PG8_BAR; PG8_MMA(0, 0, At, B0); PG8_MMA(0, 1, At, B1); PG8_BAR; PG8_SCHED;
            PG8_LDA(At, 0, 1); PG8_STAGE(PG8_SB(0, 0), b2, voffB); PG8_STAGE(PG8_SB(0, 1), b2 + hstep, voffB); PG8_STAGE(PG8_SA(0, 0), a2, voffA);
            PG8_WAIT_V(8); PG8_WAIT_L(0); PG8_BAR; PG8_MMA(1, 0, At, B0); PG8_MMA(1, 1, At, B1); PG8_BAR; PG8_SCHED;
            PG8_LDB(B0, 1, 0); PG8_LDB(B1, 1, 1); PG8_SCHED; PG8_LDA(At, 1, 0); PG8_STAGE(PG8_SA(0, 1), a2 + hstep, voffA);
            PG8_WAIT_V(8); PG8_WAIT_L(0); PG8_BAR; PG8_MMA(0, 0, At, B0); PG8_MMA(0, 1, At, B1); PG8_BAR; PG8_SCHED;
            PG8_LDA(At, 1, 1); PG8_STAGE(PG8_SB(1, 0), b3, voffB); PG8_STAGE(PG8_SB(1, 1), b3 + hstep, voffB); PG8_STAGE(PG8_SA(1, 0), a3, voffA);
            PG8_WAIT_V(8); PG8_WAIT_L(0); PG8_BAR; PG8_MMA(1, 0, At, B0); PG8_MMA(1, 1, At, B1); PG8_BAR; PG8_SCHED;
            } else {
            PG8_LDB(B0, 0, 0); PG8_SCHED; PG8_LDA(At, 0, 0); PG8_STAGE(PG8_SA(1, 1), a1 + hstep, voffA);
            PG8_WAIT_L(8); PG8_BAR; PG8_WAIT_L(0); PG8_MMA(0, 0, At, B0); PG8_BAR; PG8_SCHED;
            PG8_LDB(B1, 0, 1); PG8_STAGE(PG8_SB(0, 0), b2, voffB);
            PG8_BAR; PG8_WAIT_L(0); PG8_MMA(0, 1, At, B1); PG8_BAR;
            PG8_LDA(At, 0, 1); PG8_STAGE(PG8_SA(0, 0), a2, voffA);
            PG8_BAR; PG8_WAIT_L(0); PG8_MMA(1, 0, At, B0); PG8_BAR; PG8_SCHED;
            PG8_STAGE(PG8_SB(0, 1), b2 + hstep, voffB);
            PG8_WAIT_V(6); PG8_BAR; PG8_MMA(1, 1, At, B1); PG8_BAR;
            PG8_LDB(B0, 1, 0); PG8_SCHED; PG8_LDA(At, 1, 0); PG8_STAGE(PG8_SA(0, 1), a2 + hstep, voffA);
            PG8_WAIT_L(8); PG8_BAR; PG8_WAIT_L(0); PG8_MMA(0, 0, At, B0); PG8_BAR; PG8_SCHED;
            PG8_LDB(B1, 1, 1); PG8_STAGE(PG8_SB(1, 0), b3, voffB);
            PG8_BAR; PG8_WAIT_L(0); PG8_MMA(0, 1, At, B1); PG8_BAR;
            PG8_LDA(At, 1, 1); PG8_STAGE(PG8_SA(1, 0), a3, voffA);
            PG8_BAR; PG8_WAIT_L(0); PG8_MMA(1, 0, At, B0); PG8_BAR; PG8_SCHED;
            PG8_STAGE(PG8_SB(1, 1), b3 + hstep, voffB);
            PG8_WAIT_V(6); PG8_BAR; PG8_MMA(1, 1, At, B1); PG8_BAR;
            }
        }
        if constexpr (ALIGN_EPI) { if (wr == 0) PG8_BAR; }
        if constexpr (!Epi::AFTER_DRAIN) { E(acc, cur, wr, wc, fr, fq); S.done(cur); }
        if (!has_next) break;
#pragma unroll
        for (int a = 0; a < 2; ++a)
#pragma unroll
            for (int b = 0; b < 2; ++b)
#pragma unroll
                for (int m = 0; m < 4; ++m)
#pragma unroll
                    for (int n = 0; n < 2; ++n) acc[a][b][m][n] = (f32x4){0.f, 0.f, 0.f, 0.f};
        cur = nxt; cA = nA; cB = nB; ++ui;
        if constexpr (ALIGN_EPI) { if (wr == 1) PG8_BAR; }
    }
    PG8_WAIT_V(0);
    if constexpr (!ALIGN_EPI) { if (wr == 0) PG8_BAR; }
    PG8_BAR;
    if constexpr (Epi::AFTER_DRAIN) { E.fused(acc, cur, wr, wc, fr, fq, lds, wid, lane); S.done(cur); }
#undef PG8_SA
#undef PG8_SB
#undef PG8_STAGE
#undef PG8_LDA
#undef PG8_LDB
#undef PG8_MMA
#undef PG8_WAIT_V
#undef PG8_WAIT_L
#undef PG8_BAR
#undef PG8_SCHED
}
}
namespace att {
#define AGAS __attribute__((address_space(1)))
typedef unsigned short bf16;
using bf16x8 = __attribute__((ext_vector_type(8))) short;
using s16x4  = __attribute__((ext_vector_type(4))) short;
using f32x16 = __attribute__((ext_vector_type(16))) float;
using u32x4  = __attribute__((ext_vector_type(4))) unsigned;
constexpr int LDP = 6144, LDO = 2048;
constexpr int SHM_V = 64 * 128 * 2, SHM_K = 64 * 128 * 2;
constexpr int OFF_V = 0, OFF_K = 2 * SHM_V, OFF_WS = 2 * SHM_V + 2 * SHM_K, OFF_BT = OFF_WS + 8 * 64 * 4, ATT_LDS = OFF_BT + 2048;
constexpr float LOG2E = 1.4426950408889634f;
#define KSWZ128(row, colB) ((row) * 256 + ((colB) ^ (((row) & 7) << 4)))
#define KSWZ64(row, colB)  ((row) * 128 + ((colB) ^ ((((row) >> 1) & 7) << 4)))
#define SBAR() __builtin_amdgcn_sched_barrier(0)
__device__ __forceinline__ int crow(int r, int hi) { return (r & 3) + 8 * (r >> 2) + 4 * hi; }
__device__ __forceinline__ unsigned cvtpk(float lo, float hi) { unsigned r; asm volatile("v_cvt_pk_bf16_f32 %0, %1, %2" : "=v"(r) : "v"(lo), "v"(hi)); return r; }
__device__ __forceinline__ bf16x8 ld8(const AGAS bf16* p) { return *(const AGAS bf16x8*)(p); }
__device__ __forceinline__ unsigned short f2bf1(float f) { return (unsigned short)(cvtpk(f, 0.f) & 0xffffu); }

__device__ __forceinline__ int v_st(int k, int c) { const int kk = (k & ~0xC) | ((k & 4) << 1) | ((k & 8) >> 1); return ((kk >> 3) * 4 + (c >> 5)) * 512 + ((kk & 7) * 32 + (c & 31)) * 2; }
__device__ __forceinline__ int v_rd_base(int lane) { return ((lane & 3) << 3) | (((lane >> 2) & 3) << 6) | (((lane >> 4) & 1) << 5) | (((lane >> 5) & 1) << 8); }
constexpr int v_rd_off(int d0, int ks, int half) { return d0 * 512 + ks * 4096 + half * 2048; }
template <int OFF> __device__ __forceinline__ s16x4 tr_read(int vb) {
  s16x4 r; asm volatile("ds_read_b64_tr_b16 %0, %1 offset:%2" : "=&v"(r) : "v"(vb), "i"(OFF) : "memory"); return r;
}
template <int D0> __device__ __forceinline__ void pv_one(f32x16& od, int vb, bf16x8 pa0, bf16x8 pa1, bf16x8 pa2, bf16x8 pa3) {
  const s16x4 l0 = tr_read<v_rd_off(D0, 0, 0)>(vb), h0 = tr_read<v_rd_off(D0, 0, 1)>(vb), l1 = tr_read<v_rd_off(D0, 1, 0)>(vb), h1 = tr_read<v_rd_off(D0, 1, 1)>(vb);
  const s16x4 l2 = tr_read<v_rd_off(D0, 2, 0)>(vb), h2 = tr_read<v_rd_off(D0, 2, 1)>(vb), l3 = tr_read<v_rd_off(D0, 3, 0)>(vb), h3 = tr_read<v_rd_off(D0, 3, 1)>(vb);
  asm volatile("s_waitcnt lgkmcnt(0)" ::: "memory"); SBAR();
#define PK(L, H) (bf16x8){L[0], L[1], L[2], L[3], H[0], H[1], H[2], H[3]}
  od = __builtin_amdgcn_mfma_f32_32x32x16_bf16(pa0, PK(l0, h0), od, 0, 0, 0);
  od = __builtin_amdgcn_mfma_f32_32x32x16_bf16(pa1, PK(l1, h1), od, 0, 0, 0);
  od = __builtin_amdgcn_mfma_f32_32x32x16_bf16(pa2, PK(l2, h2), od, 0, 0, 0);
  od = __builtin_amdgcn_mfma_f32_32x32x16_bf16(pa3, PK(l3, h3), od, 0, 0, 0);
#undef PK
}
__device__ __forceinline__ void pv_d0(f32x16* o, int vb, bf16x8 pa0, bf16x8 pa1, bf16x8 pa2, bf16x8 pa3) {
  pv_one<0>(o[0], vb, pa0, pa1, pa2, pa3); pv_one<1>(o[1], vb, pa0, pa1, pa2, pa3); pv_one<2>(o[2], vb, pa0, pa1, pa2, pa3); pv_one<3>(o[3], vb, pa0, pa1, pa2, pa3);
}
#define ATT_PK4(P, BASE, OUT) do { unsigned a0_ = cvtpk(P[BASE + 0], P[BASE + 1]), a1_ = cvtpk(P[BASE + 2], P[BASE + 3]);   \
    unsigned b0_ = cvtpk(P[BASE + 4], P[BASE + 5]), b1_ = cvtpk(P[BASE + 6], P[BASE + 7]);                              \
    auto r0_ = __builtin_amdgcn_permlane32_swap(a0_, b0_, false, false); auto r1_ = __builtin_amdgcn_permlane32_swap(a1_, b1_, false, false); \
    u32x4 w_ = {r0_[0], r1_[0], r0_[1], r1_[1]}; OUT = *reinterpret_cast<bf16x8*>(&w_); } while (0)

constexpr float DSCALE = 0.125f, DTHR = 8.f;
__device__ __forceinline__ void d_partialSM(f32x16& p0, f32x16& p1, float& m_reg, float& mn, float& alpha) {
  constexpr float C = DSCALE * LOG2E;
  float pmax = p0[0];
#pragma unroll
  for (int r = 1; r < 16; ++r) pmax = fmaxf(pmax, p0[r]);
#pragma unroll
  for (int r = 0; r < 16; ++r) pmax = fmaxf(pmax, p1[r]);
  { auto rr = __builtin_amdgcn_permlane32_swap(__float_as_uint(pmax), __float_as_uint(pmax), false, false);
    pmax = fmaxf(__uint_as_float(rr[0]), __uint_as_float(rr[1])); }
  if (__builtin_expect(__all(pmax - m_reg <= DTHR / DSCALE), 1)) { mn = m_reg; alpha = 1.f; }
  else { mn = fmaxf(m_reg, pmax); alpha = __builtin_amdgcn_exp2f((m_reg - mn) * C); m_reg = mn; }
  const float mnC = -mn * C;
#pragma unroll
  for (int r = 0; r < 16; ++r) p0[r] = fmaf(p0[r], C, mnC);
#pragma unroll
  for (int r = 0; r < 16; ++r) p1[r] = fmaf(p1[r], C, mnC);
#pragma unroll
  for (int r = 0; r < 16; ++r) p0[r] = __builtin_amdgcn_exp2f(p0[r]);
}
__device__ __forceinline__ void d_finishSM(f32x16& p0, f32x16& p1, float alpha, float& l_reg, bf16x8& pa0, bf16x8& pa1, bf16x8& pa2, bf16x8& pa3) {
#pragma unroll
  for (int r = 0; r < 16; ++r) p1[r] = __builtin_amdgcn_exp2f(p1[r]);
  float ps = 0;
#pragma unroll
  for (int r = 0; r < 16; ++r) ps += p0[r];
#pragma unroll
  for (int r = 0; r < 16; ++r) ps += p1[r];
  { auto rr = __builtin_amdgcn_permlane32_swap(__float_as_uint(ps), __float_as_uint(ps), false, false);
    ps = __uint_as_float(rr[0]) + __uint_as_float(rr[1]); }
  l_reg = l_reg * alpha + ps;
  ATT_PK4(p0, 0, pa0); ATT_PK4(p0, 8, pa1); ATT_PK4(p1, 0, pa2); ATT_PK4(p1, 8, pa3);
}
__device__ __forceinline__ void d_qkt(f32x16& p0, f32x16& p1, const char* Ks, const bf16x8* qr, int r32, int hi) {
  p0 = f32x16{}; p1 = f32x16{};
#pragma unroll
  for (int d0 = 0; d0 < 4; ++d0) { const int cb = (d0 * 16 + hi * 8) * 2;
    const bf16x8 b0 = *reinterpret_cast<const bf16x8*>(Ks + KSWZ64(r32, cb));
    const bf16x8 b1 = *reinterpret_cast<const bf16x8*>(Ks + KSWZ64(32 + r32, cb));
    p0 = __builtin_amdgcn_mfma_f32_32x32x16_bf16(b0, qr[d0], p0, 0, 0, 0);
    p1 = __builtin_amdgcn_mfma_f32_32x32x16_bf16(b1, qr[d0], p1, 0, 0, 0); }
}
__device__ __forceinline__ void diff_unit(const AGAS bf16* __restrict__ proj, long row0, int T, int h, int q0, float lam, float gscale,
                                          const AGAS float* __restrict__ ng, AGAS bf16* __restrict__ out, AGAS float* __restrict__ stash, char* lds) {
  int tid_ = threadIdx.x; asm volatile("" : "+v"(tid_));
  const int tid = tid_, wid = __builtin_amdgcn_readfirstlane(tid >> 6), lane = tid & 63, r32 = lane & 31, hi = lane >> 5;
  char* V_lds = lds + OFF_V; char* K_lds = lds + OFF_K;
  float* ws = (float*)(lds + OFF_WS) + wid * 64; float* li_l = ws; float* al_l = ws + 32;
  const int ksr = tid >> 3, ksc = (tid & 7) * 8;
  const int sr = tid >> 4, sc = (tid & 15) * 8, vst0 = v_st(sr, sc), vst1 = v_st(32 + sr, sc);
  const int kst = KSWZ64(ksr, ksc * 2);
  const int vb0 = (int)(uintptr_t)V_lds + v_rd_base(lane);
  const int NT = T / 64;
  typedef float f32x4v __attribute__((ext_vector_type(4)));
#pragma unroll 1
  for (int c = 0; c < 2; ++c) {
    const AGAS bf16* pj = proj; asm volatile("" : "+s"(pj));
    const AGAS bf16* Qw = pj + (row0 + q0 + wid * 32 + r32) * LDP + h * 128 + c * 64 + hi * 8;
    const AGAS bf16* Kh = pj + row0 * LDP + 1024 + h * 128 + c * 64;
    const AGAS bf16* Vh = pj + row0 * LDP + 2048 + h * 128;
    float m_reg = -1e30f, l_reg = 0.f; f32x16 o[4] = {}; bf16x8 qr[4];
#pragma unroll
    for (int d0 = 0; d0 < 4; ++d0) qr[d0] = ld8(Qw + d0 * 16);
    struct { bf16x8 vs0, vs1, ks0; } sr_[2];
#define SLOAD(i, k0) do { sr_[i].vs0 = ld8(&Vh[(long)((k0) + sr) * LDP + sc]); sr_[i].vs1 = ld8(&Vh[(long)((k0) + 32 + sr) * LDP + sc]); \
      sr_[i].ks0 = ld8(&Kh[(long)((k0) + ksr) * LDP + ksc]); } while (0)
#define SWRITE(b, i) do { *(bf16x8*)(V_lds + (b) * SHM_V + vst0) = sr_[i].vs0; *(bf16x8*)(V_lds + (b) * SHM_V + vst1) = sr_[i].vs1; \
      *(bf16x8*)(K_lds + (b) * SHM_K + kst) = sr_[i].ks0; } while (0)
#define SWAIT() asm volatile("s_waitcnt vmcnt(3)" ::: "memory")
#define RESC(a) do { if (__any((a) < 1.f)) { if (hi == 0) al_l[r32] = (a); asm volatile("s_waitcnt lgkmcnt(0)" ::: "memory"); \
      _Pragma("unroll") for (int d = 0; d < 4; ++d) _Pragma("unroll") for (int r = 0; r < 16; ++r) o[d][r] *= al_l[crow(r, hi)]; } } while (0)
    f32x16 pA0, pA1, pB0, pB1; float mnA, mnB, alA, alB; bf16x8 pa0, pa1, pa2, pa3;
    __syncthreads();
    SLOAD(0, 0); asm volatile("s_waitcnt vmcnt(0)" ::: "memory"); SWRITE(0, 0); __syncthreads();
    d_qkt(pA0, pA1, K_lds, qr, r32, hi); d_partialSM(pA0, pA1, m_reg, mnA, alA);
    SLOAD(1, 64); if (2 < NT) SLOAD(0, 128);
    SWAIT(); SWRITE(1, 1); __syncthreads();
    for (int j = 1; j + 1 < NT; j += 2) {
      SBAR(); d_qkt(pB0, pB1, K_lds + SHM_K, qr, r32, hi);
      d_finishSM(pA0, pA1, alA, l_reg, pa0, pa1, pa2, pa3); SBAR();
      SLOAD(1, (j + 2) * 64); SBAR();
      pv_d0(o, vb0, pa0, pa1, pa2, pa3); d_partialSM(pB0, pB1, m_reg, mnB, alB);
      __syncthreads(); SWAIT(); SWRITE(0, 0);
      RESC(alB); __syncthreads();
      SBAR(); d_qkt(pA0, pA1, K_lds, qr, r32, hi);
      d_finishSM(pB0, pB1, alB, l_reg, pa0, pa1, pa2, pa3); SBAR();
      if (j + 3 < NT) SLOAD(0, (j + 3) * 64); SBAR();
      pv_d0(o, vb0 + SHM_V, pa0, pa1, pa2, pa3); d_partialSM(pA0, pA1, m_reg, mnA, alA);
      __syncthreads(); SWAIT(); SWRITE(1, 1);
      RESC(alA); __syncthreads();
    }
    SBAR(); d_qkt(pB0, pB1, K_lds + SHM_K, qr, r32, hi);
    d_finishSM(pA0, pA1, alA, l_reg, pa0, pa1, pa2, pa3); SBAR();
    pv_d0(o, vb0, pa0, pa1, pa2, pa3); d_partialSM(pB0, pB1, m_reg, mnB, alB);
    __syncthreads(); RESC(alB);
    d_finishSM(pB0, pB1, alB, l_reg, pa0, pa1, pa2, pa3); SBAR();
    pv_d0(o, vb0 + SHM_V, pa0, pa1, pa2, pa3);
#undef SLOAD
#undef SWRITE
#undef SWAIT
#undef RESC
    if (hi == 0) li_l[r32] = l_reg; asm volatile("s_waitcnt lgkmcnt(0)" ::: "memory");
    float rli[16];
#pragma unroll
    for (int r = 0; r < 16; ++r) rli[r] = __builtin_amdgcn_rcpf(li_l[crow(r, hi)]);
    AGAS float* stash_l = stash; asm volatile("" : "+s"(stash_l));
    AGAS f32x4v* st4 = (AGAS f32x4v*)(stash_l + ((size_t)wid * 64 + lane) * 64);
    if (c == 0) {
#pragma unroll
      for (int d0 = 0; d0 < 4; ++d0)
#pragma unroll
        for (int r4 = 0; r4 < 4; ++r4) st4[d0 * 4 + r4] = (f32x4v){o[d0][4 * r4] * rli[4 * r4], o[d0][4 * r4 + 1] * rli[4 * r4 + 1], o[d0][4 * r4 + 2] * rli[4 * r4 + 2], o[d0][4 * r4 + 3] * rli[4 * r4 + 3]};
    } else {
      AGAS bf16* out_l = out; asm volatile("" : "+s"(out_l));
      AGAS bf16* Ow = out_l + (row0 + q0 + wid * 32) * LDO + h * 128 + r32;
      float gv[4];
#pragma unroll
      for (int d0 = 0; d0 < 4; ++d0) gv[d0] = ng[d0 * 32 + r32] * gscale;
#pragma unroll
      for (int r4 = 0; r4 < 4; ++r4) {
        f32x4v s4[4];
#pragma unroll
        for (int d0 = 0; d0 < 4; ++d0) s4[d0] = st4[d0 * 4 + r4];
#pragma unroll
        for (int e = 0; e < 4; ++e) { const int r = 4 * r4 + e;
          float v[4]; float ss = 0.f;
#pragma unroll
          for (int d0 = 0; d0 < 4; ++d0) { v[d0] = s4[d0][e] - lam * (o[d0][r] * rli[r]); ss += v[d0] * v[d0]; }
          ss += __shfl_xor(ss, 1); ss += __shfl_xor(ss, 2); ss += __shfl_xor(ss, 4); ss += __shfl_xor(ss, 8); ss += __shfl_xor(ss, 16);
          const float rstd = 1.0f / sqrtf(ss * (1.0f / 128.0f) + 1e-5f);
          AGAS bf16* ob = Ow; asm volatile("" : "+v"(ob)); AGAS bf16* op = ob + (long)crow(r, hi) * LDO;
#pragma unroll
          for (int d0 = 0; d0 < 4; ++d0) op[d0 * 32] = f2bf1(v[d0] * rstd * gv[d0]);
        }
      }
    }
  }
}

__device__ __forceinline__ void na_qkt(f32x16& p0, f32x16& p1, const char* Ks, const bf16x8* qr, int r32, int hi) {
  p0 = f32x16{}; p1 = f32x16{};
#pragma unroll
  for (int d0 = 0; d0 < 8; ++d0) { const int cb = (d0 * 16 + hi * 8) * 2;
    const bf16x8 b0 = *reinterpret_cast<const bf16x8*>(Ks + KSWZ128(r32, cb));
    const bf16x8 b1 = *reinterpret_cast<const bf16x8*>(Ks + KSWZ128(32 + r32, cb));
    p0 = __builtin_amdgcn_mfma_f32_32x32x16_bf16(b0, qr[d0], p0, 0, 0, 0);
    p1 = __builtin_amdgcn_mfma_f32_32x32x16_bf16(b1, qr[d0], p1, 0, 0, 0); }
}
__device__ __forceinline__ void na_unit(const AGAS bf16* __restrict__ proj, long row0, int rows, int h, int r0, const AGAS float* __restrict__ rpb_h,
                                        AGAS bf16* __restrict__ out, char* lds) {
  int tid_ = threadIdx.x; asm volatile("" : "+v"(tid_));
  const int tid = tid_, wid = __builtin_amdgcn_readfirstlane(tid >> 6), lane = tid & 63, r32 = lane & 31, hi = lane >> 5;
  char* V_lds = lds + OFF_V; char* K_lds = lds + OFF_K;
  float* ws = (float*)(lds + OFF_WS) + wid * 64; float* li_l = ws; float* al_l = ws + 32;
  float* bt = (float*)(lds + OFF_BT);
  constexpr float C = 0.08838834764831845f * LOG2E;
  __syncthreads();
  for (int i = tid; i < 15 * 31; i += 512) bt[i] = rpb_h[i] * LOG2E;
  const int r = r0 + (wid >> 1), cq = (wid & 1) * 32 + r32;
  const int cs = min(max(cq - 8, 0), 48);
  const int rs_w = min(max(r - 4, 0), rows - 8);
  const int kr_lo = min(max(r0 - 4, 0), rows - 8), kr_hi = min(max(r0 - 1, 0), rows - 8) + 8;
  const AGAS bf16* Qw = proj + (row0 + (long)r * 64 + cq) * LDP + 3072 + h * 128 + hi * 8;
  bf16x8 qr[8];
#pragma unroll
  for (int d0 = 0; d0 < 8; ++d0) qr[d0] = ld8(Qw + d0 * 16);
  const int sr = tid >> 4, sc = (tid & 15) * 8, vst0 = v_st(sr, sc), vst1 = v_st(32 + sr, sc);
  const int kst0 = KSWZ128(sr, sc * 2), kst1 = KSWZ128(32 + sr, sc * 2);
  const int vb0 = (int)(uintptr_t)V_lds + v_rd_base(lane);
  const AGAS bf16* Kh = proj + row0 * LDP + 4096 + h * 128; const AGAS bf16* Vh = proj + row0 * LDP + 5120 + h * 128;
  float m_reg = -1e30f, l_reg = 0.f; f32x16 o[4] = {};
  for (int kr = kr_lo; kr < kr_hi; ++kr) {
    const long kb = (long)kr * 64;
    const bf16x8 vs0 = ld8(&Vh[(kb + sr) * LDP + sc]), vs1 = ld8(&Vh[(kb + 32 + sr) * LDP + sc]);
    const bf16x8 ks0 = ld8(&Kh[(kb + sr) * LDP + sc]), ks1 = ld8(&Kh[(kb + 32 + sr) * LDP + sc]);
    __syncthreads();
    *(bf16x8*)(V_lds + vst0) = vs0; *(bf16x8*)(V_lds + vst1) = vs1; *(bf16x8*)(K_lds + kst0) = ks0; *(bf16x8*)(K_lds + kst1) = ks1;
    __syncthreads();
    if (kr >= rs_w && kr < rs_w + 8) {
      f32x16 p0, p1; na_qkt(p0, p1, K_lds, qr, r32, hi);
      const float* btr = bt + (kr - r + 7) * 31;
      float pmax = -INFINITY;
#pragma unroll
      for (int rr = 0; rr < 16; ++rr) {
        const int ck0 = crow(rr, hi), ck1 = ck0 + 32;
        const int ci0 = min(max(ck0 - cq, -15), 15) + 15, ci1 = min(max(ck1 - cq, -15), 15) + 15;
        const float s0 = fmaf(p0[rr], C, btr[ci0]), s1 = fmaf(p1[rr], C, btr[ci1]);
        p0[rr] = (ck0 >= cs && ck0 < cs + 16) ? s0 : -INFINITY; p1[rr] = (ck1 >= cs && ck1 < cs + 16) ? s1 : -INFINITY;
        pmax = fmaxf(pmax, fmaxf(p0[rr], p1[rr]));
      }
      { auto rr = __builtin_amdgcn_permlane32_swap(__float_as_uint(pmax), __float_as_uint(pmax), false, false);
        pmax = fmaxf(__uint_as_float(rr[0]), __uint_as_float(rr[1])); }
      const float mn = fmaxf(m_reg, pmax); const float alpha = __builtin_amdgcn_exp2f(m_reg - mn); m_reg = mn;
      float ps = 0.f;
#pragma unroll
      for (int rr = 0; rr < 16; ++rr) { p0[rr] = __builtin_amdgcn_exp2f(p0[rr] - mn); p1[rr] = __builtin_amdgcn_exp2f(p1[rr] - mn); ps += p0[rr] + p1[rr]; }
      { auto rr = __builtin_amdgcn_permlane32_swap(__float_as_uint(ps), __float_as_uint(ps), false, false);
        ps = __uint_as_float(rr[0]) + __uint_as_float(rr[1]); }
      l_reg = l_reg * alpha + ps;
      if (hi == 0) al_l[r32] = alpha; asm volatile("s_waitcnt lgkmcnt(0)" ::: "memory");
#pragma unroll
      for (int d = 0; d < 4; ++d)
#pragma unroll
        for (int rr = 0; rr < 16; ++rr) o[d][rr] *= al_l[crow(rr, hi)];
      bf16x8 pa0, pa1, pa2, pa3;
      ATT_PK4(p0, 0, pa0); ATT_PK4(p0, 8, pa1); ATT_PK4(p1, 0, pa2); ATT_PK4(p1, 8, pa3);
      SBAR(); pv_d0(o, vb0, pa0, pa1, pa2, pa3);
    }
  }
  if (hi == 0) li_l[r32] = l_reg; asm volatile("s_waitcnt lgkmcnt(0)" ::: "memory");
  float rli[16];
#pragma unroll
  for (int rr = 0; rr < 16; ++rr) rli[rr] = __builtin_amdgcn_rcpf(li_l[crow(rr, hi)]);
  AGAS bf16* out_l = out; asm volatile("" : "+s"(out_l));
  AGAS bf16* Ow = out_l + (row0 + (long)r * 64 + (wid & 1) * 32) * LDO + 1024 + h * 128 + r32;
#pragma unroll
  for (int rr = 0; rr < 16; ++rr) { AGAS bf16* ob = Ow; asm volatile("" : "+v"(ob)); AGAS bf16* op = ob + (long)crow(rr, hi) * LDO;
#pragma unroll
    for (int d0 = 0; d0 < 4; ++d0) op[d0 * 32] = f2bf1(o[d0][rr] * rli[rr]); }
}
#undef SBAR
}

namespace att {
constexpr int D_SLOTK = 8192, D_LDS_K = 0, D_LDS_V = 3 * D_SLOTK, D_LDS_WS = D_LDS_V + 6 * D_SLOTK, D_LDS_END = D_LDS_WS + 8 * 256;
typedef __attribute__((address_space(3))) const char* lds_cptr;
typedef short v4i16_t __attribute__((ext_vector_type(4)));
#define SBAR() __builtin_amdgcn_sched_barrier(0)
#define WAIT_BAR(N) asm volatile("s_waitcnt vmcnt(" #N ") lgkmcnt(0)\n\ts_barrier" ::: "memory")
__device__ __forceinline__ void glds16(const AGAS void* gsrc, unsigned lds_dst) { unsigned keep;
  asm volatile("s_mov_b32 %0, m0\n\ts_mov_b32 m0, %2\n\ts_nop 0\n\tglobal_load_lds_dwordx4 %1, off\n\ts_mov_b32 m0, %0" : "=&s"(keep) : "v"(gsrc), "s"(lds_dst) : "memory"); }
__device__ __forceinline__ unsigned cvtpk_s(float lo, float hi) { typedef float f2_t __attribute__((ext_vector_type(2))); typedef __bf16 b2_t __attribute__((ext_vector_type(2)));
  f2_t v = {lo, hi}; b2_t b = __builtin_convertvector(v, b2_t); return __builtin_bit_cast(unsigned, b); }
__device__ __forceinline__ void kload8(bf16x8* kf, lds_cptr kp) {
  kf[0] = *(const __attribute__((address_space(3))) bf16x8*)(kp);        kf[1] = *(const __attribute__((address_space(3))) bf16x8*)(kp + 512);
  kf[2] = *(const __attribute__((address_space(3))) bf16x8*)(kp + 2048); kf[3] = *(const __attribute__((address_space(3))) bf16x8*)(kp + 2560);
  kf[4] = *(const __attribute__((address_space(3))) bf16x8*)(kp + 4096); kf[5] = *(const __attribute__((address_space(3))) bf16x8*)(kp + 4608);
  kf[6] = *(const __attribute__((address_space(3))) bf16x8*)(kp + 6144); kf[7] = *(const __attribute__((address_space(3))) bf16x8*)(kp + 6656);
}
__device__ __forceinline__ void kload2(bf16x8* kf, lds_cptr kp, int j) { kf[2 * j] = *(const __attribute__((address_space(3))) bf16x8*)(kp + j * 2048); kf[2 * j + 1] = *(const __attribute__((address_space(3))) bf16x8*)(kp + j * 2048 + 512); }
__device__ __forceinline__ s16x4 vtr(lds_cptr p) { return __builtin_bit_cast(s16x4, __builtin_amdgcn_ds_read_tr16_b64_v4i16((__attribute__((address_space(3))) v4i16_t*)p)); }
__device__ __forceinline__ void pv4(f32x16* o, int vb, bf16x8 pa0, bf16x8 pa1, bf16x8 pa2, bf16x8 pa3) {
#pragma unroll
  for (int d0 = 0; d0 < 4; ++d0) { s16x4 lo[4], hi[4];
#pragma unroll
    for (int ks = 0; ks < 4; ++ks) {
      asm volatile("ds_read_b64_tr_b16 %0,%1 offset:%c2" : "=&v"(lo[ks]) : "v"(vb), "i"(d0 * 4096 + ks * 1024) : "memory");
      asm volatile("ds_read_b64_tr_b16 %0,%1 offset:%c2" : "=&v"(hi[ks]) : "v"(vb), "i"(d0 * 4096 + ks * 1024 + 512) : "memory"); }
    asm volatile("s_waitcnt lgkmcnt(0)" ::: "memory"); SBAR();
#define PK(k) (bf16x8){lo[k][0], lo[k][1], lo[k][2], lo[k][3], hi[k][0], hi[k][1], hi[k][2], hi[k][3]}
    o[d0] = __builtin_amdgcn_mfma_f32_32x32x16_bf16(pa0, PK(0), o[d0], 0, 0, 0);
    o[d0] = __builtin_amdgcn_mfma_f32_32x32x16_bf16(pa1, PK(1), o[d0], 0, 0, 0);
    o[d0] = __builtin_amdgcn_mfma_f32_32x32x16_bf16(pa2, PK(2), o[d0], 0, 0, 0);
    o[d0] = __builtin_amdgcn_mfma_f32_32x32x16_bf16(pa3, PK(3), o[d0], 0, 0, 0);
#undef PK
  }
}
template <int THRL>
__device__ __forceinline__ void diff_unit2(const AGAS bf16* __restrict__ proj, long row0, int T, int h, int q0, float lam, float gscale,
                                           const AGAS float* __restrict__ ng, AGAS bf16* __restrict__ out, AGAS float* __restrict__ stash, char* shm) {
  int tid_ = threadIdx.x; asm volatile("" : "+v"(tid_));
  const int tid = tid_, lane = tid & 63, r32 = lane & 31, hi = lane >> 5; const int wid = __builtin_amdgcn_readfirstlane(tid >> 6);
  typedef float f32x4v __attribute__((ext_vector_type(4)));
  const unsigned lds0 = (unsigned)(uintptr_t)shm;
  float* wsf = (float*)(shm + D_LDS_WS) + wid * 64;
  const lds_cptr shm3 = (lds_cptr)shm;
  const int vlane = ((lane >> 4) & 1) * 32 + (lane & 3) * 8 + (4 * hi + ((lane & 15) >> 2)) * 64;
  const lds_cptr kp0 = shm3 + D_LDS_K + hi * 1024 + r32 * 16; const lds_cptr vp0 = shm3 + D_LDS_V + vlane;
  const int vb0 = (int)(lds0 + D_LDS_V) + vlane;
  const unsigned kdst = lds0 + D_LDS_K + wid * 1024, vdst = lds0 + D_LDS_V + wid * 1024;
  const int NT = T / 64;
#pragma unroll 1
  for (int c = 0; c < 2; ++c) {
    const AGAS bf16* pj = proj; asm volatile("" : "+s"(pj));
    const AGAS bf16* Qw = pj + (row0 + q0 + wid * 32) * LDP + h * 128 + c * 64;
    const AGAS bf16* ksrc = pj + (row0 + lane) * LDP + 1024 + h * 128 + c * 64 + wid * 8;
    const AGAS bf16* vsrc = pj + (row0 + 16 * (wid & 3) + (lane >> 2)) * LDP + 2048 + h * 128 + (wid >> 2) * 32 + (lane & 3) * 8;
#define DMA_K(t, slot) glds16(ksrc + (long)(t) * 64 * LDP, (unsigned)__builtin_amdgcn_readfirstlane(kdst + (slot)))
#define DMA_V(t, slot) do { glds16(vsrc + (long)(t) * 64 * LDP, (unsigned)__builtin_amdgcn_readfirstlane(vdst + 2 * (slot))); \
                            glds16(vsrc + (long)(t) * 64 * LDP + 64, (unsigned)__builtin_amdgcn_readfirstlane(vdst + 2 * (slot) + 8192)); } while (0)
    asm volatile("s_waitcnt lgkmcnt(0)\n\ts_barrier" ::: "memory");
    DMA_K(0, 0); DMA_V(0, 0); DMA_K(1, D_SLOTK);
    bf16x8 qr[4];
#pragma unroll
    for (int d0 = 0; d0 < 4; ++d0) qr[d0] = ld8(Qw + (long)r32 * LDP + d0 * 16 + hi * 8);
    float mhat = 0.f, l_reg = 0.f; f32x16 o[4]; o[0] = f32x16{}; o[1] = f32x16{}; o[2] = f32x16{}; o[3] = f32x16{};
    bool resc = false;
#define RESC() do { if (resc) { asm volatile("s_waitcnt lgkmcnt(0)" ::: "memory"); \
      _Pragma("unroll") for (int d_ = 0; d_ < 4; ++d_) _Pragma("unroll") for (int r = 0; r < 16; ++r) o[d_][r] *= wsf[crow(r, hi)]; } } while (0)
    f32x16 pA0, pA1, pB0, pB1; bf16x8 kf[8];
    int sl_prev = 0, sl_cur = 0, sl_next = D_SLOTK;
#define ROT() do { sl_prev = sl_cur; sl_cur = sl_next; sl_next = (sl_next == 2 * D_SLOTK) ? 0 : sl_next + D_SLOTK; } while (0)
    DMA_K(2, 2 * D_SLOTK);
    WAIT_BAR(3);
    { const lds_cptr kb = kp0;
      pA0 = f32x16{}; pA1 = f32x16{};
#pragma unroll
      for (int d0 = 0; d0 < 4; ++d0) {
        const bf16x8 b0 = *(const __attribute__((address_space(3))) bf16x8*)(kb + d0 * 2048), b1 = *(const __attribute__((address_space(3))) bf16x8*)(kb + d0 * 2048 + 512);
        pA0 = __builtin_amdgcn_mfma_f32_32x32x16_bf16(b0, qr[d0], pA0, 0, 0, 0); pA1 = __builtin_amdgcn_mfma_f32_32x32x16_bf16(b1, qr[d0], pA1, 0, 0, 0); }
      float rm = pA0[0];
#pragma unroll
      for (int r = 1; r < 16; ++r) rm = fmaxf(rm, pA0[r]);
#pragma unroll
      for (int r = 0; r < 16; ++r) rm = fmaxf(rm, pA1[r]);
      { auto rr = __builtin_amdgcn_permlane32_swap(__float_as_uint(rm), __float_as_uint(rm), false, false); rm = fmaxf(__uint_as_float(rr[0]), __uint_as_float(rr[1])); }
      mhat = rm;
#pragma unroll
      for (int r = 0; r < 16; ++r) { pA0[r] = __builtin_amdgcn_exp2f(pA0[r] - mhat); pA1[r] = __builtin_amdgcn_exp2f(pA1[r] - mhat); }
    }
    WAIT_BAR(0);
    DMA_K(3, 0); DMA_V(1, D_SLOTK);
    ROT();
    kload8(kf, kp0 + sl_cur);
    WAIT_BAR(3);
    s16x4 vlo[8], vhi[8]; u32x4 pw0, pw1, pw2, pw3;
#define PKW(P, B) cvtpk_s(P[B], P[B + 1])
#define PAF(k) __builtin_bit_cast(bf16x8, pw##k)
#define VFR(i) (bf16x8){vlo[i][0], vlo[i][1], vlo[i][2], vlo[i][3], vhi[i][0], vhi[i][1], vhi[i][2], vhi[i][3]}
#define PIN(x) asm volatile("" : "+v"(x))
#define MX3(a, b, c) __builtin_fmaxf(__builtin_fmaxf((a), (b)), (c))
#define EX(v) __builtin_amdgcn_exp2f(v)
#define MF(a, b, c) __builtin_amdgcn_mfma_f32_32x32x16_bf16(a, b, c, 0, 0, 0)
#define VRD(s, f) do { vlo[s] = vtr(vp_ + (((f) >> 2) * 4096 + ((f) & 3) * 1024)); vhi[s] = vtr(vp_ + (((f) >> 2) * 4096 + ((f) & 3) * 1024 + 512)); } while (0)
#define GAPA(MFS, A0, A1, A2, A3, W0, W1, PW) do { MFS; sacc += A0; sacc += A1; sacc += A2; sacc += A3; PIN(sacc); W0; W1; PIN(PW); SBAR(); } while (0)
#define GAPB(MFS, X, B) do { MFS; X[B] = EX(X[B] - mhat); X[B + 1] = EX(X[B + 1] - mhat); PIN(X); SBAR(); } while (0)
#define KRD(G, j) do { if (G) { kload2(kf, kp0 + sl_next, j); SBAR(); } } while (0)
#define STEP(C0, C1, P0, P1, t, GK, GV, GL) do { SBAR(); \
    const lds_cptr vp_ = vp0 + 2 * sl_prev; \
    VRD(0, 0); SBAR(); float sacc = (P0[0] + P0[1]); \
    GAPA(C0 = MF(kf[0], qr[0], (f32x16{})), P0[2], P0[3], P0[4], P0[5],     pw0[0] = PKW(P0, 0), pw0[1] = PKW(P0, 2), pw0); \
    VRD(1, 4); SBAR(); GAPA(C1 = MF(kf[1], qr[0], (f32x16{})), P0[6], P0[7], P0[8], P0[9],     pw0[2] = PKW(P0, 4), pw0[3] = PKW(P0, 6), pw0); \
    VRD(2, 8); SBAR(); GAPA(C0 = MF(kf[2], qr[1], C0),   P0[10], P0[11], P0[12], P0[13], pw1[0] = PKW(P0, 8), pw1[1] = PKW(P0, 10), pw1); \
    VRD(3, 12); SBAR(); GAPA(C1 = MF(kf[3], qr[1], C1),  P0[14], P0[15], P1[0], P1[1],   pw1[2] = PKW(P0, 12), pw1[3] = PKW(P0, 14), pw1); \
    VRD(4, 1); SBAR(); GAPA(C0 = MF(kf[4], qr[2], C0),   P1[2], P1[3], P1[4], P1[5],     pw2[0] = PKW(P1, 0), pw2[1] = PKW(P1, 2), pw2); \
    VRD(5, 5); SBAR(); GAPA(C1 = MF(kf[5], qr[2], C1),   P1[6], P1[7], P1[8], P1[9],     pw2[2] = PKW(P1, 4), pw2[3] = PKW(P1, 6), pw2); \
    VRD(6, 9); SBAR(); GAPA(C0 = MF(kf[6], qr[3], C0),   P1[10], P1[11], P1[12], P1[13], pw3[0] = PKW(P1, 8), pw3[1] = PKW(P1, 10), pw3); \
    VRD(7, 13); SBAR(); GAPA(C1 = MF(kf[7], qr[3], C1),  P1[14], P1[15], 0.f, 0.f,       pw3[2] = PKW(P1, 12), pw3[3] = PKW(P1, 14), pw3); \
    l_reg += sacc; \
    if (GK) { DMA_K((t) + 3, sl_cur); } if (GV) { DMA_V((t) + 1, sl_next); } \
    { float a = MX3(C0[0], C0[1], C1[0]), b = MX3(C0[2], C0[3], C1[1]); a = MX3(a, C1[2], C1[3]); \
      _Pragma("unroll") for (int r = 4; r < 16; r += 4) { a = MX3(a, C0[r], C0[r + 1]); b = MX3(b, C0[r + 2], C0[r + 3]); a = MX3(a, C1[r], C1[r + 1]); b = MX3(b, C1[r + 2], C1[r + 3]); } \
      float rm = __builtin_fmaxf(a, b); { auto rr = __builtin_amdgcn_permlane32_swap(__float_as_uint(rm), __float_as_uint(rm), false, false); rm = __builtin_fmaxf(__uint_as_float(rr[0]), __uint_as_float(rr[1])); } \
      resc = false; \
      if (__builtin_expect(__any(rm - mhat > (float)THRL), 0)) { const float dl = __builtin_fmaxf(rm - mhat, 0.f); mhat += dl; \
        const float f = __builtin_amdgcn_exp2f(-dl); l_reg *= f; if (hi == 0) wsf[r32] = f; resc = true; } } \
    SBAR(); \
    GAPB(o[0] = MF(PAF(0), VFR(0), o[0]), C0, 0);  VRD(0, 2); SBAR(); \
    GAPB(o[1] = MF(PAF(0), VFR(1), o[1]), C0, 2);  VRD(1, 6); SBAR(); \
    GAPB(o[2] = MF(PAF(0), VFR(2), o[2]), C0, 4);  VRD(2, 10); SBAR(); \
    GAPB(o[3] = MF(PAF(0), VFR(3), o[3]), C0, 6);  VRD(3, 14); SBAR(); \
    GAPB(o[0] = MF(PAF(1), VFR(4), o[0]), C0, 8);  VRD(4, 3); SBAR(); \
    GAPB(o[1] = MF(PAF(1), VFR(5), o[1]), C0, 10); VRD(5, 7); SBAR(); \
    GAPB(o[2] = MF(PAF(1), VFR(6), o[2]), C0, 12); VRD(6, 11); SBAR(); \
    GAPB(o[3] = MF(PAF(1), VFR(7), o[3]), C0, 14); VRD(7, 15); SBAR(); \
    GAPB(o[0] = MF(PAF(2), VFR(0), o[0]), C1, 0);  KRD(GL, 0); \
    GAPB(o[1] = MF(PAF(2), VFR(1), o[1]), C1, 2);  KRD(GL, 1); \
    GAPB(o[2] = MF(PAF(2), VFR(2), o[2]), C1, 4);  KRD(GL, 2); \
    GAPB(o[3] = MF(PAF(2), VFR(3), o[3]), C1, 6);  KRD(GL, 3); \
    GAPB(o[0] = MF(PAF(3), VFR(4), o[0]), C1, 8); \
    GAPB(o[1] = MF(PAF(3), VFR(5), o[1]), C1, 10); \
    GAPB(o[2] = MF(PAF(3), VFR(6), o[2]), C1, 12); \
    GAPB(o[3] = MF(PAF(3), VFR(7), o[3]), C1, 14); \
    } while (0)
#define ENDW(tt) do { if ((tt) + 3 < NT) { WAIT_BAR(3); } else if ((tt) + 2 < NT) { WAIT_BAR(2); } else { WAIT_BAR(0); } } while (0)
    int t = 1;
    for (; t + 5 < NT; t += 2) {
      STEP(pB0, pB1, pA0, pA1, t, true, true, true);       WAIT_BAR(3); RESC(); ROT();
      STEP(pA0, pA1, pB0, pB1, t + 1, true, true, true);   WAIT_BAR(3); RESC(); ROT();
    }
    for (; t + 1 < NT; t += 2) {
      STEP(pB0, pB1, pA0, pA1, t, (t + 3 < NT), (t + 1 < NT), (t + 1 < NT));         ENDW(t);     RESC(); ROT();
      STEP(pA0, pA1, pB0, pB1, t + 1, (t + 4 < NT), (t + 2 < NT), (t + 2 < NT));     ENDW(t + 1); RESC(); ROT();
    }
    STEP(pB0, pB1, pA0, pA1, NT - 1, false, false, false); RESC();
    { float sacc = pB0[0] + pB0[1];
#pragma unroll
      for (int r = 2; r < 16; ++r) sacc += pB0[r];
#pragma unroll
      for (int r = 0; r < 16; ++r) sacc += pB1[r];
      l_reg += sacc;
      pw0 = (u32x4){PKW(pB0, 0), PKW(pB0, 2), PKW(pB0, 4), PKW(pB0, 6)}; pw1 = (u32x4){PKW(pB0, 8), PKW(pB0, 10), PKW(pB0, 12), PKW(pB0, 14)};
      pw2 = (u32x4){PKW(pB1, 0), PKW(pB1, 2), PKW(pB1, 4), PKW(pB1, 6)}; pw3 = (u32x4){PKW(pB1, 8), PKW(pB1, 10), PKW(pB1, 12), PKW(pB1, 14)};
      SBAR(); pv4(o, vb0 + 2 * sl_cur, PAF(0), PAF(1), PAF(2), PAF(3)); }
#undef PKW
#undef PAF
#undef VFR
#undef PIN
#undef MX3
#undef EX
#undef MF
#undef VRD
#undef GAPA
#undef GAPB
#undef KRD
#undef STEP
#undef ENDW
#undef DMA_K
#undef DMA_V
#undef RESC
#undef ROT
    { auto rr = __builtin_amdgcn_permlane32_swap(__float_as_uint(l_reg), __float_as_uint(l_reg), false, false); l_reg = __uint_as_float(rr[0]) + __uint_as_float(rr[1]); }
    if (hi == 0) wsf[32 + r32] = l_reg; asm volatile("s_waitcnt lgkmcnt(0)" ::: "memory");
    float rli[16];
#pragma unroll
    for (int r = 0; r < 16; ++r) rli[r] = __builtin_amdgcn_rcpf(wsf[32 + crow(r, hi)]);
    AGAS float* stash_l = stash; asm volatile("" : "+s"(stash_l));
    AGAS f32x4v* st4 = (AGAS f32x4v*)(stash_l + ((size_t)wid * 64 + lane) * 64);
    if (c == 0) {
#pragma unroll
      for (int d0 = 0; d0 < 4; ++d0)
#pragma unroll
        for (int r4 = 0; r4 < 4; ++r4) st4[d0 * 4 + r4] = (f32x4v){o[d0][4 * r4] * rli[4 * r4], o[d0][4 * r4 + 1] * rli[4 * r4 + 1], o[d0][4 * r4 + 2] * rli[4 * r4 + 2], o[d0][4 * r4 + 3] * rli[4 * r4 + 3]};
    } else {
      AGAS bf16* out_l = out; asm volatile("" : "+s"(out_l));
      AGAS bf16* Ow = out_l + (row0 + q0 + wid * 32) * LDO + h * 128 + r32;
      float gv[4];
#pragma unroll
      for (int d0 = 0; d0 < 4; ++d0) gv[d0] = ng[d0 * 32 + r32] * gscale;
#pragma unroll
      for (int r4 = 0; r4 < 4; ++r4) {
        f32x4v s4[4];
#pragma unroll
        for (int d0 = 0; d0 < 4; ++d0) s4[d0] = st4[d0 * 4 + r4];
#pragma unroll
        for (int e = 0; e < 4; ++e) { const int r = 4 * r4 + e;
          float v[4]; float ss = 0.f;
#pragma unroll
          for (int d0 = 0; d0 < 4; ++d0) { v[d0] = s4[d0][e] - lam * (o[d0][r] * rli[r]); ss += v[d0] * v[d0]; }
          ss += __shfl_xor(ss, 1); ss += __shfl_xor(ss, 2); ss += __shfl_xor(ss, 4); ss += __shfl_xor(ss, 8); ss += __shfl_xor(ss, 16);
          const float rstd = 1.0f / sqrtf(ss * (1.0f / 128.0f) + 1e-5f);
          AGAS bf16* ob = Ow; asm volatile("" : "+v"(ob)); AGAS bf16* op = ob + (long)crow(r, hi) * LDO;
#pragma unroll
          for (int d0 = 0; d0 < 4; ++d0) op[d0 * 32] = f2bf1(v[d0] * rstd * gv[d0]);
        }
      }
    }
  }
  asm volatile("s_waitcnt lgkmcnt(0)\n\ts_barrier" ::: "memory");
}
#undef SBAR
#undef WAIT_BAR
}

#define GAS __attribute__((address_space(1)))
#define LAS __attribute__((address_space(3)))
typedef unsigned short bf16;
typedef unsigned v4u __attribute__((ext_vector_type(4)));
typedef float f32x4 __attribute__((ext_vector_type(4)));
typedef short bf16x8 __attribute__((ext_vector_type(8)));
typedef GAS unsigned gu32;
typedef GAS unsigned long long gu64;
#define RLX_AGENT __ATOMIC_RELAXED, __HIP_MEMORY_SCOPE_AGENT
#define LDS_WAIT() asm volatile("s_waitcnt lgkmcnt(0)" ::: "memory")
#define VM_WAIT() asm volatile("s_waitcnt vmcnt(0)" ::: "memory")
__device__ __forceinline__ unsigned long long rt() { return __builtin_amdgcn_s_memrealtime(); }
__device__ __forceinline__ unsigned f2bf(float f) { unsigned u = __builtin_bit_cast(unsigned, f); return (u + 0x7fffu + ((u >> 16) & 1u)) >> 16; }
__device__ __forceinline__ unsigned pk2(float lo, float hi) { return f2bf(lo) | (f2bf(hi) << 16); }
#define XB_TMO      128
#define XB_XCNT(j)  (256  + 64 * (j))
#define XB_XSUB(j)  (1280 + 64 * (j))
#define XB_XGEN(j)  (2304 + 64 * (j))
#define XB_TOP      3328
#define XB_TOPGEN   3392
#define XCD_BAR_WORDS 3456
#define XB_SPIN_CAP (1u << 18)

__device__ __forceinline__ unsigned xb_ld(unsigned* p)              { return __hip_atomic_load(p, __ATOMIC_RELAXED, __HIP_MEMORY_SCOPE_AGENT); }
__device__ __forceinline__ unsigned xb_add(unsigned* p, unsigned v) { return __hip_atomic_fetch_add(p, v, __ATOMIC_RELAXED, __HIP_MEMORY_SCOPE_AGENT); }
__device__ __forceinline__ unsigned xb_xcc_id() { return (unsigned)__builtin_amdgcn_s_getreg((3 << 11) | 20) & 0xFu; }
#define XB_SPIN(cond, bar) do { unsigned _sp = 0; while (cond) { __builtin_amdgcn_s_sleep(1); \
    if ((++_sp & 255u) == 0u) { if (xb_ld(&(bar)[XB_TMO])) break; if (_sp > XB_SPIN_CAP) { atomicAdd(&(bar)[XB_TMO], 1u); break; } } } } while (0)

struct XcdBarrier {
    unsigned* bar; unsigned x;
    volatile LAS unsigned* st;
};

__device__ __forceinline__ XcdBarrier xcd_barrier_post(unsigned* bar, volatile LAS unsigned* st) {
    XcdBarrier b; b.bar = bar; b.x = xb_xcc_id(); b.st = st;
    if (threadIdx.x == 0) (void)xb_add(&bar[XB_XCNT(b.x)], 1u);
    return b;
}
__device__ __forceinline__ void xcd_barrier_complete(unsigned* bar, unsigned x, unsigned& nloc, unsigned& nx) {
    const unsigned G = gridDim.x * gridDim.y * gridDim.z;
    unsigned sum, cnt, mine, sp = 0u;
    for (;;) {
        sum = 0u; cnt = 0u; mine = 0u;
#pragma unroll
        for (unsigned j = 0; j < 16; ++j) { const unsigned c = xb_ld(&bar[XB_XCNT(j)]); sum += c; cnt += (c > 0u) ? 1u : 0u; mine = (j == x) ? c : mine; }
        if (sum == G) break;
        __builtin_amdgcn_s_sleep(1);
        if ((++sp & 255u) == 0u) { if (xb_ld(&bar[XB_TMO])) break; if (sp > XB_SPIN_CAP) { atomicAdd(&bar[XB_TMO], 1u); break; } }
    }
    nloc = mine > 0u ? mine : 1u; nx = cnt > 0u ? cnt : 1u;
}

__device__ __forceinline__ void xcd_barrier(const XcdBarrier& b) {
    asm volatile("s_waitcnt vmcnt(0)" ::: "memory");
    __syncthreads();
    unsigned bx_ = b.x; asm volatile("" : "+s"(bx_));
    if (threadIdx.x == 0) {
        unsigned* bar = b.bar; asm volatile("" : "+s"(bar));
        __builtin_amdgcn_s_waitcnt(0);
        unsigned nloc = b.st[0], nx = b.st[1];
        if (nloc == 0u) { xcd_barrier_complete(bar, bx_, nloc, nx); b.st[0] = nloc; b.st[1] = nx; }
        const unsigned old = xb_add(&bar[XB_XSUB(bx_)], 1u);
        const unsigned gen = old / nloc;
        if (old + 1u == (gen + 1u) * nloc) {
            __builtin_amdgcn_fence(__ATOMIC_RELEASE, "agent");
            asm volatile("s_waitcnt vmcnt(0)" ::: "memory");
            const unsigned og = xb_add(&bar[XB_TOP], 1u);
            const unsigned tg = og / nx;
            if (og + 1u == (tg + 1u) * nx) xb_add(&bar[XB_TOPGEN], 1u);
            else XB_SPIN(xb_ld(&bar[XB_TOPGEN]) == tg, bar);
            __builtin_amdgcn_fence(__ATOMIC_ACQUIRE, "agent");
            xb_add(&bar[XB_XGEN(bx_)], 1u);
            asm volatile("s_waitcnt vmcnt(0)" ::: "memory");
        } else {
            XB_SPIN(xb_ld(&bar[XB_XGEN(bx_)]) == gen, bar);
            __builtin_amdgcn_fence(__ATOMIC_ACQUIRE, "agent");
            asm volatile("s_waitcnt vmcnt(0)" ::: "memory");
        }
    }
    __syncthreads();
}
constexpr int NWAVES = 8;
constexpr int DM = 2048, DFF = 5632, NGU = 2 * DFF, NIN = 6144, NLAYER = 2;
constexpr int MP = 8 * 4096, MS = 2 * 16384, M = MP + MS;
constexpr int NB = 10, MODW = 9 * DM;
constexpr float LN_EPS = 1e-5f;
constexpr float DN_ALPHA = 1.4142135623730951f;

constexpr size_t MiB = 1u << 20;
constexpr size_t WS_CTL = 0, CTL_ZERO_BYTES = 1 * MiB;
constexpr size_t WS_MODV = 1 * MiB;
constexpr size_t WS_ROPE = 3 * MiB;
constexpr size_t WS_MISC = 7 * MiB;
constexpr size_t WS_W = 8 * MiB;
constexpr size_t WO_GU1 = 0, WO_D1 = 44 * MiB, WO_IN = 66 * MiB, WO_OUT = 90 * MiB, WO_GU2 = 98 * MiB, WO_D2 = 142 * MiB, W_BYTES = 164 * MiB;
constexpr size_t WS_HA = WS_W + W_BYTES;
constexpr size_t WS_HB = WS_HA + 256 * MiB;
constexpr size_t WS_BIG = WS_HB + 256 * MiB;
constexpr size_t WS_END = WS_BIG + 768 * MiB;
static_assert((size_t)NGU * DM * 2 == 44 * MiB && (size_t)DM * DFF * 2 == 22 * MiB && (size_t)NIN * DM * 2 == 24 * MiB && (size_t)DM * DM * 2 == 8 * MiB, "weight map");
static_assert((size_t)M * NIN * 2 == 768 * MiB && (size_t)M * DM * 2 == 256 * MiB, "activation map");
constexpr int CW_BAR = 4096;

constexpr int RING_OFF = 0, RING_BYTES = 131072;
constexpr int LDSCTL_OFF = RING_BYTES, MISC_OFF = LDSCTL_OFF + 320;
constexpr int LDS_BYTES = 147456;

__device__ __forceinline__ float wave_sum(float v) {
#pragma unroll
    for (int o = 1; o < 64; o <<= 1) v += __shfl_xor(v, o);
    return v;
}
template <int MODE> __device__ __forceinline__ int dest_row(int s) {
    if (MODE == 1) { const int half = s >= DFF ? 1 : 0; const int j = s - half * DFF; return 256 * (j >> 7) + 128 * half + (j & 127); }
    if (MODE == 2) { if (s < 2048) { const int d = s & 63; const int p = d < 32 ? 2 * d : 2 * (d - 32) + 1; return (s & ~63) + p; } return s; }
    return s;
}
template <int MODE> __device__ __forceinline__ void transpose_item(const float* W, int K, int N, bf16* WT, LAS float* scr, int item, int lane) {
    const int nblk = N / 32, kb = item / nblk, nb = item % nblk, k0 = 64 * kb, n0 = 32 * nb;
#pragma unroll 8
    for (int i = 0; i < 32; ++i) { const int kk = 2 * i + (lane >> 5); scr[kk * 33 + (lane & 31)] = W[(size_t)(k0 + kk) * N + n0 + (lane & 31)]; }
    LDS_WAIT(); asm volatile("" ::: "memory");
    const int c = lane & 7;
#pragma unroll
    for (int j = 0; j < 4; ++j) { const int n = (lane >> 3) + 8 * j; const LAS float* s = scr + (8 * c) * 33 + n;
        v4u o; o.x = pk2(s[0 * 33], s[1 * 33]); o.y = pk2(s[2 * 33], s[3 * 33]); o.z = pk2(s[4 * 33], s[5 * 33]); o.w = pk2(s[6 * 33], s[7 * 33]);
        *(GAS v4u*)(WT + (size_t)dest_row<MODE>(n0 + n) * K + k0 + 8 * c) = o; }
    LDS_WAIT(); asm volatile("" ::: "memory");
}
struct Args { const GAS float* in[20]; GAS float* out; GAS unsigned char* ws; };

typedef const __attribute__((address_space(4))) Args* KArgsT;
__device__ __forceinline__ void convert_layer(KArgsT a, int l, unsigned char* wsw, LAS float* scr, int gw, int NGW, int lane) {
    constexpr int I_GU = (DM / 64) * (NGU / 32), I_D = (DFF / 64) * (DM / 32), I_IN = (DM / 64) * (NIN / 32), I_O = (DM / 64) * (DM / 32);
    constexpr int NITEMS = 2 * I_GU + 2 * I_D + I_IN + I_O;
    asm volatile("" : "+v"(lane));
    for (int it = gw; it < NITEMS; it += NGW) {
        int r = it;
        if (r < I_GU) { transpose_item<1>(((const float*)a->in[8]) + (size_t)l * DM * NGU, DM, NGU, (bf16*)(wsw + WO_GU1), scr, r, lane); continue; } r -= I_GU;
        if (r < I_D)  { transpose_item<0>(((const float*)a->in[9]) + (size_t)l * DFF * DM, DFF, DM, (bf16*)(wsw + WO_D1), scr, r, lane); continue; } r -= I_D;
        if (r < I_IN) { transpose_item<2>(((const float*)a->in[10]) + (size_t)l * DM * NIN, DM, NIN, (bf16*)(wsw + WO_IN), scr, r, lane); continue; } r -= I_IN;
        if (r < I_O)  { transpose_item<0>(((const float*)a->in[11]) + (size_t)l * DM * DM, DM, DM, (bf16*)(wsw + WO_OUT), scr, r, lane); continue; } r -= I_O;
        if (r < I_GU) { transpose_item<1>(((const float*)a->in[18]) + (size_t)l * DM * NGU, DM, NGU, (bf16*)(wsw + WO_GU2), scr, r, lane); continue; } r -= I_GU;
        transpose_item<0>(((const float*)a->in[19]) + (size_t)l * DFF * DM, DFF, DM, (bf16*)(wsw + WO_D2), scr, r, lane);
    }
}
__device__ __forceinline__ int batch_of_row(int m) { return m < MP ? (m >> 12) : 8 + ((m - MP) >> 14); }
__device__ __forceinline__ void mod_rows(const float* xp, const float* xs, bf16* hout, const float* modl, int sh_idx, int gw, int NGW, int lane) {
    asm volatile("" : "+v"(lane));
    for (int m = gw; m < M; m += NGW) {
        const float* xr = m < MP ? xp + (size_t)m * DM : xs + (size_t)(m - MP) * DM;
        const float* mb = modl + (size_t)batch_of_row(m) * MODW;
        GAS unsigned long long* o8 = (GAS unsigned long long*)(hout + (size_t)m * DM) + lane;
#pragma unroll
        for (int j = 0; j < 8; ++j) { const int col = 4 * lane + 256 * j;
            const f32x4 v = *(const GAS f32x4*)(xr + col), sh = *(const GAS f32x4*)(mb + sh_idx * DM + col), sc = *(const GAS f32x4*)(mb + (sh_idx + 1) * DM + col);
            const f32x4 hv = v * (sc + 1.0f) + sh;
            o8[64 * j] = (unsigned long long)pk2(hv.x, hv.y) | ((unsigned long long)pk2(hv.z, hv.w) << 32); }
    }
}
__device__ __forceinline__ void ln_rows(float* y, bf16* hout, const float* lng, const float* lnb, const float* modl, int sh_idx, int gw, int NGW, int lane) {
    asm volatile("" : "+v"(lane));
    for (int m = gw; m < M; m += NGW) {
        GAS f32x4* yr = (GAS f32x4*)(y + (size_t)m * DM) + lane;
        f32x4 v[8]; float s = 0.f;
#pragma unroll
        for (int j = 0; j < 8; ++j) { v[j] = yr[64 * j]; s += (v[j].x + v[j].y) + (v[j].z + v[j].w); }
        const float mean = wave_sum(s) * (1.f / DM); float s2 = 0.f;
#pragma unroll
        for (int j = 0; j < 8; ++j) { v[j] = v[j] - mean; s2 += (v[j].x * v[j].x + v[j].y * v[j].y) + (v[j].z * v[j].z + v[j].w * v[j].w); }
        const float rstd = 1.f / sqrtf(wave_sum(s2) * (1.f / DM) + LN_EPS);
        const float* mb = modl + (size_t)batch_of_row(m) * MODW;
        GAS unsigned long long* o8 = (GAS unsigned long long*)(hout + (size_t)m * DM) + lane;
#pragma unroll
        for (int j = 0; j < 8; ++j) { const int col = 4 * lane + 256 * j;
            const f32x4 g = *(const GAS f32x4*)(lng + col), b = *(const GAS f32x4*)(lnb + col);
            const f32x4 xv = v[j] * rstd * g + b;
            yr[64 * j] = xv;
            if (hout) { const f32x4 sh = *(const GAS f32x4*)(mb + sh_idx * DM + col), sc = *(const GAS f32x4*)(mb + (sh_idx + 1) * DM + col);
                const f32x4 hv = xv * (sc + 1.0f) + sh;
                o8[64 * j] = (unsigned long long)pk2(hv.x, hv.y) | ((unsigned long long)pk2(hv.z, hv.w) << 32); } }
    }
}
#ifdef PROBE_LN_REP
__device__ __forceinline__ void ln_dummy(float* y, bf16* hout, const float* modl, int sh_idx, int gw, int NGW, int lane) {
    asm volatile("" : "+v"(lane));
    for (int m = gw; m < M; m += NGW) {
        GAS f32x4* yr = (GAS f32x4*)(y + (size_t)m * DM) + lane;
        f32x4 v[8]; float s = 0.f;
#pragma unroll
        for (int j = 0; j < 8; ++j) { v[j] = yr[64 * j]; s += (v[j].x + v[j].y) + (v[j].z + v[j].w); }
        const float mean = wave_sum(s) * (1.f / DM); float s2 = 0.f;
#pragma unroll
        for (int j = 0; j < 8; ++j) { const f32x4 d = v[j] - mean; s2 += (d.x * d.x + d.y * d.y) + (d.z * d.z + d.w * d.w); }
        const float rstd = 1.f / sqrtf(wave_sum(s2) * (1.f / DM) + LN_EPS);
        const float keep = rstd > 1e30f ? 0.f : 1.f;
        const float* mb = modl + (size_t)batch_of_row(m) * MODW;
        GAS unsigned long long* o8 = (GAS unsigned long long*)(hout + (size_t)m * DM) + lane;
#pragma unroll
        for (int j = 0; j < 8; ++j) { const int col = 4 * lane + 256 * j;
            const f32x4 xv = v[j] * keep;
            yr[64 * j] = xv;
            const f32x4 sh = *(const GAS f32x4*)(mb + sh_idx * DM + col), sc = *(const GAS f32x4*)(mb + (sh_idx + 1) * DM + col);
            const f32x4 hv = xv * (sc + 1.0f) + sh;
            o8[64 * j] = (unsigned long long)pk2(hv.x, hv.y) | ((unsigned long long)pk2(hv.z, hv.w) << 32); }
    }
}
#endif
__device__ __forceinline__ void modv_phase(KArgsT a, float* modv, LAS unsigned char* lds, int G, int tid, int wave, int lane) {
    LAS float* sc = (LAS float*)lds;
    LAS float* red = (LAS float*)(lds + NB * DM * 4);
    constexpr int NCH = MODW / 128, NIT = NLAYER * NCH;
    if ((int)blockIdx.x >= NIT) return;
    for (int i = tid; i < NB * DM; i += NWAVES * 64) { const int b = i / DM, k = i % DM; const float cv = b < 8 ? ((const float*)a->in[2])[b * DM + k] : ((const float*)a->in[3])[(b - 8) * DM + k];
        sc[i] = cv / (1.0f + __expf(-cv)); }
    __syncthreads();
    for (int it = blockIdx.x; it < NIT; it += G) {
        const int l = it / NCH, ch = it % NCH;
        const float* wp = ((const float*)a->in[4]) + ((size_t)l * DM + wave * 256) * MODW + ch * 128 + 2 * lane;
        float ax[NB], ay[NB];
#pragma unroll
        for (int b = 0; b < NB; ++b) { ax[b] = 0.f; ay[b] = 0.f; }
        for (int k = 0; k < 256; k += 4) {
            typedef float f32x2v __attribute__((ext_vector_type(2)));
            const f32x2v w0 = *(const GAS f32x2v*)(wp + (size_t)(k + 0) * MODW), w1 = *(const GAS f32x2v*)(wp + (size_t)(k + 1) * MODW);
            const f32x2v w2 = *(const GAS f32x2v*)(wp + (size_t)(k + 2) * MODW), w3 = *(const GAS f32x2v*)(wp + (size_t)(k + 3) * MODW);
#pragma unroll
            for (int b = 0; b < NB; ++b) { const f32x4 s4 = *(const LAS f32x4*)(sc + b * DM + wave * 256 + k);
                ax[b] += s4.x * w0.x + s4.y * w1.x + s4.z * w2.x + s4.w * w3.x; ay[b] += s4.x * w0.y + s4.y * w1.y + s4.z * w2.y + s4.w * w3.y; }
        }
#pragma unroll
        for (int b = 0; b < NB; ++b) { red[(wave * NB + b) * 128 + 2 * lane] = ax[b]; red[(wave * NB + b) * 128 + 2 * lane + 1] = ay[b]; }
        __syncthreads();
        for (int o = tid; o < NB * 128; o += NWAVES * 64) { const int b = o / 128, cc = o % 128; float s = 0.f;
#pragma unroll
            for (int w = 0; w < NWAVES; ++w) s += red[(w * NB + b) * 128 + cc];
            modv[((size_t)l * NB + b) * MODW + ch * 128 + cc] = s + ((const float*)a->in[5])[(size_t)l * MODW + ch * 128 + cc]; }
        __syncthreads();
    }
}
__device__ const double ROPE_INVF[32] = {1.0,0.7498942093324559,0.5623413251903491,0.4216965034285822,0.31622776601683794,0.23713737056616552,0.1778279410038923,0.1333521432163324,0.1,0.07498942093324558,0.05623413251903491,0.042169650342858224,0.03162277660168379,0.023713737056616554,0.01778279410038923,0.01333521432163324,0.01,0.007498942093324558,0.005623413251903491,0.004216965034285823,0.0031622776601683794,0.0023713737056616554,0.0017782794100389228,0.001333521432163324,0.001,0.0007498942093324559,0.0005623413251903491,0.00042169650342858224,0.00031622776601683794,0.00023713737056616554,0.00017782794100389227,0.0001333521432163324};
__device__ __forceinline__ void rope_tables(float* ropeC, float* ropeS, int gtid, int nthr) {
    for (int idx = gtid; idx < 16384 * 32; idx += nthr) {
        const int t = idx >> 5, i = idx & 31; const double x = (double)t * ROPE_INVF[i];
        const double q = __builtin_rint(x * 0.63661977236758134308);
        double r = __builtin_fma(-q, 1.57079632679489655800e+00, x); r = __builtin_fma(-q, 6.12323399573676603587e-17, r);
        const double r2 = r * r;
        const double sp = r + r * r2 * (-1.0 / 6 + r2 * (1.0 / 120 + r2 * (-1.0 / 5040 + r2 * (1.0 / 362880 + r2 * (-1.0 / 39916800 + r2 * (1.0 / 6227020800.0))))));
        const double cp = 1.0 + r2 * (-0.5 + r2 * (1.0 / 24 + r2 * (-1.0 / 720 + r2 * (1.0 / 40320 + r2 * (-1.0 / 3628800 + r2 * (1.0 / 479001600.0 + r2 * (-1.0 / 87178291200.0)))))));
        const int qi = ((int)q) & 3;
        const double sv = qi == 0 ? sp : qi == 1 ? cp : qi == 2 ? -sp : -cp;
        const double cv = qi == 0 ? cp : qi == 1 ? -sp : qi == 2 ? -cp : sp;
        ropeC[idx] = (float)cv; ropeS[idx] = (float)sv;
    }
}

#ifndef PH
#define PH 0xFFFF
#endif
#define LAUNDER_S(p) asm volatile("" : "+s"(p))
typedef const __attribute__((address_space(4))) Args* KArgs;
__device__ __forceinline__ KArgs kargs() { KArgs p = (KArgs)__builtin_amdgcn_kernarg_segment_ptr(); LAUNDER_S(p); return p; }
constexpr float LAM_INIT0 = 0.2f, LAM_INIT1 = 0.35550906759096926f;

__global__ void __launch_bounds__(NWAVES * 64, 2) mega_fwd(Args args_unused) {
    extern __shared__ __attribute__((aligned(16))) unsigned char lds[];
    LAS unsigned char* L = (LAS unsigned char*)lds;
    volatile LAS unsigned* MISC = (volatile LAS unsigned*)(L + MISC_OFF);
    const int tid = threadIdx.x, lane = tid & 63, wave = __builtin_amdgcn_readfirstlane(tid >> 6);
    const int G = gridDim.x; const int bx = blockIdx.x; const int vcu = (G % 8 == 0) ? (bx % 8) * (G / 8) + bx / 8 : bx;
    const int gw = vcu * NWAVES + wave, NGW = G * NWAVES;
    for (int u = tid; u < (LDS_BYTES - LDSCTL_OFF) / 4; u += NWAVES * 64) ((LAS unsigned*)(L + LDSCTL_OFF))[u] = 0u;
    __syncthreads();
    XcdBarrier bar;
    { KArgs ap = kargs(); bar = xcd_barrier_post((unsigned*)(((unsigned char*)ap->ws) + WS_CTL) + CW_BAR, MISC + 8); }
#ifdef PROBE_BAR_REP
#define GRID_BAR() do { _Pragma("unroll 1") for (int rep_ = 0; rep_ < PROBE_BAR_REP; ++rep_) xcd_barrier(bar); } while (0)
#else
#define GRID_BAR() xcd_barrier(bar)
#endif
    LAS float* scr = (LAS float*)(L + RING_OFF + wave * 16384);

    {
        KArgs ap = kargs(); unsigned char* ws = ((unsigned char*)ap->ws);
#if PH & 1
        modv_phase(ap, (float*)(ws + WS_MODV), L, G, tid, wave, lane);
        rope_tables((float*)(ws + WS_ROPE), (float*)(ws + WS_ROPE) + 16384 * 32, bx * (NWAVES * 64) + tid, G * NWAVES * 64);
#endif
        if (bx == 0 && wave == 0) {
            float* lamv = (float*)(ws + WS_MISC);
#pragma unroll
            for (int l = 0; l < NLAYER; ++l) {
                const float s1 = wave_sum(((const float*)ap->in[12])[l * 64 + lane] * ((const float*)ap->in[13])[l * 64 + lane]), s2 = wave_sum(((const float*)ap->in[14])[l * 64 + lane] * ((const float*)ap->in[15])[l * 64 + lane]);
                if (lane == 0) lamv[l] = expf(s1) - expf(s2) + (l == 0 ? LAM_INIT0 : LAM_INIT1);
            }
        }
        __syncthreads();
#if PH & 2
#ifdef PROBE_CONV_REP
#pragma unroll 1
        for (int rep = 1; rep < PROBE_CONV_REP; ++rep) convert_layer(ap, 0, ws + WS_W, scr, gw, NGW, lane);
#endif
        convert_layer(ap, 0, ws + WS_W, scr, gw, NGW, lane);
#endif
    }
    GRID_BAR();
    {
        KArgs ap = kargs(); unsigned char* ws = ((unsigned char*)ap->ws);
#if PH & 4
        mod_rows(((const float*)ap->in[0]), ((const float*)ap->in[1]), (bf16*)(ws + WS_HA), (const float*)(ws + WS_MODV), 0, gw, NGW, lane);
#endif
    }
    GRID_BAR();

#pragma unroll 1
    for (int l = 0; l < NLAYER; ++l) {
        { KArgs ap = kargs(); unsigned char* ws = ((unsigned char*)ap->ws);
          pg8::Gemm g{(const bf16*)(ws + WS_HA), (const bf16*)(ws + WS_W + WO_GU1), M, NGU, DM}; pg8::StaticOrder S; { int g_ = G, c_ = bx; LAUNDER_S(g_); LAUNDER_S(c_); S.init(M, NGU, g_, c_); }
          pg8::EpiSwiGLU E{(bf16*)(ws + WS_BIG), DFF};
#if PH & 8
#ifdef PROBE_G1_REP
#pragma unroll 1
          for (int rep = 0; rep < PROBE_G1_REP; ++rep)
#endif
          pg8::gemm_phase<pg8::EpiSwiGLU, pg8::StaticOrder, true, true>(L + RING_OFF, g, S, E);
#endif
        }
        GRID_BAR();
        { KArgs ap = kargs(); unsigned char* ws = ((unsigned char*)ap->ws); float* out = ((float*)ap->out);
          const float* xsrc_p = l == 0 ? ((const float*)ap->in[0]) : out; const float* xsrc_s = l == 0 ? ((const float*)ap->in[1]) : out + (size_t)MP * DM;
          pg8::Gemm g{(const bf16*)(ws + WS_BIG), (const bf16*)(ws + WS_W + WO_D1), M, DM, DFF}; pg8::StaticOrderG<4> S; { int g_ = G, c_ = bx; LAUNDER_S(g_); LAUNDER_S(c_); S.init(M, DM, g_, c_); }
          pg8::EpiResid E{xsrc_p, xsrc_s, out, DM, (const float*)(ws + WS_MODV) + (size_t)l * NB * MODW + 2 * DM, 0.5f, DN_ALPHA};
#if PH & 16
#ifdef PROBE_G2_REP
#pragma unroll 1
          for (int rep = 0; rep < (l == 0 ? PROBE_G2_REP : 1); ++rep)
#endif
          pg8::gemm_phase<pg8::EpiResid, pg8::StaticOrderG<4>, true, true>(L + RING_OFF, g, S, E);
#endif
        }
        GRID_BAR();
        { KArgs ap = kargs(); unsigned char* ws = ((unsigned char*)ap->ws);
#if PH & 4
          ln_rows(((float*)ap->out), (bf16*)(ws + WS_HB), ((const float*)ap->in[6]) + (size_t)l * 3 * DM, ((const float*)ap->in[7]) + (size_t)l * 3 * DM, (const float*)(ws + WS_MODV) + (size_t)l * NB * MODW, 3, gw, NGW, lane);
#ifdef PROBE_LN_REP
#pragma unroll 1
          for (int rep = 1; rep < PROBE_LN_REP; ++rep) ln_dummy(((float*)ap->out), (bf16*)(ws + WS_HB), (const float*)(ws + WS_MODV) + (size_t)l * NB * MODW, 3, gw, NGW, lane);
#endif
#endif
        }
        GRID_BAR();
        { KArgs ap = kargs(); unsigned char* ws = ((unsigned char*)ap->ws);
          pg8::Gemm g{(const bf16*)(ws + WS_HB), (const bf16*)(ws + WS_W + WO_IN), M, NIN, DM}; pg8::StaticOrder S; { int g_ = G, c_ = bx; LAUNDER_S(g_); LAUNDER_S(c_); S.init(M, NIN, g_, c_); }
          #ifdef USE_DIFF1
          pg8::EpiRope E{(bf16*)(ws + WS_BIG), NIN, (const float*)(ws + WS_ROPE), (const float*)(ws + WS_ROPE) + 16384 * 32, 1.0f};
#else
          pg8::EpiRope E{(bf16*)(ws + WS_BIG), NIN, (const float*)(ws + WS_ROPE), (const float*)(ws + WS_ROPE) + 16384 * 32, 0.125f * 1.4426950408889634f};
#endif
#if PH & 32
#ifdef PROBE_G3_REP
#pragma unroll 1
          for (int rep = 0; rep < PROBE_G3_REP; ++rep)
#endif
          pg8::gemm_phase<pg8::EpiRope, pg8::StaticOrder, true, true>(L + RING_OFF, g, S, E);
#endif
        }
        GRID_BAR();
        {
            KArgs ap = kargs(); unsigned char* ws = ((unsigned char*)ap->ws);
            const GAS bf16* BIG = (const GAS bf16*)(ap->ws + WS_BIG); GAS bf16* HA = (GAS bf16*)(ap->ws + WS_HA);
            const float lam = ((const float*)(ws + WS_MISC))[l]; const float gscale = 1.0f - (l == 0 ? LAM_INIT0 : LAM_INIT1);
            const GAS float* ng = ap->in[16] + l * 128; const GAS float* rpb = ap->in[17] + (size_t)l * 8 * 15 * 31;
            GAS float* stash = (GAS float*)(ap->ws + WS_HB) + (size_t)bx * 32768;
#ifndef PROBE_ATT_REP
#define PROBE_ATT_REP 1
#endif
#pragma unroll 1
            for (int rep = 0; rep < PROBE_ATT_REP; ++rep)
#pragma unroll 1
            for (int i = 0;; ++i) {
                const int u = i * G + vcu; if (u >= 4096) break;
#ifdef PROBE_NA_ONLY_REP
                if (rep > 0 && u < 2048) continue;
#endif
                if (u < 2048) {
                    long row0; int T, h, q0;
                    if (u < 1024) { const int bh = u >> 6, qt = u & 63; row0 = MP + (long)(bh >> 3) * 16384; T = 16384; h = bh & 7; q0 = qt * 256; }
                    else { const int v = u - 1024, bh = v >> 4, qt = v & 15; row0 = (long)(bh >> 3) * 4096; T = 4096; h = bh & 7; q0 = qt * 256; }
#if PH & 64
#ifdef USE_DIFF1
                    att::diff_unit(BIG, row0, T, h, q0, lam, gscale, ng, HA, stash, (char*)lds);
#else
                    att::diff_unit2<8>(BIG, row0, T, h, q0, lam, gscale, ng, HA, stash, (char*)lds);
#endif
#endif
                } else {
                    long row0; int rows, h, r0; int v = u - 2048;
                    if (v < 1024) { const int bh = v >> 4, rg = v & 15; row0 = (long)(bh >> 3) * 4096; rows = 64; h = bh & 7; r0 = rg * 4; }
                    else { v -= 1024; const int bh = v >> 6, rg = v & 63; row0 = MP + (long)(bh >> 3) * 16384; rows = 256; h = bh & 7; r0 = rg * 4; }
#if PH & 128
                    att::na_unit(BIG, row0, rows, h, r0, rpb + h * 15 * 31, HA, (char*)lds);
#endif
                }
            }
        }
        GRID_BAR();
        { KArgs ap = kargs(); unsigned char* ws = ((unsigned char*)ap->ws); float* out = ((float*)ap->out);
          pg8::Gemm g{(const bf16*)(ws + WS_HA), (const bf16*)(ws + WS_W + WO_OUT), M, DM, DM}; pg8::StaticOrderG<4> S; { int g_ = G, c_ = bx; LAUNDER_S(g_); LAUNDER_S(c_); S.init(M, DM, g_, c_); }
          pg8::EpiResid E{out, out + (size_t)MP * DM, out, DM, (const float*)(ws + WS_MODV) + (size_t)l * NB * MODW + 5 * DM, 1.0f, DN_ALPHA};
#if PH & 16
          pg8::gemm_phase<pg8::EpiResid, pg8::StaticOrderG<4>, true, true>(L + RING_OFF, g, S, E);
#endif
        }
        GRID_BAR();
        { KArgs ap = kargs(); unsigned char* ws = ((unsigned char*)ap->ws);
#if PH & 4
          ln_rows(((float*)ap->out), (bf16*)(ws + WS_HB), ((const float*)ap->in[6]) + (size_t)l * 3 * DM + DM, ((const float*)ap->in[7]) + (size_t)l * 3 * DM + DM, (const float*)(ws + WS_MODV) + (size_t)l * NB * MODW, 6, gw, NGW, lane);
#endif
        }
        GRID_BAR();
        { KArgs ap = kargs(); unsigned char* ws = ((unsigned char*)ap->ws);
          pg8::Gemm g{(const bf16*)(ws + WS_HB), (const bf16*)(ws + WS_W + WO_GU2), M, NGU, DM}; pg8::StaticOrder S; { int g_ = G, c_ = bx; LAUNDER_S(g_); LAUNDER_S(c_); S.init(M, NGU, g_, c_); }
          pg8::EpiSwiGLU E{(bf16*)(ws + WS_BIG), DFF};
#if PH & 8
#ifdef PROBE_G1_REP
#pragma unroll 1
          for (int rep = 0; rep < PROBE_G1_REP; ++rep)
#endif
          pg8::gemm_phase<pg8::EpiSwiGLU, pg8::StaticOrder, true, true>(L + RING_OFF, g, S, E);
#endif
        }
        GRID_BAR();
        { KArgs ap = kargs(); unsigned char* ws = ((unsigned char*)ap->ws); float* out = ((float*)ap->out);
          pg8::Gemm g{(const bf16*)(ws + WS_BIG), (const bf16*)(ws + WS_W + WO_D2), M, DM, DFF}; pg8::StaticOrderG<4> S; { int g_ = G, c_ = bx; LAUNDER_S(g_); LAUNDER_S(c_); S.init(M, DM, g_, c_); }
          pg8::EpiResid E{out, out + (size_t)MP * DM, out, DM, (const float*)(ws + WS_MODV) + (size_t)l * NB * MODW + 8 * DM, 0.5f, DN_ALPHA};
#if PH & 16
          pg8::gemm_phase<pg8::EpiResid, pg8::StaticOrderG<4>, true, true>(L + RING_OFF, g, S, E);
#endif
        }
        GRID_BAR();
        { KArgs ap = kargs(); unsigned char* ws = ((unsigned char*)ap->ws);
          const float* lng = ((const float*)ap->in[6]) + (size_t)l * 3 * DM + 2 * DM; const float* lnb = ((const float*)ap->in[7]) + (size_t)l * 3 * DM + 2 * DM;
          if (l + 1 < NLAYER) {
#if PH & 4
            ln_rows(((float*)ap->out), (bf16*)(ws + WS_HA), lng, lnb, (const float*)(ws + WS_MODV) + (size_t)(l + 1) * NB * MODW, 0, gw, NGW, lane);
#endif
#if PH & 2
            convert_layer(ap, l + 1, ws + WS_W, scr, gw, NGW, lane);
#endif
          } else {
#if PH & 4
            ln_rows(((float*)ap->out), nullptr, lng, lnb, (const float*)(ws + WS_MODV), 0, gw, NGW, lane);
#endif
          }
        }
        if (l + 1 < NLAYER) GRID_BAR();
    }
#undef GRID_BAR
}

extern "C" void kernel_launch(void* const* d_in, const int* in_sizes, int n_in, void* d_out, int out_size, void* d_ws, size_t ws_size, hipStream_t stream) {
    static int grid = 0;
    if (grid == 0) {
        if (n_in != 20 || out_size != M * DM || ws_size < WS_END) { fprintf(stderr, "kernel_launch: unexpected shapes: n_in %d out %d ws %zu (need %zu)\n", n_in, out_size, ws_size, (size_t)WS_END); grid = -1; return; }
        int dev = 0, cus = 0, per_cu = 0;
        if (hipGetDevice(&dev) != hipSuccess || hipDeviceGetAttribute(&cus, hipDeviceAttributeMultiprocessorCount, dev) != hipSuccess) { grid = -1; return; }
        if (hipFuncSetAttribute((const void*)mega_fwd, hipFuncAttributeMaxDynamicSharedMemorySize, LDS_BYTES) != hipSuccess) { fprintf(stderr, "kernel_launch: hipFuncSetAttribute failed\n"); grid = -1; return; }
        if (hipOccupancyMaxActiveBlocksPerMultiprocessor(&per_cu, (const void*)mega_fwd, NWAVES * 64, LDS_BYTES) != hipSuccess || per_cu < 1)
            fprintf(stderr, "kernel_launch: note: occupancy query reports %d workgroups per CU\n", per_cu);
        (void)hipGetLastError();
        grid = cus;
    }
    if (grid < 0) return;
    if (hipMemsetAsync((char*)d_ws + WS_CTL, 0, CTL_ZERO_BYTES, stream) != hipSuccess) return;
    Args a{};
    for (int i = 0; i < 20; ++i) a.in[i] = (const GAS float*)d_in[i];
    a.out = (GAS float*)d_out; a.ws = (GAS unsigned char*)d_ws;
    hipLaunchKernelGGL(mega_fwd, dim3(grid), dim3(NWAVES * 64), LDS_BYTES, stream, a);
    const hipError_t le = hipPeekAtLastError();
    if (le != hipSuccess) fprintf(stderr, "kernel_launch: launch failed: %s\n", hipGetErrorName(le));
}
```

```cpp
#include <hip/hip_runtime.h>
#include <cstdio>
#include <cstdint>
namespace pg8 {
#define PG8_LAS __attribute__((address_space(3)))
typedef unsigned short bf16_t;
typedef short bf16x8 __attribute__((ext_vector_type(8)));
typedef float f32x4 __attribute__((ext_vector_type(4)));
typedef unsigned u32x4 __attribute__((ext_vector_type(4)));
constexpr int BM = 256, BK = 64, HALF = 128, HTB = HALF * BK * 2  , STAGE_BYTES = 8 * HTB, NXCD = 8, WGM = 8;

__host__ __device__ __forceinline__ int lds_byte(int r, int c) { const int st = (r >> 4) * 2 + (c >> 5), rr = r & 15, cc = c & 31, ob = rr * 64 + cc * 2; return st * 1024 + (ob ^ (((ob >> 9) & 1) << 5)); }
__host__ __device__ __forceinline__ void stage_rc(int b, int& R, int& C) { const int st = b / 1024, sb = b % 1024, swz = sb ^ (((sb >> 9) & 1) << 5); R = (st >> 1) * 16 + swz / 64; C = (st & 1) * 32 + (swz % 64) / 2; }
__host__ __device__ __forceinline__ int perm32(int rho) { const int n = rho >> 4, i = rho & 15; return 8 * (i >> 2) + 4 * n + (i & 3); }

struct Unit { int pm, pn; };
struct Gemm { const bf16_t* A; const bf16_t* Bt; int M, N, K; };

struct StaticOrder {
    int nM, nN, nwg, G, c;
    __host__ __device__ void init(int M, int N, int G_, int c_) { nM = M / BM; nN = N / BM; nwg = nM * nN; G = G_; c = c_; }
    __host__ __device__ bool next(int i, Unit& u) const {
        const long L = (long)i * G + c; if (L >= nwg) return false;
        int wgid = (int)L; { const int q = nwg / NXCD, r = nwg % NXCD, xcd = wgid % NXCD, off = wgid / NXCD; wgid = (xcd < r ? xcd * (q + 1) : r * (q + 1) + (xcd - r) * q) + off; }
        const int nig = WGM * nN, gid = wgid / nig, fm = gid * WGM, gsz = (nM - fm) < WGM ? (nM - fm) : WGM;
        u.pm = fm + ((wgid % nig) % gsz); u.pn = (wgid % nig) / gsz; return true;
    }
    __device__ __forceinline__ void a_ready(const Unit&) const {}
    __device__ __forceinline__ void done(const Unit&) const {}
};

__device__ __forceinline__ unsigned cvt_pk_bf16(float lo, float hi) { unsigned r; asm volatile("v_cvt_pk_bf16_f32 %0, %1, %2" : "=v"(r) : "v"(lo), "v"(hi)); return r; }
typedef float f32x2 __attribute__((ext_vector_type(2)));
template <int WG> struct StaticOrderG {
    int nM, nN, nwg, G, c;
    __host__ __device__ void init(int M, int N, int G_, int c_) { nM = M / BM; nN = N / BM; nwg = nM * nN; G = G_; c = c_; }
    __host__ __device__ bool next(int i, Unit& u) const {
        const long L = (long)i * G + c; if (L >= nwg) return false;
        int wgid = (int)L; { const int q = nwg / NXCD, r = nwg % NXCD, xcd = wgid % NXCD, off = wgid / NXCD; wgid = (xcd < r ? xcd * (q + 1) : r * (q + 1) + (xcd - r) * q) + off; }
        const int nig = WG * nN, gid = wgid / nig, fm = gid * WG, gsz = (nM - fm) < WG ? (nM - fm) : WG;
        u.pm = fm + ((wgid % nig) % gsz); u.pn = (wgid % nig) / gsz; return true;
    }
    __device__ __forceinline__ void a_ready(const Unit&) const {}
    __device__ __forceinline__ void done(const Unit&) const {}
};
__device__ __forceinline__ float silu_f(float g) { return g * __builtin_amdgcn_rcpf(1.0f + __builtin_amdgcn_exp2f(-1.4426950408889634f * g)); }
struct EpiSwiGLU {
    static constexpr bool PERM = true, AFTER_DRAIN = false;
    bf16_t* O; int ldc;
    __device__ __forceinline__ void operator()(const f32x4 (&acc)[2][2][4][2], const Unit& u, int wr, int wc, int fr, int fq) const {
        const int r0 = wr * 64 + fr, col0 = u.pn * HALF + wc * 32 + 8 * fq;
        bf16_t* base = O + (size_t)u.pm * BM * ldc + (size_t)(col0 >> 6) * (BM * BK) + (col0 & 63);
#pragma unroll
        for (int ai = 0; ai < 2; ++ai)
#pragma unroll
            for (int m = 0; m < 4; ++m) { bf16_t* rowp = base + (r0 + ai * HALF + m * 16) * BK;
                const f32x4 g0 = acc[ai][0][m][0], g1 = acc[ai][0][m][1], u0 = acc[ai][1][m][0], u1 = acc[ai][1][m][1];
                u32x4 w;
                w.x = cvt_pk_bf16(silu_f(g0[0]) * u0[0], silu_f(g0[1]) * u0[1]); w.y = cvt_pk_bf16(silu_f(g0[2]) * u0[2], silu_f(g0[3]) * u0[3]);
                w.z = cvt_pk_bf16(silu_f(g1[0]) * u1[0], silu_f(g1[1]) * u1[1]); w.w = cvt_pk_bf16(silu_f(g1[2]) * u1[2], silu_f(g1[3]) * u1[3]);
                *(u32x4*)rowp = w; }
    }
};
struct EpiResid {
    static constexpr bool PERM = false, AFTER_DRAIN = false;
    const float* xp; const float* xs;
    float* y; int ldc; const float* gate;
    float coef, alpha;
    __device__ __forceinline__ void operator()(const f32x4 (&acc)[2][2][4][2], const Unit& u, int wr, int wc, int fr, int fq) const {
        const int trow = u.pm * BM; const bool samp = trow >= 32768;
        const int bidx = samp ? 8 + ((trow - 32768) >> 14) : (trow >> 12);
        const float* xb = samp ? xs + (size_t)(trow - 32768) * ldc : xp + (size_t)trow * ldc;
        float* yb = y + (size_t)trow * ldc;
        const int col0 = u.pn * BM + wc * 32 + 4 * fq;
        const float* gp = gate + (size_t)bidx * 18432 + col0;
        f32x4 gv[2][2];
#pragma unroll
        for (int bj = 0; bj < 2; ++bj)
#pragma unroll
            for (int n = 0; n < 2; ++n) gv[bj][n] = (*(const f32x4*)(gp + bj * HALF + n * 16) + 1.0f) * coef;
#pragma unroll
        for (int ai = 0; ai < 2; ++ai) {
            f32x4 xv[4][2][2];
#pragma unroll
            for (int m = 0; m < 4; ++m) { const size_t off = (size_t)(ai * HALF + wr * 64 + m * 16 + fr) * ldc + col0;
#pragma unroll
                for (int bj = 0; bj < 2; ++bj)
#pragma unroll
                    for (int n = 0; n < 2; ++n) xv[m][bj][n] = *(const f32x4*)(xb + off + bj * HALF + n * 16); }
#pragma unroll
            for (int m = 0; m < 4; ++m) { const size_t off = (size_t)(ai * HALF + wr * 64 + m * 16 + fr) * ldc + col0;
#pragma unroll
                for (int bj = 0; bj < 2; ++bj)
#pragma unroll
                    for (int n = 0; n < 2; ++n) { const f32x4 o = xv[m][bj][n] * alpha + gv[bj][n] * acc[ai][bj][m][n]; *(f32x4*)(yb + off + bj * HALF + n * 16) = o; } }
            asm volatile("" ::: "memory");
        }
    }
};
struct EpiRope {
    static constexpr bool PERM = true, AFTER_DRAIN = false;
    bf16_t* O; int ldc; const float* ropeC; const float* ropeS;
    float qscale;
    __device__ __forceinline__ void operator()(const f32x4 (&acc)[2][2][4][2], const Unit& u, int wr, int wc, int fr, int fq) const {
        const int row0 = u.pm * BM + wr * 64 + fr, col0 = u.pn * BM + wc * 32 + 8 * fq;
        const bool rot = u.pn < 8; const int i0 = (wc & 1) * 16 + 4 * fq;
        const float qs = u.pn < 4 ? qscale : 1.0f;
        f32x4 cs[2][4], sn[2][4];
#pragma unroll
        for (int ai = 0; ai < 2; ++ai)
#pragma unroll
            for (int m = 0; m < 4; ++m) { const int row = row0 + ai * HALF + m * 16; const int t = row < 32768 ? (row & 4095) : (row & 16383);
                cs[ai][m] = (f32x4){1.f, 1.f, 1.f, 1.f}; sn[ai][m] = (f32x4){0.f, 0.f, 0.f, 0.f};
                if (rot) { cs[ai][m] = *(const f32x4*)(ropeC + (size_t)t * 32 + i0); sn[ai][m] = *(const f32x4*)(ropeS + (size_t)t * 32 + i0); } }
#pragma unroll
        for (int ai = 0; ai < 2; ++ai)
#pragma unroll
            for (int m = 0; m < 4; ++m) { const int row = row0 + ai * HALF + m * 16;
                const f32x4 c4 = cs[ai][m], s4 = sn[ai][m];
                bf16_t* rowp = O + (size_t)row * ldc + col0;
#pragma unroll
                for (int bj = 0; bj < 2; ++bj) { const f32x4 v0 = acc[ai][bj][m][0], v1 = acc[ai][bj][m][1];
                    const float a0 = v0[0] * c4[0] - v0[1] * s4[0], b0 = v0[1] * c4[0] + v0[0] * s4[0];
                    const float a1 = v0[2] * c4[1] - v0[3] * s4[1], b1 = v0[3] * c4[1] + v0[2] * s4[1];
                    const float a2 = v1[0] * c4[2] - v1[1] * s4[2], b2 = v1[1] * c4[2] + v1[0] * s4[2];
                    const float a3 = v1[2] * c4[3] - v1[3] * s4[3], b3 = v1[3] * c4[3] + v1[2] * s4[3];
                    u32x4 w; w.x = cvt_pk_bf16(a0 * qs, b0 * qs); w.y = cvt_pk_bf16(a1 * qs, b1 * qs); w.z = cvt_pk_bf16(a2 * qs, b2 * qs); w.w = cvt_pk_bf16(a3 * qs, b3 * qs);
                    *(u32x4*)(rowp + bj * HALF) = w; } }
    }
};

template <class Epi, class Sched, bool ALIGN_EPI = false, bool SP2 = false, bool ABLK = false, bool BBLK = false>
__device__ __forceinline__ void gemm_phase(PG8_LAS unsigned char* lds, const Gemm g, const Sched& S, const Epi& E) {
    int tid_ = threadIdx.x; asm volatile("" : "+v"(tid_));
    const int tid = tid_, wid = __builtin_amdgcn_readfirstlane(tid >> 6), lane = tid & 63, wr = wid >> 2, wc = wid & 3, fr = lane & 15, fq = lane >> 4;
    const int K = g.K, nt = K / BK;
    unsigned voffA[2], voffB[2];
#pragma unroll
    for (int i = 0; i < 2; ++i) { int R, C; stage_rc(tid * 16 + i * 8192, R, C); const int Rb = Epi::PERM ? ((R & ~31) + perm32(R & 31)) : R;
        voffA[i] = ABLK ? (unsigned)(R * BK + C) * 2u : (unsigned)(R * K + C) * 2u; voffB[i] = BBLK ? (unsigned)(Rb * BK + C) * 2u : (unsigned)(Rb * K + C) * 2u; }
    const size_t kstep = (size_t)(BK * 2);
    const size_t hstep = (size_t)HALF * K * 2;
    const size_t tstep = 2 * hstep;
    const size_t kstepB = BBLK ? (size_t)(BM * BK * 2) : kstep, hstepB = BBLK ? (size_t)(HALF * BK * 2) : hstep;
    const size_t kstepA = ABLK ? (size_t)(BM * BK * 2) : kstep, hstepA = ABLK ? (size_t)(HALF * BK * 2) : hstep;
    const unsigned ldsw = (unsigned)wid * 1024u;
    const int aoff = lds_byte(wr * 64 + fr, fq * 8), boff = lds_byte(wc * 32 + fr, fq * 8);
#define PG8_SA(b, h) (((b) * 2 + (h)) * HTB)
#define PG8_SB(b, h) ((4 + (b) * 2 + (h)) * HTB)
#define PG8_STAGE(bufoff, gbase, voff) do { _Pragma("unroll") for (int _i = 0; _i < 2; ++_i) \
        __builtin_amdgcn_global_load_lds((const unsigned*)((const char*)(gbase) + (voff)[_i]), (PG8_LAS unsigned*)(lds + (bufoff) + ldsw + _i * 8192), 16, 0, 0); } while (0)
#define PG8_LDA(dst, b, h) do { _Pragma("unroll") for (int m = 0; m < 4; ++m) _Pragma("unroll") for (int k = 0; k < 2; ++k) dst[m][k] = *(const PG8_LAS bf16x8*)(lds + PG8_SA(b, h) + aoff + m * 2048 + k * 1024); } while (0)
#define PG8_LDB(dst, b, h) do { _Pragma("unroll") for (int n = 0; n < 2; ++n) _Pragma("unroll") for (int k = 0; k < 2; ++k) dst[n][k] = *(const PG8_LAS bf16x8*)(lds + PG8_SB(b, h) + boff + n * 2048 + k * 1024); } while (0)
#define PG8_MMA(ai, bj, At, Bt) do { __builtin_amdgcn_s_setprio(1); _Pragma("unroll") for (int m = 0; m < 4; ++m) _Pragma("unroll") for (int n = 0; n < 2; ++n) _Pragma("unroll") for (int k = 0; k < 2; ++k) \
        acc[ai][bj][m][n] = __builtin_amdgcn_mfma_f32_16x16x32_bf16(Bt[n][k], At[m][k], acc[ai][bj][m][n], 0, 0, 0); __builtin_amdgcn_s_setprio(0); } while (0)
#define PG8_WAIT_V(n) asm volatile("s_waitcnt vmcnt(" #n ")" ::: "memory")
#define PG8_WAIT_L(n) asm volatile("s_waitcnt lgkmcnt(" #n ")" ::: "memory")
#define PG8_BAR __builtin_amdgcn_s_barrier()
#define PG8_SCHED __builtin_amdgcn_sched_barrier(0)
    Unit cur, nxt; int ui = 0;
    if (!S.next(0, cur)) return;
    f32x4 acc[2][2][4][2];
#pragma unroll
    for (int a = 0; a < 2; ++a)
#pragma unroll
        for (int b = 0; b < 2; ++b)
#pragma unroll
            for (int m = 0; m < 4; ++m)
#pragma unroll
                for (int n = 0; n < 2; ++n) acc[a][b][m][n] = (f32x4){0.f, 0.f, 0.f, 0.f};
    bf16x8 At[4][2], B0[2][2], B1[2][2];
    const char* cA = (const char*)g.A + (size_t)cur.pm * tstep; const char* cB = (const char*)g.Bt + (size_t)cur.pn * tstep;
    S.a_ready(cur);
    if constexpr (SP2) {
        PG8_STAGE(PG8_SB(0, 0), cB, voffB); PG8_STAGE(PG8_SB(0, 1), cB + hstepB, voffB); PG8_STAGE(PG8_SA(0, 0), cA, voffA); PG8_STAGE(PG8_SA(0, 1), cA + hstepA, voffA);
        if (wr == 1) PG8_BAR;
        PG8_WAIT_V(2); PG8_BAR;
        PG8_STAGE(PG8_SB(1, 0), cB + kstepB, voffB); PG8_STAGE(PG8_SA(1, 0), cA + kstepA, voffA); PG8_STAGE(PG8_SB(1, 1), cB + hstepB + kstepB, voffB);
        PG8_WAIT_V(6); PG8_BAR;
    } else {
        PG8_STAGE(PG8_SB(0, 0), cB, voffB); PG8_STAGE(PG8_SA(0, 0), cA, voffA); PG8_STAGE(PG8_SB(0, 1), cB + hstepB, voffB); PG8_STAGE(PG8_SA(0, 1), cA + hstepA, voffA);
        if (wr == 1) PG8_BAR;
        PG8_WAIT_V(4); PG8_BAR;
        PG8_STAGE(PG8_SB(1, 0), cB + kstepB, voffB); PG8_STAGE(PG8_SA(1, 0), cA + kstepA, voffA); PG8_STAGE(PG8_SB(1, 1), cB + hstepB + kstepB, voffB);
        PG8_WAIT_V(6); PG8_BAR;
    }
    for (;;) {
        const bool has_next = S.next(ui + 1, nxt);
        const char* nA = has_next ? (const char*)g.A + (size_t)nxt.pm * tstep : cA; const char* nB = has_next ? (const char*)g.Bt + (size_t)nxt.pn * tstep : cB;
        for (int t = 0; t < nt; t += 2) {
            const bool last = (t == nt - 2);
            const char* a1 = cA + (size_t)(t + 1) * kstepA;
            const char* a2 = last ? nA : cA + (size_t)(t + 2) * kstepA; const char* b2 = last ? nB : cB + (size_t)(t + 2) * kstepB;
            const char* a3 = a2 + kstepA; const char* b3 = b2 + kstepB;
            if (last && has_next) S.a_ready(nxt);
            if constexpr (SP2) {
            PG8_LDB(B0, 0, 0); PG8_LDB(B1, 0, 1); PG8_SCHED; PG8_LDA(At, 0, 0); PG8_STAGE(PG8_SA(1, 1), a1 + hstepA, voffA);
            PG8_WAIT_V(8); PG8_WAIT_L(0); PG8_BAR; PG8_MMA(0, 0, At, B0); PG8_MMA(0, 1, At, B1); PG8_BAR; PG8_SCHED;
            PG8_LDA(At, 0, 1); PG8_STAGE(PG8_SB(0, 0), b2, voffB); PG8_STAGE(PG8_SB(0, 1), b2 + hstepB, voffB); PG8_STAGE(PG8_SA(0, 0), a2, voffA);
            PG8_WAIT_V(8); PG8_WAIT_L(0); PG8_BAR; PG8_MMA(1, 0, At, B0); PG8_MMA(1, 1, At, B1); PG8_BAR; PG8_SCHED;
            PG8_LDB(B0, 1, 0); PG8_LDB(B1, 1, 1); PG8_SCHED; PG8_LDA(At, 1, 0); PG8_STAGE(PG8_SA(0, 1), a2 + hstepA, voffA);
            PG8_WAIT_V(8); PG8_WAIT_L(0); PG8_BAR; PG8_MMA(0, 0, At, B0); PG8_MMA(0, 1, At, B1); PG8_BAR; PG8_SCHED;
            PG8_LDA(At, 1, 1); PG8_STAGE(PG8_SB(1, 0), b3, voffB); PG8_STAGE(PG8_SB(1, 1), b3 + hstepB, voffB); PG8_STAGE(PG8_SA(1, 0), a3, voffA);
            PG8_WAIT_V(8); PG8_WAIT_L(0); PG8_BAR; PG8_MMA(1, 0, At, B0); PG8_MMA(1, 1, At, B1); PG8_BAR; PG8_SCHED;
            } else {
            PG8_LDB(B0, 0, 0); PG8_SCHED; PG8_LDA(At, 0, 0); PG8_STAGE(PG8_SA(1, 1), a1 + hstepA, voffA);
            PG8_WAIT_L(8); PG8_BAR; PG8_WAIT_L(0); PG8_MMA(0, 0, At, B0); PG8_BAR; PG8_SCHED;
            PG8_LDB(B1, 0, 1); PG8_STAGE(PG8_SB(0, 0), b2, voffB);
            PG8_BAR; PG8_WAIT_L(0); PG8_MMA(0, 1, At, B1); PG8_BAR;
            PG8_LDA(At, 0, 1); PG8_STAGE(PG8_SA(0, 0), a2, voffA);
            PG8_BAR; PG8_WAIT_L(0); PG8_MMA(1, 0, At, B0); PG8_BAR; PG8_SCHED;
            PG8_STAGE(PG8_SB(0, 1), b2 + hstepB, voffB);
            PG8_WAIT_V(6); PG8_BAR; PG8_MMA(1, 1, At, B1); PG8_BAR;
            PG8_LDB(B0, 1, 0); PG8_SCHED; PG8_LDA(At, 1, 0); PG8_STAGE(PG8_SA(0, 1), a2 + hstepA, voffA);
            PG8_WAIT_L(8); PG8_BAR; PG8_WAIT_L(0); PG8_MMA(0, 0, At, B0); PG8_BAR; PG8_SCHED;
            PG8_LDB(B1, 1, 1); PG8_STAGE(PG8_SB(1, 0), b3, voffB);
            PG8_BAR; PG8_WAIT_L(0); PG8_MMA(0, 1, At, B1); PG8_BAR;
            PG8_LDA(At, 1, 1); PG8_STAGE(PG8_SA(1, 0), a3, voffA);
            PG8_BAR; PG8_WAIT_L(0); PG8_MMA(1, 0, At, B0); PG8_BAR; PG8_SCHED;
            PG8_STAGE(PG8_SB(1, 1), b3 + hstepB, voffB);
            PG8_WAIT_V(6); PG8_BAR; PG8_MMA(1, 1, At, B1); PG8_BAR;
            }
        }
        if constexpr (ALIGN_EPI) { if (wr == 0) PG8_BAR; }
        if constexpr (!Epi::AFTER_DRAIN) { E(acc, cur, wr, wc, fr, fq); S.done(cur); }
        if (!has_next) break;
#pragma unroll
        for (int a = 0; a < 2; ++a)
#pragma unroll
            for (int b = 0; b < 2; ++b)
#pragma unroll
                for (int m = 0; m < 4; ++m)
#pragma unroll
                    for (int n = 0; n < 2; ++n) acc[a][b][m][n] = (f32x4){0.f, 0.f, 0.f, 0.f};
        cur = nxt; cA = nA; cB = nB; ++ui;
        if constexpr (ALIGN_EPI) { if (wr == 1) PG8_BAR; }
    }
    PG8_WAIT_V(0);
    if constexpr (!ALIGN_EPI) { if (wr == 0) PG8_BAR; }
    PG8_BAR;
    if constexpr (Epi::AFTER_DRAIN) { E.fused(acc, cur, wr, wc, fr, fq, lds, wid, lane); S.done(cur); }
#undef PG8_SA
#undef PG8_SB
#undef PG8_STAGE
#undef PG8_LDA
#undef PG8_LDB
#undef PG8_MMA
#undef PG8_WAIT_V
#undef PG8_WAIT_L
#undef PG8_BAR
#undef PG8_SCHED
}
}
namespace att {
#define AGAS __attribute__((address_space(1)))
typedef unsigned short bf16;
using bf16x8 = __attribute__((ext_vector_type(8))) short;
using s16x4  = __attribute__((ext_vector_type(4))) short;
using f32x16 = __attribute__((ext_vector_type(16))) float;
using u32x4  = __attribute__((ext_vector_type(4))) unsigned;
constexpr int LDP = 6144, LDO = 2048;
constexpr int SHM_V = 64 * 128 * 2, SHM_K = 64 * 128 * 2;
constexpr int OFF_V = 0, OFF_K = 2 * SHM_V, OFF_WS = 2 * SHM_V + 2 * SHM_K, OFF_BT = OFF_WS + 8 * 64 * 4, ATT_LDS = OFF_BT + 2048;
constexpr float LOG2E = 1.4426950408889634f;
#define KSWZ128(row, colB) ((row) * 256 + ((colB) ^ (((row) & 7) << 4)))
#define KSWZ64(row, colB)  ((row) * 128 + ((colB) ^ ((((row) >> 1) & 7) << 4)))
#define SBAR() __builtin_amdgcn_sched_barrier(0)
__device__ __forceinline__ int crow(int r, int hi) { return (r & 3) + 8 * (r >> 2) + 4 * hi; }
__device__ __forceinline__ unsigned cvtpk(float lo, float hi) { unsigned r; asm volatile("v_cvt_pk_bf16_f32 %0, %1, %2" : "=v"(r) : "v"(lo), "v"(hi)); return r; }
__device__ __forceinline__ bf16x8 ld8(const AGAS bf16* p) { return *(const AGAS bf16x8*)(p); }
__device__ __forceinline__ unsigned short f2bf1(float f) { return (unsigned short)(cvtpk(f, 0.f) & 0xffffu); }

__device__ __forceinline__ int v_st(int k, int c) { const int kk = (k & ~0xC) | ((k & 4) << 1) | ((k & 8) >> 1); return ((kk >> 3) * 4 + (c >> 5)) * 512 + ((kk & 7) * 32 + (c & 31)) * 2; }
__device__ __forceinline__ int v_rd_base(int lane) { return ((lane & 3) << 3) | (((lane >> 2) & 3) << 6) | (((lane >> 4) & 1) << 5) | (((lane >> 5) & 1) << 8); }
constexpr int v_rd_off(int d0, int ks, int half) { return d0 * 512 + ks * 4096 + half * 2048; }
template <int OFF> __device__ __forceinline__ s16x4 tr_read(int vb) {
  s16x4 r; asm volatile("ds_read_b64_tr_b16 %0, %1 offset:%2" : "=&v"(r) : "v"(vb), "i"(OFF) : "memory"); return r;
}
template <int D0> __device__ __forceinline__ void pv_one(f32x16& od, int vb, bf16x8 pa0, bf16x8 pa1, bf16x8 pa2, bf16x8 pa3) {
  const s16x4 l0 = tr_read<v_rd_off(D0, 0, 0)>(vb), h0 = tr_read<v_rd_off(D0, 0, 1)>(vb), l1 = tr_read<v_rd_off(D0, 1, 0)>(vb), h1 = tr_read<v_rd_off(D0, 1, 1)>(vb);
  const s16x4 l2 = tr_read<v_rd_off(D0, 2, 0)>(vb), h2 = tr_read<v_rd_off(D0, 2, 1)>(vb), l3 = tr_read<v_rd_off(D0, 3, 0)>(vb), h3 = tr_read<v_rd_off(D0, 3, 1)>(vb);
  asm volatile("s_waitcnt lgkmcnt(0)" ::: "memory"); SBAR();
#define PK(L, H) (bf16x8){L[0], L[1], L[2], L[3], H[0], H[1], H[2], H[3]}
  od = __builtin_amdgcn_mfma_f32_32x32x16_bf16(pa0, PK(l0, h0), od, 0, 0, 0);
  od = __builtin_amdgcn_mfma_f32_32x32x16_bf16(pa1, PK(l1, h1), od, 0, 0, 0);
  od = __builtin_amdgcn_mfma_f32_32x32x16_bf16(pa2, PK(l2, h2), od, 0, 0, 0);
  od = __builtin_amdgcn_mfma_f32_32x32x16_bf16(pa3, PK(l3, h3), od, 0, 0, 0);
#undef PK
}
__device__ __forceinline__ void pv_d0(f32x16* o, int vb, bf16x8 pa0, bf16x8 pa1, bf16x8 pa2, bf16x8 pa3) {
  pv_one<0>(o[0], vb, pa0, pa1, pa2, pa3); pv_one<1>(o[1], vb, pa0, pa1, pa2, pa3); pv_one<2>(o[2], vb, pa0, pa1, pa2, pa3); pv_one<3>(o[3], vb, pa0, pa1, pa2, pa3);
}
#define ATT_PK4(P, BASE, OUT) do { unsigned a0_ = cvtpk(P[BASE + 0], P[BASE + 1]), a1_ = cvtpk(P[BASE + 2], P[BASE + 3]);   \
    unsigned b0_ = cvtpk(P[BASE + 4], P[BASE + 5]), b1_ = cvtpk(P[BASE + 6], P[BASE + 7]);                              \
    auto r0_ = __builtin_amdgcn_permlane32_swap(a0_, b0_, false, false); auto r1_ = __builtin_amdgcn_permlane32_swap(a1_, b1_, false, false); \
    u32x4 w_ = {r0_[0], r1_[0], r0_[1], r1_[1]}; OUT = *reinterpret_cast<bf16x8*>(&w_); } while (0)

constexpr float DSCALE = 0.125f, DTHR = 8.f;
__device__ __forceinline__ void d_partialSM(f32x16& p0, f32x16& p1, float& m_reg, float& mn, float& alpha) {
  constexpr float C = DSCALE * LOG2E;
  float pmax = p0[0];
#pragma unroll
  for (int r = 1; r < 16; ++r) pmax = fmaxf(pmax, p0[r]);
#pragma unroll
  for (int r = 0; r < 16; ++r) pmax = fmaxf(pmax, p1[r]);
  { auto rr = __builtin_amdgcn_permlane32_swap(__float_as_uint(pmax), __float_as_uint(pmax), false, false);
    pmax = fmaxf(__uint_as_float(rr[0]), __uint_as_float(rr[1])); }
  if (__builtin_expect(__all(pmax - m_reg <= DTHR / DSCALE), 1)) { mn = m_reg; alpha = 1.f; }
  else { mn = fmaxf(m_reg, pmax); alpha = __builtin_amdgcn_exp2f((m_reg - mn) * C); m_reg = mn; }
  const float mnC = -mn * C;
#pragma unroll
  for (int r = 0; r < 16; ++r) p0[r] = fmaf(p0[r], C, mnC);
#pragma unroll
  for (int r = 0; r < 16; ++r) p1[r] = fmaf(p1[r], C, mnC);
#pragma unroll
  for (int r = 0; r < 16; ++r) p0[r] = __builtin_amdgcn_exp2f(p0[r]);
}
__device__ __forceinline__ void d_finishSM(f32x16& p0, f32x16& p1, float alpha, float& l_reg, bf16x8& pa0, bf16x8& pa1, bf16x8& pa2, bf16x8& pa3) {
#pragma unroll
  for (int r = 0; r < 16; ++r) p1[r] = __builtin_amdgcn_exp2f(p1[r]);
  float ps = 0;
#pragma unroll
  for (int r = 0; r < 16; ++r) ps += p0[r];
#pragma unroll
  for (int r = 0; r < 16; ++r) ps += p1[r];
  { auto rr = __builtin_amdgcn_permlane32_swap(__float_as_uint(ps), __float_as_uint(ps), false, false);
    ps = __uint_as_float(rr[0]) + __uint_as_float(rr[1]); }
  l_reg = l_reg * alpha + ps;
  ATT_PK4(p0, 0, pa0); ATT_PK4(p0, 8, pa1); ATT_PK4(p1, 0, pa2); ATT_PK4(p1, 8, pa3);
}
__device__ __forceinline__ void d_qkt(f32x16& p0, f32x16& p1, const char* Ks, const bf16x8* qr, int r32, int hi) {
  p0 = f32x16{}; p1 = f32x16{};
#pragma unroll
  for (int d0 = 0; d0 < 4; ++d0) { const int cb = (d0 * 16 + hi * 8) * 2;
    const bf16x8 b0 = *reinterpret_cast<const bf16x8*>(Ks + KSWZ64(r32, cb));
    const bf16x8 b1 = *reinterpret_cast<const bf16x8*>(Ks + KSWZ64(32 + r32, cb));
    p0 = __builtin_amdgcn_mfma_f32_32x32x16_bf16(b0, qr[d0], p0, 0, 0, 0);
    p1 = __builtin_amdgcn_mfma_f32_32x32x16_bf16(b1, qr[d0], p1, 0, 0, 0); }
}
__device__ __forceinline__ void diff_unit(const AGAS bf16* __restrict__ proj, long row0, int T, int h, int q0, float lam, float gscale,
                                          const AGAS float* __restrict__ ng, AGAS bf16* __restrict__ out, AGAS float* __restrict__ stash, char* lds) {
  int tid_ = threadIdx.x; asm volatile("" : "+v"(tid_));
  const int tid = tid_, wid = __builtin_amdgcn_readfirstlane(tid >> 6), lane = tid & 63, r32 = lane & 31, hi = lane >> 5;
  char* V_lds = lds + OFF_V; char* K_lds = lds + OFF_K;
  float* ws = (float*)(lds + OFF_WS) + wid * 64; float* li_l = ws; float* al_l = ws + 32;
  const int ksr = tid >> 3, ksc = (tid & 7) * 8;
  const int sr = tid >> 4, sc = (tid & 15) * 8, vst0 = v_st(sr, sc), vst1 = v_st(32 + sr, sc);
  const int kst = KSWZ64(ksr, ksc * 2);
  const int vb0 = (int)(uintptr_t)V_lds + v_rd_base(lane);
  const int NT = T / 64;
  typedef float f32x4v __attribute__((ext_vector_type(4)));
#pragma unroll 1
  for (int c = 0; c < 2; ++c) {
    const AGAS bf16* pj = proj; asm volatile("" : "+s"(pj));
    const AGAS bf16* Qw = pj + (row0 + q0 + wid * 32 + r32) * LDP + h * 128 + c * 64 + hi * 8;
    const AGAS bf16* Kh = pj + row0 * LDP + 1024 + h * 128 + c * 64;
    const AGAS bf16* Vh = pj + row0 * LDP + 2048 + h * 128;
    float m_reg = -1e30f, l_reg = 0.f; f32x16 o[4] = {}; bf16x8 qr[4];
#pragma unroll
    for (int d0 = 0; d0 < 4; ++d0) qr[d0] = ld8(Qw + d0 * 16);
    struct { bf16x8 vs0, vs1, ks0; } sr_[2];
#define SLOAD(i, k0) do { sr_[i].vs0 = ld8(&Vh[(long)((k0) + sr) * LDP + sc]); sr_[i].vs1 = ld8(&Vh[(long)((k0) + 32 + sr) * LDP + sc]); \
      sr_[i].ks0 = ld8(&Kh[(long)((k0) + ksr) * LDP + ksc]); } while (0)
#define SWRITE(b, i) do { *(bf16x8*)(V_lds + (b) * SHM_V + vst0) = sr_[i].vs0; *(bf16x8*)(V_lds + (b) * SHM_V + vst1) = sr_[i].vs1; \
      *(bf16x8*)(K_lds + (b) * SHM_K + kst) = sr_[i].ks0; } while (0)
#define SWAIT() asm volatile("s_waitcnt vmcnt(3)" ::: "memory")
#define RESC(a) do { if (__any((a) < 1.f)) { if (hi == 0) al_l[r32] = (a); asm volatile("s_waitcnt lgkmcnt(0)" ::: "memory"); \
      _Pragma("unroll") for (int d = 0; d < 4; ++d) _Pragma("unroll") for (int r = 0; r < 16; ++r) o[d][r] *= al_l[crow(r, hi)]; } } while (0)
    f32x16 pA0, pA1, pB0, pB1; float mnA, mnB, alA, alB; bf16x8 pa0, pa1, pa2, pa3;
    __syncthreads();
    SLOAD(0, 0); asm volatile("s_waitcnt vmcnt(0)" ::: "memory"); SWRITE(0, 0); __syncthreads();
    d_qkt(pA0, pA1, K_lds, qr, r32, hi); d_partialSM(pA0, pA1, m_reg, mnA, alA);
    SLOAD(1, 64); if (2 < NT) SLOAD(0, 128);
    SWAIT(); SWRITE(1, 1); __syncthreads();
    for (int j = 1; j + 1 < NT; j += 2) {
      SBAR(); d_qkt(pB0, pB1, K_lds + SHM_K, qr, r32, hi);
      d_finishSM(pA0, pA1, alA, l_reg, pa0, pa1, pa2, pa3); SBAR();
      SLOAD(1, (j + 2) * 64); SBAR();
      pv_d0(o, vb0, pa0, pa1, pa2, pa3); d_partialSM(pB0, pB1, m_reg, mnB, alB);
      __syncthreads(); SWAIT(); SWRITE(0, 0);
      RESC(alB); __syncthreads();
      SBAR(); d_qkt(pA0, pA1, K_lds, qr, r32, hi);
      d_finishSM(pB0, pB1, alB, l_reg, pa0, pa1, pa2, pa3); SBAR();
      if (j + 3 < NT) SLOAD(0, (j + 3) * 64); SBAR();
      pv_d0(o, vb0 + SHM_V, pa0, pa1, pa2, pa3); d_partialSM(pA0, pA1, m_reg, mnA, alA);
      __syncthreads(); SWAIT(); SWRITE(1, 1);
      RESC(alA); __syncthreads();
    }
    SBAR(); d_qkt(pB0, pB1, K_lds + SHM_K, qr, r32, hi);
    d_finishSM(pA0, pA1, alA, l_reg, pa0, pa1, pa2, pa3); SBAR();
    pv_d0(o, vb0, pa0, pa1, pa2, pa3); d_partialSM(pB0, pB1, m_reg, mnB, alB);
    __syncthreads(); RESC(alB);
    d_finishSM(pB0, pB1, alB, l_reg, pa0, pa1, pa2, pa3); SBAR();
    pv_d0(o, vb0 + SHM_V, pa0, pa1, pa2, pa3);
#undef SLOAD
#undef SWRITE
#undef SWAIT
#undef RESC
    if (hi == 0) li_l[r32] = l_reg; asm volatile("s_waitcnt lgkmcnt(0)" ::: "memory");
    float rli[16];
#pragma unroll
    for (int r = 0; r < 16; ++r) rli[r] = __builtin_amdgcn_rcpf(li_l[crow(r, hi)]);
    AGAS float* stash_l = stash; asm volatile("" : "+s"(stash_l));
    AGAS f32x4v* st4 = (AGAS f32x4v*)(stash_l + ((size_t)wid * 64 + lane) * 64);
    if (c == 0) {
#pragma unroll
      for (int d0 = 0; d0 < 4; ++d0)
#pragma unroll
        for (int r4 = 0; r4 < 4; ++r4) st4[d0 * 4 + r4] = (f32x4v){o[d0][4 * r4] * rli[4 * r4], o[d0][4 * r4 + 1] * rli[4 * r4 + 1], o[d0][4 * r4 + 2] * rli[4 * r4 + 2], o[d0][4 * r4 + 3] * rli[4 * r4 + 3]};
    } else {
      AGAS bf16* out_l = out; asm volatile("" : "+s"(out_l));
      AGAS bf16* Ow = out_l + (row0 + q0 + wid * 32) * LDO + h * 128 + r32;
      float gv[4];
#pragma unroll
      for (int d0 = 0; d0 < 4; ++d0) gv[d0] = ng[d0 * 32 + r32] * gscale;
#pragma unroll
      for (int r4 = 0; r4 < 4; ++r4) {
        f32x4v s4[4];
#pragma unroll
        for (int d0 = 0; d0 < 4; ++d0) s4[d0] = st4[d0 * 4 + r4];
#pragma unroll
        for (int e = 0; e < 4; ++e) { const int r = 4 * r4 + e;
          float v[4]; float ss = 0.f;
#pragma unroll
          for (int d0 = 0; d0 < 4; ++d0) { v[d0] = s4[d0][e] - lam * (o[d0][r] * rli[r]); ss += v[d0] * v[d0]; }
          ss += __shfl_xor(ss, 1); ss += __shfl_xor(ss, 2); ss += __shfl_xor(ss, 4); ss += __shfl_xor(ss, 8); ss += __shfl_xor(ss, 16);
          const float rstd = 1.0f / sqrtf(ss * (1.0f / 128.0f) + 1e-5f);
          AGAS bf16* ob = Ow; asm volatile("" : "+v"(ob)); AGAS bf16* op = ob + (long)crow(r, hi) * LDO;
#pragma unroll
          for (int d0 = 0; d0 < 4; ++d0) op[d0 * 32] = f2bf1(v[d0] * rstd * gv[d0]);
        }
      }
    }
  }
}

__device__ __forceinline__ void na_qkt(f32x16& p0, f32x16& p1, const char* Ks, const bf16x8* qr, int r32, int hi) {
  p0 = f32x16{}; p1 = f32x16{};
#pragma unroll
  for (int d0 = 0; d0 < 8; ++d0) { const int cb = (d0 * 16 + hi * 8) * 2;
    const bf16x8 b0 = *reinterpret_cast<const bf16x8*>(Ks + KSWZ128(r32, cb));
    const bf16x8 b1 = *reinterpret_cast<const bf16x8*>(Ks + KSWZ128(32 + r32, cb));
    p0 = __builtin_amdgcn_mfma_f32_32x32x16_bf16(b0, qr[d0], p0, 0, 0, 0);
    p1 = __builtin_amdgcn_mfma_f32_32x32x16_bf16(b1, qr[d0], p1, 0, 0, 0); }
}
__device__ __forceinline__ void na_unit(const AGAS bf16* __restrict__ proj, long row0, int rows, int h, int r0, const AGAS float* __restrict__ rpb_h,
                                        AGAS bf16* __restrict__ out, char* lds) {
  int tid_ = threadIdx.x; asm volatile("" : "+v"(tid_));
  const int tid = tid_, wid = __builtin_amdgcn_readfirstlane(tid >> 6), lane = tid & 63, r32 = lane & 31, hi = lane >> 5;
  char* V_lds = lds + OFF_V; char* K_lds = lds + OFF_K;
  float* ws = (float*)(lds + OFF_WS) + wid * 64; float* li_l = ws; float* al_l = ws + 32;
  float* bt = (float*)(lds + OFF_BT);
  constexpr float C = 0.08838834764831845f * LOG2E;
  __syncthreads();
  for (int i = tid; i < 15 * 31; i += 512) bt[i] = rpb_h[i] * LOG2E;
  const int r = r0 + (wid >> 1), cq = (wid & 1) * 32 + r32;
  const int cs = min(max(cq - 8, 0), 48);
  const int rs_w = min(max(r - 4, 0), rows - 8);
  const int kr_lo = min(max(r0 - 4, 0), rows - 8), kr_hi = min(max(r0 - 1, 0), rows - 8) + 8;
  const AGAS bf16* Qw = proj + (row0 + (long)r * 64 + cq) * LDP + 3072 + h * 128 + hi * 8;
  bf16x8 qr[8];
#pragma unroll
  for (int d0 = 0; d0 < 8; ++d0) qr[d0] = ld8(Qw + d0 * 16);
  const int sr = tid >> 4, sc = (tid & 15) * 8, vst0 = v_st(sr, sc), vst1 = v_st(32 + sr, sc);
  const int kst0 = KSWZ128(sr, sc * 2), kst1 = KSWZ128(32 + sr, sc * 2);
  const int vb0 = (int)(uintptr_t)V_lds + v_rd_base(lane);
  const AGAS bf16* Kh = proj + row0 * LDP + 4096 + h * 128; const AGAS bf16* Vh = proj + row0 * LDP + 5120 + h * 128;
  float m_reg = -1e30f, l_reg = 0.f; f32x16 o[4] = {};
  for (int kr = kr_lo; kr < kr_hi; ++kr) {
    const long kb = (long)kr * 64;
    const bf16x8 vs0 = ld8(&Vh[(kb + sr) * LDP + sc]), vs1 = ld8(&Vh[(kb + 32 + sr) * LDP + sc]);
    const bf16x8 ks0 = ld8(&Kh[(kb + sr) * LDP + sc]), ks1 = ld8(&Kh[(kb + 32 + sr) * LDP + sc]);
    __syncthreads();
    *(bf16x8*)(V_lds + vst0) = vs0; *(bf16x8*)(V_lds + vst1) = vs1; *(bf16x8*)(K_lds + kst0) = ks0; *(bf16x8*)(K_lds + kst1) = ks1;
    __syncthreads();
    if (kr >= rs_w && kr < rs_w + 8) {
      f32x16 p0, p1; na_qkt(p0, p1, K_lds, qr, r32, hi);
      const float* btr = bt + (kr - r + 7) * 31;
      float pmax = -INFINITY;
#pragma unroll
      for (int rr = 0; rr < 16; ++rr) {
        const int ck0 = crow(rr, hi), ck1 = ck0 + 32;
        const int ci0 = min(max(ck0 - cq, -15), 15) + 15, ci1 = min(max(ck1 - cq, -15), 15) + 15;
        const float s0 = fmaf(p0[rr], C, btr[ci0]), s1 = fmaf(p1[rr], C, btr[ci1]);
        p0[rr] = (ck0 >= cs && ck0 < cs + 16) ? s0 : -INFINITY; p1[rr] = (ck1 >= cs && ck1 < cs + 16) ? s1 : -INFINITY;
        pmax = fmaxf(pmax, fmaxf(p0[rr], p1[rr]));
      }
      { auto rr = __builtin_amdgcn_permlane32_swap(__float_as_uint(pmax), __float_as_uint(pmax), false, false);
        pmax = fmaxf(__uint_as_float(rr[0]), __uint_as_float(rr[1])); }
      const float mn = fmaxf(m_reg, pmax); const float alpha = __builtin_amdgcn_exp2f(m_reg - mn); m_reg = mn;
      float ps = 0.f;
#pragma unroll
      for (int rr = 0; rr < 16; ++rr) { p0[rr] = __builtin_amdgcn_exp2f(p0[rr] - mn); p1[rr] = __builtin_amdgcn_exp2f(p1[rr] - mn); ps += p0[rr] + p1[rr]; }
      { auto rr = __builtin_amdgcn_permlane32_swap(__float_as_uint(ps), __float_as_uint(ps), false, false);
        ps = __uint_as_float(rr[0]) + __uint_as_float(rr[1]); }
      l_reg = l_reg * alpha + ps;
      if (hi == 0) al_l[r32] = alpha; asm volatile("s_waitcnt lgkmcnt(0)" ::: "memory");
#pragma unroll
      for (int d = 0; d < 4; ++d)
#pragma unroll
        for (int rr = 0; rr < 16; ++rr) o[d][rr] *= al_l[crow(rr, hi)];
      bf16x8 pa0, pa1, pa2, pa3;
      ATT_PK4(p0, 0, pa0); ATT_PK4(p0, 8, pa1); ATT_PK4(p1, 0, pa2); ATT_PK4(p1, 8, pa3);
      SBAR(); pv_d0(o, vb0, pa0, pa1, pa2, pa3);
    }
  }
  if (hi == 0) li_l[r32] = l_reg; asm volatile("s_waitcnt lgkmcnt(0)" ::: "memory");
  float rli[16];
#pragma unroll
  for (int rr = 0; rr < 16; ++rr) rli[rr] = __builtin_amdgcn_rcpf(li_l[crow(rr, hi)]);
  AGAS bf16* out_l = out; asm volatile("" : "+s"(out_l));
  AGAS bf16* Ow = out_l + (row0 + (long)r * 64 + (wid & 1) * 32) * LDO + 1024 + h * 128 + r32;
#pragma unroll
  for (int rr = 0; rr < 16; ++rr) { AGAS bf16* ob = Ow; asm volatile("" : "+v"(ob)); AGAS bf16* op = ob + (long)crow(rr, hi) * LDO;
#pragma unroll
    for (int d0 = 0; d0 < 4; ++d0) op[d0 * 32] = f2bf1(o[d0][rr] * rli[rr]); }
}
#undef SBAR
}

namespace att {
constexpr int D_SLOTK = 8192, D_LDS_K = 0, D_LDS_V = 3 * D_SLOTK, D_LDS_WS = D_LDS_V + 6 * D_SLOTK, D_LDS_END = D_LDS_WS + 8 * 256;
typedef __attribute__((address_space(3))) const char* lds_cptr;
typedef short v4i16_t __attribute__((ext_vector_type(4)));
#define SBAR() __builtin_amdgcn_sched_barrier(0)
#define WAIT_BAR(N) asm volatile("s_waitcnt vmcnt(" #N ") lgkmcnt(0)\n\ts_barrier" ::: "memory")
__device__ __forceinline__ void glds16(const AGAS void* gsrc, unsigned lds_dst) { unsigned keep;
  asm volatile("s_mov_b32 %0, m0\n\ts_mov_b32 m0, %2\n\ts_nop 0\n\tglobal_load_lds_dwordx4 %1, off\n\ts_mov_b32 m0, %0" : "=&s"(keep) : "v"(gsrc), "s"(lds_dst) : "memory"); }
__device__ __forceinline__ unsigned cvtpk_s(float lo, float hi) { typedef float f2_t __attribute__((ext_vector_type(2))); typedef __bf16 b2_t __attribute__((ext_vector_type(2)));
  f2_t v = {lo, hi}; b2_t b = __builtin_convertvector(v, b2_t); return __builtin_bit_cast(unsigned, b); }
__device__ __forceinline__ void kload8(bf16x8* kf, lds_cptr kp) {
  kf[0] = *(const __attribute__((address_space(3))) bf16x8*)(kp);        kf[1] = *(const __attribute__((address_space(3))) bf16x8*)(kp + 512);
  kf[2] = *(const __attribute__((address_space(3))) bf16x8*)(kp + 2048); kf[3] = *(const __attribute__((address_space(3))) bf16x8*)(kp + 2560);
  kf[4] = *(const __attribute__((address_space(3))) bf16x8*)(kp + 4096); kf[5] = *(const __attribute__((address_space(3))) bf16x8*)(kp + 4608);
  kf[6] = *(const __attribute__((address_space(3))) bf16x8*)(kp + 6144); kf[7] = *(const __attribute__((address_space(3))) bf16x8*)(kp + 6656);
}
__device__ __forceinline__ void kload2(bf16x8* kf, lds_cptr kp, int j) { kf[2 * j] = *(const __attribute__((address_space(3))) bf16x8*)(kp + j * 2048); kf[2 * j + 1] = *(const __attribute__((address_space(3))) bf16x8*)(kp + j * 2048 + 512); }
__device__ __forceinline__ s16x4 vtr(lds_cptr p) { return __builtin_bit_cast(s16x4, __builtin_amdgcn_ds_read_tr16_b64_v4i16((__attribute__((address_space(3))) v4i16_t*)p)); }
__device__ __forceinline__ void pv4(f32x16* o, int vb, bf16x8 pa0, bf16x8 pa1, bf16x8 pa2, bf16x8 pa3) {
#pragma unroll
  for (int d0 = 0; d0 < 4; ++d0) { s16x4 lo[4], hi[4];
#pragma unroll
    for (int ks = 0; ks < 4; ++ks) {
      asm volatile("ds_read_b64_tr_b16 %0,%1 offset:%c2" : "=&v"(lo[ks]) : "v"(vb), "i"(d0 * 4096 + ks * 1024) : "memory");
      asm volatile("ds_read_b64_tr_b16 %0,%1 offset:%c2" : "=&v"(hi[ks]) : "v"(vb), "i"(d0 * 4096 + ks * 1024 + 512) : "memory"); }
    asm volatile("s_waitcnt lgkmcnt(0)" ::: "memory"); SBAR();
#define PK(k) (bf16x8){lo[k][0], lo[k][1], lo[k][2], lo[k][3], hi[k][0], hi[k][1], hi[k][2], hi[k][3]}
    o[d0] = __builtin_amdgcn_mfma_f32_32x32x16_bf16(pa0, PK(0), o[d0], 0, 0, 0);
    o[d0] = __builtin_amdgcn_mfma_f32_32x32x16_bf16(pa1, PK(1), o[d0], 0, 0, 0);
    o[d0] = __builtin_amdgcn_mfma_f32_32x32x16_bf16(pa2, PK(2), o[d0], 0, 0, 0);
    o[d0] = __builtin_amdgcn_mfma_f32_32x32x16_bf16(pa3, PK(3), o[d0], 0, 0, 0);
#undef PK
  }
}
template <int THRL>
__device__ __forceinline__ void diff_unit2(const AGAS bf16* __restrict__ proj, long row0, int T, int h, int q0, float lam, float gscale,
                                           const AGAS float* __restrict__ ng, AGAS bf16* __restrict__ out, AGAS float* __restrict__ stash, char* shm) {
  int tid_ = threadIdx.x; asm volatile("" : "+v"(tid_));
  const int tid = tid_, lane = tid & 63, r32 = lane & 31, hi = lane >> 5; const int wid = __builtin_amdgcn_readfirstlane(tid >> 6);
  typedef float f32x4v __attribute__((ext_vector_type(4))); typedef float f32x2p __attribute__((ext_vector_type(2)));
  const unsigned lds0 = (unsigned)(uintptr_t)shm;
  float* wsf = (float*)(shm + D_LDS_WS) + wid * 64;
  const lds_cptr shm3 = (lds_cptr)shm;
  const int vlane = ((lane >> 4) & 1) * 32 + (lane & 3) * 8 + (4 * hi + ((lane & 15) >> 2)) * 64;
  const lds_cptr kp0 = shm3 + D_LDS_K + hi * 1024 + r32 * 16; const lds_cptr vp0 = shm3 + D_LDS_V + vlane;
  const int vb0 = (int)(lds0 + D_LDS_V) + vlane;
  const unsigned kdst = lds0 + D_LDS_K + wid * 1024, vdst = lds0 + D_LDS_V + wid * 1024;
  const int NT = T / 64;
#pragma unroll 1
  for (int c = 0; c < 2; ++c) {
    const AGAS bf16* pj = proj; asm volatile("" : "+s"(pj));
    const AGAS bf16* Qw = pj + (row0 + q0 + wid * 32) * LDP + h * 128 + c * 64;
    const AGAS bf16* ksrc = pj + (row0 + lane) * LDP + 1024 + h * 128 + c * 64 + wid * 8;
    const AGAS bf16* vsrc = pj + (row0 + 16 * (wid & 3) + (lane >> 2)) * LDP + 2048 + h * 128 + (wid >> 2) * 32 + (lane & 3) * 8;
#define DMA_K(t, slot) glds16(ksrc + (long)(t) * 64 * LDP, (unsigned)__builtin_amdgcn_readfirstlane(kdst + (slot)))
#define DMA_V(t, slot) do { glds16(vsrc + (long)(t) * 64 * LDP, (unsigned)__builtin_amdgcn_readfirstlane(vdst + 2 * (slot))); \
                            glds16(vsrc + (long)(t) * 64 * LDP + 64, (unsigned)__builtin_amdgcn_readfirstlane(vdst + 2 * (slot) + 8192)); } while (0)
    asm volatile("s_waitcnt lgkmcnt(0)\n\ts_barrier" ::: "memory");
    DMA_K(0, 0); DMA_V(0, 0); DMA_K(1, D_SLOTK);
    bf16x8 qr[4];
#pragma unroll
    for (int d0 = 0; d0 < 4; ++d0) qr[d0] = ld8(Qw + (long)r32 * LDP + d0 * 16 + hi * 8);
    float mhat = 0.f, l_reg = 0.f; f32x16 o[4]; o[0] = f32x16{}; o[1] = f32x16{}; o[2] = f32x16{}; o[3] = f32x16{};
    bool resc = false;
#define RESC() do { if (resc) { asm volatile("s_waitcnt lgkmcnt(0)" ::: "memory"); \
      _Pragma("unroll") for (int d_ = 0; d_ < 4; ++d_) _Pragma("unroll") for (int r = 0; r < 16; ++r) o[d_][r] *= wsf[crow(r, hi)]; } } while (0)
    f32x16 pA0, pA1, pB0, pB1; bf16x8 kf[8];
    int sl_prev = 0, sl_cur = 0, sl_next = D_SLOTK;
#define ROT() do { sl_prev = sl_cur; sl_cur = sl_next; sl_next = (sl_next == 2 * D_SLOTK) ? 0 : sl_next + D_SLOTK; } while (0)
    DMA_K(2, 2 * D_SLOTK);
    WAIT_BAR(3);
    { const lds_cptr kb = kp0;
      pA0 = f32x16{}; pA1 = f32x16{};
#pragma unroll
      for (int d0 = 0; d0 < 4; ++d0) {
        const bf16x8 b0 = *(const __attribute__((address_space(3))) bf16x8*)(kb + d0 * 2048), b1 = *(const __attribute__((address_space(3))) bf16x8*)(kb + d0 * 2048 + 512);
        pA0 = __builtin_amdgcn_mfma_f32_32x32x16_bf16(b0, qr[d0], pA0, 0, 0, 0); pA1 = __builtin_amdgcn_mfma_f32_32x32x16_bf16(b1, qr[d0], pA1, 0, 0, 0); }
      float rm = pA0[0];
#pragma unroll
      for (int r = 1; r < 16; ++r) rm = fmaxf(rm, pA0[r]);
#pragma unroll
      for (int r = 0; r < 16; ++r) rm = fmaxf(rm, pA1[r]);
      { auto rr = __builtin_amdgcn_permlane32_swap(__float_as_uint(rm), __float_as_uint(rm), false, false); rm = fmaxf(__uint_as_float(rr[0]), __uint_as_float(rr[1])); }
      mhat = rm;
#pragma unroll
      for (int r = 0; r < 16; ++r) { pA0[r] = __builtin_amdgcn_exp2f(pA0[r] - mhat); pA1[r] = __builtin_amdgcn_exp2f(pA1[r] - mhat); }
    }
    WAIT_BAR(0);
    DMA_K(3, 0); DMA_V(1, D_SLOTK);
    ROT();
    kload8(kf, kp0 + sl_cur);
    WAIT_BAR(3);
    s16x4 vlo[8], vhi[8]; u32x4 pw0, pw1, pw2, pw3;
#define PKW(P, B) cvtpk_s(P[B], P[B + 1])
#define PAF(k) __builtin_bit_cast(bf16x8, pw##k)
#define VFR(i) (bf16x8){vlo[i][0], vlo[i][1], vlo[i][2], vlo[i][3], vhi[i][0], vhi[i][1], vhi[i][2], vhi[i][3]}
#define PIN(x) asm volatile("" : "+v"(x))
#define MX3(a, b, c) __builtin_fmaxf(__builtin_fmaxf((a), (b)), (c))
#define EX(v) __builtin_amdgcn_exp2f(v)
#define MF(a, b, c) __builtin_amdgcn_mfma_f32_32x32x16_bf16(a, b, c, 0, 0, 0)
#define VRD(s, f) do { vlo[s] = vtr(vp_ + (((f) >> 2) * 4096 + ((f) & 3) * 1024)); vhi[s] = vtr(vp_ + (((f) >> 2) * 4096 + ((f) & 3) * 1024 + 512)); } while (0)
#define GAPA(MFS, A0, A1, A2, A3, W0, W1, PW) do { MFS; sacc += A0; sacc += A1; sacc += A2; sacc += A3; PIN(sacc); W0; W1; PIN(PW); SBAR(); } while (0)
#define GAPB(MFS, X, B) do { MFS; X[B] = EX(X[B] - mhat); X[B + 1] = EX(X[B + 1] - mhat); PIN(X); SBAR(); } while (0)
#define KRD(G, j) do { if (G) { kload2(kf, kp0 + sl_next, j); SBAR(); } } while (0)
#define STEP(C0, C1, P0, P1, t, GK, GV, GL) do { SBAR(); \
    const lds_cptr vp_ = vp0 + 2 * sl_prev; \
    VRD(0, 0); SBAR(); float sacc = (P0[0] + P0[1]); \
    GAPA(C0 = MF(kf[0], qr[0], (f32x16{})), P0[2], P0[3], P0[4], P0[5],     pw0[0] = PKW(P0, 0), pw0[1] = PKW(P0, 2), pw0); \
    VRD(1, 4); SBAR(); GAPA(C1 = MF(kf[1], qr[0], (f32x16{})), P0[6], P0[7], P0[8], P0[9],     pw0[2] = PKW(P0, 4), pw0[3] = PKW(P0, 6), pw0); \
    VRD(2, 8); SBAR(); GAPA(C0 = MF(kf[2], qr[1], C0),   P0[10], P0[11], P0[12], P0[13], pw1[0] = PKW(P0, 8), pw1[1] = PKW(P0, 10), pw1); \
    VRD(3, 12); SBAR(); GAPA(C1 = MF(kf[3], qr[1], C1),  P0[14], P0[15], P1[0], P1[1],   pw1[2] = PKW(P0, 12), pw1[3] = PKW(P0, 14), pw1); \
    VRD(4, 1); SBAR(); GAPA(C0 = MF(kf[4], qr[2], C0),   P1[2], P1[3], P1[4], P1[5],     pw2[0] = PKW(P1, 0), pw2[1] = PKW(P1, 2), pw2); \
    VRD(5, 5); SBAR(); GAPA(C1 = MF(kf[5], qr[2], C1),   P1[6], P1[7], P1[8], P1[9],     pw2[2] = PKW(P1, 4), pw2[3] = PKW(P1, 6), pw2); \
    VRD(6, 9); SBAR(); GAPA(C0 = MF(kf[6], qr[3], C0),   P1[10], P1[11], P1[12], P1[13], pw3[0] = PKW(P1, 8), pw3[1] = PKW(P1, 10), pw3); \
    VRD(7, 13); SBAR(); GAPA(C1 = MF(kf[7], qr[3], C1),  P1[14], P1[15], 0.f, 0.f,       pw3[2] = PKW(P1, 12), pw3[3] = PKW(P1, 14), pw3); \
    l_reg += sacc; \
    if (GK) { DMA_K((t) + 3, sl_cur); } if (GV) { DMA_V((t) + 1, sl_next); } \
    { float a = MX3(C0[0], C0[1], C1[0]), b = MX3(C0[2], C0[3], C1[1]); a = MX3(a, C1[2], C1[3]); \
      _Pragma("unroll") for (int r = 4; r < 16; r += 4) { a = MX3(a, C0[r], C0[r + 1]); b = MX3(b, C0[r + 2], C0[r + 3]); a = MX3(a, C1[r], C1[r + 1]); b = MX3(b, C1[r + 2], C1[r + 3]); } \
      float rm = __builtin_fmaxf(a, b); { auto rr = __builtin_amdgcn_permlane32_swap(__float_as_uint(rm), __float_as_uint(rm), false, false); rm = __builtin_fmaxf(__uint_as_float(rr[0]), __uint_as_float(rr[1])); } \
      resc = false; \
      if (__builtin_expect(__any(rm - mhat > (float)THRL), 0)) { const float dl = __builtin_fmaxf(rm - mhat, 0.f); mhat += dl; \
        const float f = __builtin_amdgcn_exp2f(-dl); l_reg *= f; if (hi == 0) wsf[r32] = f; resc = true; } } \
    SBAR(); \
    GAPB(o[0] = MF(PAF(0), VFR(0), o[0]), C0, 0);  VRD(0, 2); SBAR(); \
    GAPB(o[1] = MF(PAF(0), VFR(1), o[1]), C0, 2);  VRD(1, 6); SBAR(); \
    GAPB(o[2] = MF(PAF(0), VFR(2), o[2]), C0, 4);  VRD(2, 10); SBAR(); \
    GAPB(o[3] = MF(PAF(0), VFR(3), o[3]), C0, 6);  VRD(3, 14); SBAR(); \
    GAPB(o[0] = MF(PAF(1), VFR(4), o[0]), C0, 8);  VRD(4, 3); SBAR(); \
    GAPB(o[1] = MF(PAF(1), VFR(5), o[1]), C0, 10); VRD(5, 7); SBAR(); \
    GAPB(o[2] = MF(PAF(1), VFR(6), o[2]), C0, 12); VRD(6, 11); SBAR(); \
    GAPB(o[3] = MF(PAF(1), VFR(7), o[3]), C0, 14); VRD(7, 15); SBAR(); \
    GAPB(o[0] = MF(PAF(2), VFR(0), o[0]), C1, 0);  KRD(GL, 0); \
    GAPB(o[1] = MF(PAF(2), VFR(1), o[1]), C1, 2);  KRD(GL, 1); \
    GAPB(o[2] = MF(PAF(2), VFR(2), o[2]), C1, 4);  KRD(GL, 2); \
    GAPB(o[3] = MF(PAF(2), VFR(3), o[3]), C1, 6);  KRD(GL, 3); \
    GAPB(o[0] = MF(PAF(3), VFR(4), o[0]), C1, 8); \
    GAPB(o[1] = MF(PAF(3), VFR(5), o[1]), C1, 10); \
    GAPB(o[2] = MF(PAF(3), VFR(6), o[2]), C1, 12); \
    GAPB(o[3] = MF(PAF(3), VFR(7), o[3]), C1, 14); \
    } while (0)
#define ENDW(tt) do { if ((tt) + 3 < NT) { WAIT_BAR(3); } else if ((tt) + 2 < NT) { WAIT_BAR(2); } else { WAIT_BAR(0); } } while (0)
    int t = 1;
    for (; t + 5 < NT; t += 2) {
      STEP(pB0, pB1, pA0, pA1, t, true, true, true);       WAIT_BAR(3); RESC(); ROT();
      STEP(pA0, pA1, pB0, pB1, t + 1, true, true, true);   WAIT_BAR(3); RESC(); ROT();
    }
    for (; t + 1 < NT; t += 2) {
      STEP(pB0, pB1, pA0, pA1, t, (t + 3 < NT), (t + 1 < NT), (t + 1 < NT));         ENDW(t);     RESC(); ROT();
      STEP(pA0, pA1, pB0, pB1, t + 1, (t + 4 < NT), (t + 2 < NT), (t + 2 < NT));     ENDW(t + 1); RESC(); ROT();
    }
    STEP(pB0, pB1, pA0, pA1, NT - 1, false, false, false); RESC();
    { float sacc = pB0[0] + pB0[1];
#pragma unroll
      for (int r = 2; r < 16; ++r) sacc += pB0[r];
#pragma unroll
      for (int r = 0; r < 16; ++r) sacc += pB1[r];
      l_reg += sacc;
      pw0 = (u32x4){PKW(pB0, 0), PKW(pB0, 2), PKW(pB0, 4), PKW(pB0, 6)}; pw1 = (u32x4){PKW(pB0, 8), PKW(pB0, 10), PKW(pB0, 12), PKW(pB0, 14)};
      pw2 = (u32x4){PKW(pB1, 0), PKW(pB1, 2), PKW(pB1, 4), PKW(pB1, 6)}; pw3 = (u32x4){PKW(pB1, 8), PKW(pB1, 10), PKW(pB1, 12), PKW(pB1, 14)};
      SBAR(); pv4(o, vb0 + 2 * sl_cur, PAF(0), PAF(1), PAF(2), PAF(3)); }
#undef PKW
#undef PAF
#undef VFR
#undef PIN
#undef MX3
#undef EX
#undef MF
#undef VRD
#undef GAPA
#undef GAPB
#undef KRD
#undef STEP
#undef ENDW
#undef DMA_K
#undef DMA_V
#undef RESC
#undef ROT
    { auto rr = __builtin_amdgcn_permlane32_swap(__float_as_uint(l_reg), __float_as_uint(l_reg), false, false); l_reg = __uint_as_float(rr[0]) + __uint_as_float(rr[1]); }
    if (hi == 0) wsf[32 + r32] = l_reg; asm volatile("s_waitcnt lgkmcnt(0)" ::: "memory");
    float rli[16];
#pragma unroll
    for (int r = 0; r < 16; ++r) rli[r] = __builtin_amdgcn_rcpf(wsf[32 + crow(r, hi)]);
    AGAS float* stash_l = stash; asm volatile("" : "+s"(stash_l));
    AGAS f32x4v* st4 = (AGAS f32x4v*)(stash_l + ((size_t)wid * 64 + lane) * 64);
    if (c == 0) {
#pragma unroll
      for (int d0 = 0; d0 < 4; ++d0)
#pragma unroll
        for (int r4 = 0; r4 < 4; ++r4) st4[d0 * 4 + r4] = (f32x4v){o[d0][4 * r4] * rli[4 * r4], o[d0][4 * r4 + 1] * rli[4 * r4 + 1], o[d0][4 * r4 + 2] * rli[4 * r4 + 2], o[d0][4 * r4 + 3] * rli[4 * r4 + 3]};
    } else {
      AGAS bf16* out_l = out; asm volatile("" : "+s"(out_l));
      AGAS bf16* Ow = out_l + (row0 + q0 + wid * 32) * LDO + h * 128 + r32;
      float gv[4];
#pragma unroll
      for (int d0 = 0; d0 < 4; ++d0) gv[d0] = ng[d0 * 32 + r32] * gscale;
#pragma unroll
      for (int r4 = 0; r4 < 4; ++r4) {
        f32x4v s4[4];
#pragma unroll
        for (int d0 = 0; d0 < 4; ++d0) s4[d0] = st4[d0 * 4 + r4];
#pragma unroll
        for (int e = 0; e < 4; ++e) { const int r = 4 * r4 + e;
          float v[4]; float ss = 0.f;
#pragma unroll
          for (int d0 = 0; d0 < 4; ++d0) { v[d0] = s4[d0][e] - lam * (o[d0][r] * rli[r]); ss += v[d0] * v[d0]; }
          ss += __shfl_xor(ss, 1); ss += __shfl_xor(ss, 2); ss += __shfl_xor(ss, 4); ss += __shfl_xor(ss, 8); ss += __shfl_xor(ss, 16);
          const float rstd = 1.0f / sqrtf(ss * (1.0f / 128.0f) + 1e-5f);
          AGAS bf16* ob = Ow; asm volatile("" : "+v"(ob)); AGAS bf16* op = ob + (long)crow(r, hi) * LDO;
#pragma unroll
          for (int d0 = 0; d0 < 4; ++d0) op[d0 * 32] = f2bf1(v[d0] * rstd * gv[d0]);
        }
      }
    }
  }
  asm volatile("s_waitcnt lgkmcnt(0)\n\ts_barrier" ::: "memory");
}
#undef SBAR
#undef WAIT_BAR
}

#define GAS __attribute__((address_space(1)))
#define LAS __attribute__((address_space(3)))
typedef unsigned short bf16;
typedef unsigned v4u __attribute__((ext_vector_type(4)));
typedef float f32x4 __attribute__((ext_vector_type(4)));
typedef short bf16x8 __attribute__((ext_vector_type(8)));
typedef GAS unsigned gu32;
typedef GAS unsigned long long gu64;
#define RLX_AGENT __ATOMIC_RELAXED, __HIP_MEMORY_SCOPE_AGENT
#define LDS_WAIT() asm volatile("s_waitcnt lgkmcnt(0)" ::: "memory")
#define VM_WAIT() asm volatile("s_waitcnt vmcnt(0)" ::: "memory")
__device__ __forceinline__ unsigned long long rt() { return __builtin_amdgcn_s_memrealtime(); }
__device__ __forceinline__ unsigned f2bf(float f) { unsigned u = __builtin_bit_cast(unsigned, f); return (u + 0x7fffu + ((u >> 16) & 1u)) >> 16; }
__device__ __forceinline__ unsigned pk2(float lo, float hi) { return f2bf(lo) | (f2bf(hi) << 16); }
#define XB_TMO      128
#define XB_XCNT(j)  (256  + 64 * (j))
#define XB_XSUB(j)  (1280 + 64 * (j))
#define XB_XGEN(j)  (2304 + 64 * (j))
#define XB_TOP      3328
#define XB_TOPGEN   3392
#define XCD_BAR_WORDS 3456
#define XB_SPIN_CAP (1u << 18)

__device__ __forceinline__ unsigned xb_ld(unsigned* p)              { return __hip_atomic_load(p, __ATOMIC_RELAXED, __HIP_MEMORY_SCOPE_AGENT); }
__device__ __forceinline__ unsigned xb_add(unsigned* p, unsigned v) { return __hip_atomic_fetch_add(p, v, __ATOMIC_RELAXED, __HIP_MEMORY_SCOPE_AGENT); }
__device__ __forceinline__ unsigned xb_xcc_id() { return (unsigned)__builtin_amdgcn_s_getreg((3 << 11) | 20) & 0xFu; }
#define XB_SPIN(cond, bar) do { unsigned _sp = 0; while (cond) { __builtin_amdgcn_s_sleep(1); \
    if ((++_sp & 255u) == 0u) { if (xb_ld(&(bar)[XB_TMO])) break; if (_sp > XB_SPIN_CAP) { atomicAdd(&(bar)[XB_TMO], 1u); break; } } } } while (0)

struct XcdBarrier {
    unsigned* bar; unsigned x;
    volatile LAS unsigned* st;
};

__device__ __forceinline__ XcdBarrier xcd_barrier_post(unsigned* bar, volatile LAS unsigned* st) {
    XcdBarrier b; b.bar = bar; b.x = xb_xcc_id(); b.st = st;
    if (threadIdx.x == 0) (void)xb_add(&bar[XB_XCNT(b.x)], 1u);
    return b;
}
__device__ __forceinline__ void xcd_barrier_complete(unsigned* bar, unsigned x, unsigned& nloc, unsigned& nx) {
    const unsigned G = gridDim.x * gridDim.y * gridDim.z;
    unsigned sum, cnt, mine, sp = 0u;
    for (;;) {
        sum = 0u; cnt = 0u; mine = 0u;
#pragma unroll
        for (unsigned j = 0; j < 16; ++j) { const unsigned c = xb_ld(&bar[XB_XCNT(j)]); sum += c; cnt += (c > 0u) ? 1u : 0u; mine = (j == x) ? c : mine; }
        if (sum == G) break;
        __builtin_amdgcn_s_sleep(1);
        if ((++sp & 255u) == 0u) { if (xb_ld(&bar[XB_TMO])) break; if (sp > XB_SPIN_CAP) { atomicAdd(&bar[XB_TMO], 1u); break; } }
    }
    nloc = mine > 0u ? mine : 1u; nx = cnt > 0u ? cnt : 1u;
}

__device__ __forceinline__ void xcd_barrier(const XcdBarrier& b) {
    asm volatile("s_waitcnt vmcnt(0)" ::: "memory");
    __syncthreads();
    unsigned bx_ = b.x; asm volatile("" : "+s"(bx_));
    if (threadIdx.x == 0) {
        unsigned* bar = b.bar; asm volatile("" : "+s"(bar));
        __builtin_amdgcn_s_waitcnt(0);
        unsigned nloc = b.st[0], nx = b.st[1];
        if (nloc == 0u) { xcd_barrier_complete(bar, bx_, nloc, nx); b.st[0] = nloc; b.st[1] = nx; }
        const unsigned old = xb_add(&bar[XB_XSUB(bx_)], 1u);
        const unsigned gen = old / nloc;
        if (old + 1u == (gen + 1u) * nloc) {
            __builtin_amdgcn_fence(__ATOMIC_RELEASE, "agent");
            asm volatile("s_waitcnt vmcnt(0)" ::: "memory");
            const unsigned og = xb_add(&bar[XB_TOP], 1u);
            const unsigned tg = og / nx;
            if (og + 1u == (tg + 1u) * nx) xb_add(&bar[XB_TOPGEN], 1u);
            else XB_SPIN(xb_ld(&bar[XB_TOPGEN]) == tg, bar);
            __builtin_amdgcn_fence(__ATOMIC_ACQUIRE, "agent");
            xb_add(&bar[XB_XGEN(bx_)], 1u);
            asm volatile("s_waitcnt vmcnt(0)" ::: "memory");
        } else {
            XB_SPIN(xb_ld(&bar[XB_XGEN(bx_)]) == gen, bar);
            __builtin_amdgcn_fence(__ATOMIC_ACQUIRE, "agent");
            asm volatile("s_waitcnt vmcnt(0)" ::: "memory");
        }
    }
    __syncthreads();
}
constexpr int NWAVES = 8;
constexpr int DM = 2048, DFF = 5632, NGU = 2 * DFF, NIN = 6144, NLAYER = 2;
constexpr int MP = 8 * 4096, MS = 2 * 16384, M = MP + MS;
constexpr int NB = 10, MODW = 9 * DM;
constexpr float LN_EPS = 1e-5f;
constexpr float DN_ALPHA = 1.4142135623730951f;

constexpr size_t MiB = 1u << 20;
constexpr size_t WS_CTL = 0, CTL_ZERO_BYTES = 1 * MiB;
constexpr size_t WS_MODV = 1 * MiB;
constexpr size_t WS_ROPE = 3 * MiB;
constexpr size_t WS_MISC = 7 * MiB;
constexpr size_t WS_W = 8 * MiB;
constexpr size_t WO_GU1 = 0, WO_D1 = 44 * MiB, WO_IN = 66 * MiB, WO_OUT = 90 * MiB, WO_GU2 = 98 * MiB, WO_D2 = 142 * MiB, W_BYTES = 164 * MiB;
constexpr size_t WS_HA = WS_W + W_BYTES;
constexpr size_t WS_HB = WS_HA + 256 * MiB;
constexpr size_t WS_BIG = WS_HB + 256 * MiB;
constexpr size_t WS_END = WS_BIG + 768 * MiB;
static_assert((size_t)NGU * DM * 2 == 44 * MiB && (size_t)DM * DFF * 2 == 22 * MiB && (size_t)NIN * DM * 2 == 24 * MiB && (size_t)DM * DM * 2 == 8 * MiB, "weight map");
static_assert((size_t)M * NIN * 2 == 768 * MiB && (size_t)M * DM * 2 == 256 * MiB, "activation map");
constexpr int CW_BAR = 4096;

constexpr int RING_OFF = 0, RING_BYTES = 131072;
constexpr int LDSCTL_OFF = RING_BYTES, MISC_OFF = LDSCTL_OFF + 320;
constexpr int LDS_BYTES = 147456;

__device__ __forceinline__ float wave_sum(float v) {
#pragma unroll
    for (int o = 1; o < 64; o <<= 1) v += __shfl_xor(v, o);
    return v;
}
template <int MODE> __device__ __forceinline__ int dest_row(int s) {
    if (MODE == 1) { const int half = s >= DFF ? 1 : 0; const int j = s - half * DFF; return 256 * (j >> 7) + 128 * half + (j & 127); }
    if (MODE == 2) { if (s < 2048) { const int d = s & 63; const int p = d < 32 ? 2 * d : 2 * (d - 32) + 1; return (s & ~63) + p; } return s; }
    return s;
}
template <int MODE> __device__ __forceinline__ void transpose_item(const float* W, int K, int N, bf16* WT, LAS float* scr, int item, int lane) {
    const int nblk = N / 32, kb = item / nblk, nb = item % nblk, k0 = 64 * kb, n0 = 32 * nb;
#pragma unroll 8
    for (int i = 0; i < 32; ++i) { const int kk = 2 * i + (lane >> 5); scr[kk * 33 + (lane & 31)] = W[(size_t)(k0 + kk) * N + n0 + (lane & 31)]; }
    LDS_WAIT(); asm volatile("" ::: "memory");
    const int c = lane & 7;
#pragma unroll
    for (int j = 0; j < 4; ++j) { const int n = (lane >> 3) + 8 * j; const LAS float* s = scr + (8 * c) * 33 + n;
        v4u o; o.x = pk2(s[0 * 33], s[1 * 33]); o.y = pk2(s[2 * 33], s[3 * 33]); o.z = pk2(s[4 * 33], s[5 * 33]); o.w = pk2(s[6 * 33], s[7 * 33]);
        const int dr = dest_row<MODE>(n0 + n);
        *(GAS v4u*)(WT + ((size_t)(dr >> 8) * (K >> 6) + (k0 >> 6)) * 16384 + (dr & 255) * 64 + 8 * c) = o; }
    LDS_WAIT(); asm volatile("" ::: "memory");
}
struct Args { const GAS float* in[20]; GAS float* out; GAS unsigned char* ws; };

typedef const __attribute__((address_space(4))) Args* KArgsT;
__device__ __forceinline__ void convert_layer(KArgsT a, int l, unsigned char* wsw, LAS float* scr, int gw, int NGW, int lane) {
    constexpr int I_GU = (DM / 64) * (NGU / 32), I_D = (DFF / 64) * (DM / 32), I_IN = (DM / 64) * (NIN / 32), I_O = (DM / 64) * (DM / 32);
    constexpr int NITEMS = 2 * I_GU + 2 * I_D + I_IN + I_O;
    asm volatile("" : "+v"(lane));
    for (int it = gw; it < NITEMS; it += NGW) {
        int r = it;
        if (r < I_GU) { transpose_item<1>(((const float*)a->in[8]) + (size_t)l * DM * NGU, DM, NGU, (bf16*)(wsw + WO_GU1), scr, r, lane); continue; } r -= I_GU;
        if (r < I_D)  { transpose_item<0>(((const float*)a->in[9]) + (size_t)l * DFF * DM, DFF, DM, (bf16*)(wsw + WO_D1), scr, r, lane); continue; } r -= I_D;
        if (r < I_IN) { transpose_item<2>(((const float*)a->in[10]) + (size_t)l * DM * NIN, DM, NIN, (bf16*)(wsw + WO_IN), scr, r, lane); continue; } r -= I_IN;
        if (r < I_O)  { transpose_item<0>(((const float*)a->in[11]) + (size_t)l * DM * DM, DM, DM, (bf16*)(wsw + WO_OUT), scr, r, lane); continue; } r -= I_O;
        if (r < I_GU) { transpose_item<1>(((const float*)a->in[18]) + (size_t)l * DM * NGU, DM, NGU, (bf16*)(wsw + WO_GU2), scr, r, lane); continue; } r -= I_GU;
        transpose_item<0>(((const float*)a->in[19]) + (size_t)l * DFF * DM, DFF, DM, (bf16*)(wsw + WO_D2), scr, r, lane);
    }
}
__device__ __forceinline__ int batch_of_row(int m) { return m < MP ? (m >> 12) : 8 + ((m - MP) >> 14); }
__device__ __forceinline__ void mod_rows(const float* xp, const float* xs, bf16* hout, const float* modl, int sh_idx, int gw, int NGW, int lane) {
    asm volatile("" : "+v"(lane));
    for (int m = gw; m < M; m += NGW) {
        const float* xr = m < MP ? xp + (size_t)m * DM : xs + (size_t)(m - MP) * DM;
        const float* mb = modl + (size_t)batch_of_row(m) * MODW;
        GAS unsigned long long* o8 = (GAS unsigned long long*)(hout + (size_t)m * DM) + lane;
#pragma unroll
        for (int j = 0; j < 8; ++j) { const int col = 4 * lane + 256 * j;
            const f32x4 v = *(const GAS f32x4*)(xr + col), sh = *(const GAS f32x4*)(mb + sh_idx * DM + col), sc = *(const GAS f32x4*)(mb + (sh_idx + 1) * DM + col);
            const f32x4 hv = v * (sc + 1.0f) + sh;
            o8[64 * j] = (unsigned long long)pk2(hv.x, hv.y) | ((unsigned long long)pk2(hv.z, hv.w) << 32); }
    }
}
__device__ __forceinline__ void ln_rows(float* y, bf16* hout, const float* lng, const float* lnb, const float* modl, int sh_idx, int gw, int NGW, int lane) {
    asm volatile("" : "+v"(lane));
    for (int m = gw; m < M; m += NGW) {
        GAS f32x4* yr = (GAS f32x4*)(y + (size_t)m * DM) + lane;
        f32x4 v[8]; float s = 0.f;
#pragma unroll
        for (int j = 0; j < 8; ++j) { v[j] = yr[64 * j]; s += (v[j].x + v[j].y) + (v[j].z + v[j].w); }
        const float mean = wave_sum(s) * (1.f / DM); float s2 = 0.f;
#pragma unroll
        for (int j = 0; j < 8; ++j) { v[j] = v[j] - mean; s2 += (v[j].x * v[j].x + v[j].y * v[j].y) + (v[j].z * v[j].z + v[j].w * v[j].w); }
        const float rstd = 1.f / sqrtf(wave_sum(s2) * (1.f / DM) + LN_EPS);
        const float* mb = modl + (size_t)batch_of_row(m) * MODW;
        GAS unsigned long long* o8 = (GAS unsigned long long*)(hout + (size_t)m * DM) + lane;
#pragma unroll
        for (int j = 0; j < 8; ++j) { const int col = 4 * lane + 256 * j;
            const f32x4 g = *(const GAS f32x4*)(lng + col), b = *(const GAS f32x4*)(lnb + col);
            const f32x4 xv = v[j] * rstd * g + b;
            yr[64 * j] = xv;
            if (hout) { const f32x4 sh = *(const GAS f32x4*)(mb + sh_idx * DM + col), sc = *(const GAS f32x4*)(mb + (sh_idx + 1) * DM + col);
                const f32x4 hv = xv * (sc + 1.0f) + sh;
                o8[64 * j] = (unsigned long long)pk2(hv.x, hv.y) | ((unsigned long long)pk2(hv.z, hv.w) << 32); } }
    }
}
#ifdef PROBE_LN_REP
__device__ __forceinline__ void ln_dummy(float* y, bf16* hout, const float* modl, int sh_idx, int gw, int NGW, int lane) {
    asm volatile("" : "+v"(lane));
    for (int m = gw; m < M; m += NGW) {
        GAS f32x4* yr = (GAS f32x4*)(y + (size_t)m * DM) + lane;
        f32x4 v[8]; float s = 0.f;
#pragma unroll
        for (int j = 0; j < 8; ++j) { v[j] = yr[64 * j]; s += (v[j].x + v[j].y) + (v[j].z + v[j].w); }
        const float mean = wave_sum(s) * (1.f / DM); float s2 = 0.f;
#pragma unroll
        for (int j = 0; j < 8; ++j) { const f32x4 d = v[j] - mean; s2 += (d.x * d.x + d.y * d.y) + (d.z * d.z + d.w * d.w); }
        const float rstd = 1.f / sqrtf(wave_sum(s2) * (1.f / DM) + LN_EPS);
        const float keep = rstd > 1e30f ? 0.f : 1.f;
        const float* mb = modl + (size_t)batch_of_row(m) * MODW;
        GAS unsigned long long* o8 = (GAS unsigned long long*)(hout + (size_t)m * DM) + lane;
#pragma unroll
        for (int j = 0; j < 8; ++j) { const int col = 4 * lane + 256 * j;
            const f32x4 xv = v[j] * keep;
            yr[64 * j] = xv;
            const f32x4 sh = *(const GAS f32x4*)(mb + sh_idx * DM + col), sc = *(const GAS f32x4*)(mb + (sh_idx + 1) * DM + col);
            const f32x4 hv = xv * (sc + 1.0f) + sh;
            o8[64 * j] = (unsigned long long)pk2(hv.x, hv.y) | ((unsigned long long)pk2(hv.z, hv.w) << 32); }
    }
}
#endif
__device__ __forceinline__ void modv_phase(KArgsT a, float* modv, LAS unsigned char* lds, int G, int tid, int wave, int lane) {
    LAS float* sc = (LAS float*)lds;
    LAS float* red = (LAS float*)(lds + NB * DM * 4);
    constexpr int NCH = MODW / 128, NIT = NLAYER * NCH;
    if ((int)blockIdx.x >= NIT) return;
    for (int i = tid; i < NB * DM; i += NWAVES * 64) { const int b = i / DM, k = i % DM; const float cv = b < 8 ? ((const float*)a->in[2])[b * DM + k] : ((const float*)a->in[3])[(b - 8) * DM + k];
        sc[i] = cv / (1.0f + __expf(-cv)); }
    __syncthreads();
    for (int it = blockIdx.x; it < NIT; it += G) {
        const int l = it / NCH, ch = it % NCH;
        const float* wp = ((const float*)a->in[4]) + ((size_t)l * DM + wave * 256) * MODW + ch * 128 + 2 * lane;
        float ax[NB], ay[NB];
#pragma unroll
        for (int b = 0; b < NB; ++b) { ax[b] = 0.f; ay[b] = 0.f; }
        for (int k = 0; k < 256; k += 4) {
            typedef float f32x2v __attribute__((ext_vector_type(2)));
            const f32x2v w0 = *(const GAS f32x2v*)(wp + (size_t)(k + 0) * MODW), w1 = *(const GAS f32x2v*)(wp + (size_t)(k + 1) * MODW);
            const f32x2v w2 = *(const GAS f32x2v*)(wp + (size_t)(k + 2) * MODW), w3 = *(const GAS f32x2v*)(wp + (size_t)(k + 3) * MODW);
#pragma unroll
            for (int b = 0; b < NB; ++b) { const f32x4 s4 = *(const LAS f32x4*)(sc + b * DM + wave * 256 + k);
                ax[b] += s4.x * w0.x + s4.y * w1.x + s4.z * w2.x + s4.w * w3.x; ay[b] += s4.x * w0.y + s4.y * w1.y + s4.z * w2.y + s4.w * w3.y; }
        }
#pragma unroll
        for (int b = 0; b < NB; ++b) { red[(wave * NB + b) * 128 + 2 * lane] = ax[b]; red[(wave * NB + b) * 128 + 2 * lane + 1] = ay[b]; }
        __syncthreads();
        for (int o = tid; o < NB * 128; o += NWAVES * 64) { const int b = o / 128, cc = o % 128; float s = 0.f;
#pragma unroll
            for (int w = 0; w < NWAVES; ++w) s += red[(w * NB + b) * 128 + cc];
            modv[((size_t)l * NB + b) * MODW + ch * 128 + cc] = s + ((const float*)a->in[5])[(size_t)l * MODW + ch * 128 + cc]; }
        __syncthreads();
    }
}
__device__ const double ROPE_INVF[32] = {1.0,0.7498942093324559,0.5623413251903491,0.4216965034285822,0.31622776601683794,0.23713737056616552,0.1778279410038923,0.1333521432163324,0.1,0.07498942093324558,0.05623413251903491,0.042169650342858224,0.03162277660168379,0.023713737056616554,0.01778279410038923,0.01333521432163324,0.01,0.007498942093324558,0.005623413251903491,0.004216965034285823,0.0031622776601683794,0.0023713737056616554,0.0017782794100389228,0.001333521432163324,0.001,0.0007498942093324559,0.0005623413251903491,0.00042169650342858224,0.00031622776601683794,0.00023713737056616554,0.00017782794100389227,0.0001333521432163324};
__device__ __forceinline__ void rope_tables(float* ropeC, float* ropeS, int gtid, int nthr) {
    for (int idx = gtid; idx < 16384 * 32; idx += nthr) {
        const int t = idx >> 5, i = idx & 31; const double x = (double)t * ROPE_INVF[i];
        const double q = __builtin_rint(x * 0.63661977236758134308);
        double r = __builtin_fma(-q, 1.57079632679489655800e+00, x); r = __builtin_fma(-q, 6.12323399573676603587e-17, r);
        const double r2 = r * r;
        const double sp = r + r * r2 * (-1.0 / 6 + r2 * (1.0 / 120 + r2 * (-1.0 / 5040 + r2 * (1.0 / 362880 + r2 * (-1.0 / 39916800 + r2 * (1.0 / 6227020800.0))))));
        const double cp = 1.0 + r2 * (-0.5 + r2 * (1.0 / 24 + r2 * (-1.0 / 720 + r2 * (1.0 / 40320 + r2 * (-1.0 / 3628800 + r2 * (1.0 / 479001600.0 + r2 * (-1.0 / 87178291200.0)))))));
        const int qi = ((int)q) & 3;
        const double sv = qi == 0 ? sp : qi == 1 ? cp : qi == 2 ? -sp : -cp;
        const double cv = qi == 0 ? cp : qi == 1 ? -sp : qi == 2 ? -cp : sp;
        ropeC[idx] = (float)cv; ropeS[idx] = (float)sv;
    }
}

#ifndef PH
#define PH 0xFFFF
#endif
#define LAUNDER_S(p) asm volatile("" : "+s"(p))
typedef const __attribute__((address_space(4))) Args* KArgs;
__device__ __forceinline__ KArgs kargs() { KArgs p = (KArgs)__builtin_amdgcn_kernarg_segment_ptr(); LAUNDER_S(p); return p; }
constexpr float LAM_INIT0 = 0.2f, LAM_INIT1 = 0.35550906759096926f;

__global__ void __launch_bounds__(NWAVES * 64, 2) mega_fwd(Args args_unused) {
    extern __shared__ __attribute__((aligned(16))) unsigned char lds[];
    LAS unsigned char* L = (LAS unsigned char*)lds;
    volatile LAS unsigned* MISC = (volatile LAS unsigned*)(L + MISC_OFF);
    const int tid = threadIdx.x, lane = tid & 63, wave = __builtin_amdgcn_readfirstlane(tid >> 6);
    const int G = gridDim.x; const int bx = blockIdx.x; const int vcu = (G % 8 == 0) ? (bx % 8) * (G / 8) + bx / 8 : bx;
    const int gw = vcu * NWAVES + wave, NGW = G * NWAVES;
    for (int u = tid; u < (LDS_BYTES - LDSCTL_OFF) / 4; u += NWAVES * 64) ((LAS unsigned*)(L + LDSCTL_OFF))[u] = 0u;
    __syncthreads();
    XcdBarrier bar;
    { KArgs ap = kargs(); bar = xcd_barrier_post((unsigned*)(((unsigned char*)ap->ws) + WS_CTL) + CW_BAR, MISC + 8); }
#ifdef PROBE_BAR_REP
#define GRID_BAR() do { _Pragma("unroll 1") for (int rep_ = 0; rep_ < PROBE_BAR_REP; ++rep_) xcd_barrier(bar); } while (0)
#else
#define GRID_BAR() xcd_barrier(bar)
#endif
    LAS float* scr = (LAS float*)(L + RING_OFF + wave * 16384);

    {
        KArgs ap = kargs(); unsigned char* ws = ((unsigned char*)ap->ws);
#if PH & 1
        modv_phase(ap, (float*)(ws + WS_MODV), L, G, tid, wave, lane);
        rope_tables((float*)(ws + WS_ROPE), (float*)(ws + WS_ROPE) + 16384 * 32, bx * (NWAVES * 64) + tid, G * NWAVES * 64);
#endif
        if (bx == 0 && wave == 0) {
            float* lamv = (float*)(ws + WS_MISC);
#pragma unroll
            for (int l = 0; l < NLAYER; ++l) {
                const float s1 = wave_sum(((const float*)ap->in[12])[l * 64 + lane] * ((const float*)ap->in[13])[l * 64 + lane]), s2 = wave_sum(((const float*)ap->in[14])[l * 64 + lane] * ((const float*)ap->in[15])[l * 64 + lane]);
                if (lane == 0) lamv[l] = expf(s1) - expf(s2) + (l == 0 ? LAM_INIT0 : LAM_INIT1);
            }
        }
        __syncthreads();
#if PH & 2
#ifdef PROBE_CONV_REP
#pragma unroll 1
        for (int rep = 1; rep < PROBE_CONV_REP; ++rep) convert_layer(ap, 0, ws + WS_W, scr, gw, NGW, lane);
#endif
        convert_layer(ap, 0, ws + WS_W, scr, gw, NGW, lane);
#endif
    }
    GRID_BAR();
    {
        KArgs ap = kargs(); unsigned char* ws = ((unsigned char*)ap->ws);
#if PH & 4
        mod_rows(((const float*)ap->in[0]), ((const float*)ap->in[1]), (bf16*)(ws + WS_HA), (const float*)(ws + WS_MODV), 0, gw, NGW, lane);
#endif
    }
    GRID_BAR();

#pragma unroll 1
    for (int l = 0; l < NLAYER; ++l) {
        { KArgs ap = kargs(); unsigned char* ws = ((unsigned char*)ap->ws);
          pg8::Gemm g{(const bf16*)(ws + WS_HA), (const bf16*)(ws + WS_W + WO_GU1), M, NGU, DM}; pg8::StaticOrder S; { int g_ = G, c_ = bx; LAUNDER_S(g_); LAUNDER_S(c_); S.init(M, NGU, g_, c_); }
          pg8::EpiSwiGLU E{(bf16*)(ws + WS_BIG), DFF};
#if PH & 8
#ifdef PROBE_G1_REP
#pragma unroll 1
          for (int rep = 0; rep < PROBE_G1_REP; ++rep)
#endif
          pg8::gemm_phase<pg8::EpiSwiGLU, pg8::StaticOrder, true, true, false, true>(L + RING_OFF, g, S, E);
#endif
        }
        GRID_BAR();
        { KArgs ap = kargs(); unsigned char* ws = ((unsigned char*)ap->ws); float* out = ((float*)ap->out);
          const float* xsrc_p = l == 0 ? ((const float*)ap->in[0]) : out; const float* xsrc_s = l == 0 ? ((const float*)ap->in[1]) : out + (size_t)MP * DM;
          pg8::Gemm g{(const bf16*)(ws + WS_BIG), (const bf16*)(ws + WS_W + WO_D1), M, DM, DFF}; pg8::StaticOrderG<4> S; { int g_ = G, c_ = bx; LAUNDER_S(g_); LAUNDER_S(c_); S.init(M, DM, g_, c_); }
          pg8::EpiResid E{xsrc_p, xsrc_s, out, DM, (const float*)(ws + WS_MODV) + (size_t)l * NB * MODW + 2 * DM, 0.5f, DN_ALPHA};
#if PH & 16
#ifdef PROBE_G2_REP
#pragma unroll 1
          for (int rep = 0; rep < (l == 0 ? PROBE_G2_REP : 1); ++rep)
#endif
          pg8::gemm_phase<pg8::EpiResid, pg8::StaticOrderG<4>, true, true, true, true>(L + RING_OFF, g, S, E);
#endif
        }
        GRID_BAR();
        { KArgs ap = kargs(); unsigned char* ws = ((unsigned char*)ap->ws);
#if PH & 4
          ln_rows(((float*)ap->out), (bf16*)(ws + WS_HB), ((const float*)ap->in[6]) + (size_t)l * 3 * DM, ((const float*)ap->in[7]) + (size_t)l * 3 * DM, (const float*)(ws + WS_MODV) + (size_t)l * NB * MODW, 3, gw, NGW, lane);
#ifdef PROBE_LN_REP
#pragma unroll 1
          for (int rep = 1; rep < PROBE_LN_REP; ++rep) ln_dummy(((float*)ap->out), (bf16*)(ws + WS_HB), (const float*)(ws + WS_MODV) + (size_t)l * NB * MODW, 3, gw, NGW, lane);
#endif
#endif
        }
        GRID_BAR();
        { KArgs ap = kargs(); unsigned char* ws = ((unsigned char*)ap->ws);
          pg8::Gemm g{(const bf16*)(ws + WS_HB), (const bf16*)(ws + WS_W + WO_IN), M, NIN, DM}; pg8::StaticOrder S; { int g_ = G, c_ = bx; LAUNDER_S(g_); LAUNDER_S(c_); S.init(M, NIN, g_, c_); }
          #ifdef USE_DIFF1
          pg8::EpiRope E{(bf16*)(ws + WS_BIG), NIN, (const float*)(ws + WS_ROPE), (const float*)(ws + WS_ROPE) + 16384 * 32, 1.0f};
#else
          pg8::EpiRope E{(bf16*)(ws + WS_BIG), NIN, (const float*)(ws + WS_ROPE), (const float*)(ws + WS_ROPE) + 16384 * 32, 0.125f * 1.4426950408889634f};
#endif
#if PH & 32
#ifdef PROBE_G3_REP
#pragma unroll 1
          for (int rep = 0; rep < PROBE_G3_REP; ++rep)
#endif
          pg8::gemm_phase<pg8::EpiRope, pg8::StaticOrder, true, true, false, true>(L + RING_OFF, g, S, E);
#endif
        }
        GRID_BAR();
        {
            KArgs ap = kargs(); unsigned char* ws = ((unsigned char*)ap->ws);
            const GAS bf16* BIG = (const GAS bf16*)(ap->ws + WS_BIG); GAS bf16* HA = (GAS bf16*)(ap->ws + WS_HA);
            const float lam = ((const float*)(ws + WS_MISC))[l]; const float gscale = 1.0f - (l == 0 ? LAM_INIT0 : LAM_INIT1);
            const GAS float* ng = ap->in[16] + l * 128; const GAS float* rpb = ap->in[17] + (size_t)l * 8 * 15 * 31;
            GAS float* stash = (GAS float*)(ap->ws + WS_HB) + (size_t)bx * 32768;
#ifndef PROBE_ATT_REP
#define PROBE_ATT_REP 1
#endif
#pragma unroll 1
            for (int rep = 0; rep < PROBE_ATT_REP; ++rep)
#pragma unroll 1
            for (int i = 0;; ++i) {
                const int u = i * G + vcu; if (u >= 4096) break;
#ifdef PROBE_NA_ONLY_REP
                if (rep > 0 && u < 2048) continue;
#endif
                if (u < 2048) {
                    long row0; int T, h, q0;
                    if (u < 1024) { const int bh = u >> 6, qt = u & 63; row0 = MP + (long)(bh >> 3) * 16384; T = 16384; h = bh & 7; q0 = qt * 256; }
                    else { const int v = u - 1024, bh = v >> 4, qt = v & 15; row0 = (long)(bh >> 3) * 4096; T = 4096; h = bh & 7; q0 = qt * 256; }
#if PH & 64
#ifdef USE_DIFF1
                    att::diff_unit(BIG, row0, T, h, q0, lam, gscale, ng, HA, stash, (char*)lds);
#else
                    att::diff_unit2<8>(BIG, row0, T, h, q0, lam, gscale, ng, HA, stash, (char*)lds);
#endif
#endif
                } else {
                    long row0; int rows, h, r0; int v = u - 2048;
                    if (v < 1024) { const int bh = v >> 4, rg = v & 15; row0 = (long)(bh >> 3) * 4096; rows = 64; h = bh & 7; r0 = rg * 4; }
                    else { v -= 1024; const int bh = v >> 6, rg = v & 63; row0 = MP + (long)(bh >> 3) * 16384; rows = 256; h = bh & 7; r0 = rg * 4; }
#if PH & 128
                    att::na_unit(BIG, row0, rows, h, r0, rpb + h * 15 * 31, HA, (char*)lds);
#endif
                }
            }
        }
        GRID_BAR();
        { KArgs ap = kargs(); unsigned char* ws = ((unsigned char*)ap->ws); float* out = ((float*)ap->out);
          pg8::Gemm g{(const bf16*)(ws + WS_HA), (const bf16*)(ws + WS_W + WO_OUT), M, DM, DM}; pg8::StaticOrderG<4> S; { int g_ = G, c_ = bx; LAUNDER_S(g_); LAUNDER_S(c_); S.init(M, DM, g_, c_); }
          pg8::EpiResid E{out, out + (size_t)MP * DM, out, DM, (const float*)(ws + WS_MODV) + (size_t)l * NB * MODW + 5 * DM, 1.0f, DN_ALPHA};
#if PH & 16
          pg8::gemm_phase<pg8::EpiResid, pg8::StaticOrderG<4>, true, true, false, true>(L + RING_OFF, g, S, E);
#endif
        }
        GRID_BAR();
        { KArgs ap = kargs(); unsigned char* ws = ((unsigned char*)ap->ws);
#if PH & 4
          ln_rows(((float*)ap->out), (bf16*)(ws + WS_HB), ((const float*)ap->in[6]) + (size_t)l * 3 * DM + DM, ((const float*)ap->in[7]) + (size_t)l * 3 * DM + DM, (const float*)(ws + WS_MODV) + (size_t)l * NB * MODW, 6, gw, NGW, lane);
#endif
        }
        GRID_BAR();
        { KArgs ap = kargs(); unsigned char* ws = ((unsigned char*)ap->ws);
          pg8::Gemm g{(const bf16*)(ws + WS_HB), (const bf16*)(ws + WS_W + WO_GU2), M, NGU, DM}; pg8::StaticOrder S; { int g_ = G, c_ = bx; LAUNDER_S(g_); LAUNDER_S(c_); S.init(M, NGU, g_, c_); }
          pg8::EpiSwiGLU E{(bf16*)(ws + WS_BIG), DFF};
#if PH & 8
#ifdef PROBE_G1_REP
#pragma unroll 1
          for (int rep = 0; rep < PROBE_G1_REP; ++rep)
#endif
          pg8::gemm_phase<pg8::EpiSwiGLU, pg8::StaticOrder, true, true, false, true>(L + RING_OFF, g, S, E);
#endif
        }
        GRID_BAR();
        { KArgs ap = kargs(); unsigned char* ws = ((unsigned char*)ap->ws); float* out = ((float*)ap->out);
          pg8::Gemm g{(const bf16*)(ws + WS_BIG), (const bf16*)(ws + WS_W + WO_D2), M, DM, DFF}; pg8::StaticOrderG<4> S; { int g_ = G, c_ = bx; LAUNDER_S(g_); LAUNDER_S(c_); S.init(M, DM, g_, c_); }
          pg8::EpiResid E{out, out + (size_t)MP * DM, out, DM, (const float*)(ws + WS_MODV) + (size_t)l * NB * MODW + 8 * DM, 0.5f, DN_ALPHA};
#if PH & 16
          pg8::gemm_phase<pg8::EpiResid, pg8::StaticOrderG<4>, true, true, true, true>(L + RING_OFF, g, S, E);
#endif
        }
        GRID_BAR();
        { KArgs ap = kargs(); unsigned char* ws = ((unsigned char*)ap->ws);
          const float* lng = ((const float*)ap->in[6]) + (size_t)l * 3 * DM + 2 * DM; const float* lnb = ((const float*)ap->in[7]) + (size_t)l * 3 * DM + 2 * DM;
          if (l + 1 < NLAYER) {
#if PH & 4
            ln_rows(((float*)ap->out), (bf16*)(ws + WS_HA), lng, lnb, (const float*)(ws + WS_MODV) + (size_t)(l + 1) * NB * MODW, 0, gw, NGW, lane);
#endif
#if PH & 2
            convert_layer(ap, l + 1, ws + WS_W, scr, gw, NGW, lane);
#endif
          } else {
#if PH & 4
            ln_rows(((float*)ap->out), nullptr, lng, lnb, (const float*)(ws + WS_MODV), 0, gw, NGW, lane);
#endif
          }
        }
        if (l + 1 < NLAYER) GRID_BAR();
    }
#undef GRID_BAR
}

extern "C" void kernel_launch(void* const* d_in, const int* in_sizes, int n_in, void* d_out, int out_size, void* d_ws, size_t ws_size, hipStream_t stream) {
    static int grid = 0;
    if (grid == 0) {
        if (n_in != 20 || out_size != M * DM || ws_size < WS_END) { fprintf(stderr, "kernel_launch: unexpected shapes: n_in %d out %d ws %zu (need %zu)\n", n_in, out_size, ws_size, (size_t)WS_END); grid = -1; return; }
        int dev = 0, cus = 0, per_cu = 0;
        if (hipGetDevice(&dev) != hipSuccess || hipDeviceGetAttribute(&cus, hipDeviceAttributeMultiprocessorCount, dev) != hipSuccess) { grid = -1; return; }
        if (hipFuncSetAttribute((const void*)mega_fwd, hipFuncAttributeMaxDynamicSharedMemorySize, LDS_BYTES) != hipSuccess) { fprintf(stderr, "kernel_launch: hipFuncSetAttribute failed\n"); grid = -1; return; }
        if (hipOccupancyMaxActiveBlocksPerMultiprocessor(&per_cu, (const void*)mega_fwd, NWAVES * 64, LDS_BYTES) != hipSuccess || per_cu < 1)
            fprintf(stderr, "kernel_launch: note: occupancy query reports %d workgroups per CU\n", per_cu);
        (void)hipGetLastError();
        grid = cus;
    }
    if (grid < 0) return;
    if (hipMemsetAsync((char*)d_ws + WS_CTL, 0, CTL_ZERO_BYTES, stream) != hipSuccess) return;
    Args a{};
    for (int i = 0; i < 20; ++i) a.in[i] = (const GAS float*)d_in[i];
    a.out = (GAS float*)d_out; a.ws = (GAS unsigned char*)d_ws;
    hipLaunchKernelGGL(mega_fwd, dim3(grid), dim3(NWAVES * 64), LDS_BYTES, stream, a);
    const hipError_t le = hipPeekAtLastError();
    if (le != hipSuccess) fprintf(stderr, "kernel_launch: launch failed: %s\n", hipGetErrorName(le));
}
```

```cpp
#include <hip/hip_runtime.h>
#include <cstdio>
#include <cstdint>
namespace pg8 {
#define PG8_LAS __attribute__((address_space(3)))
typedef unsigned short bf16_t;
typedef short bf16x8 __attribute__((ext_vector_type(8)));
typedef float f32x4 __attribute__((ext_vector_type(4)));
typedef unsigned u32x4 __attribute__((ext_vector_type(4)));
constexpr int BM = 256, BK = 64, HALF = 128, HTB = HALF * BK * 2  , STAGE_BYTES = 8 * HTB, NXCD = 8, WGM = 8;

__host__ __device__ __forceinline__ int lds_byte(int r, int c) { const int st = (r >> 4) * 2 + (c >> 5), rr = r & 15, cc = c & 31, ob = rr * 64 + cc * 2; return st * 1024 + (ob ^ (((ob >> 9) & 1) << 5)); }
__host__ __device__ __forceinline__ void stage_rc(int b, int& R, int& C) { const int st = b / 1024, sb = b % 1024, swz = sb ^ (((sb >> 9) & 1) << 5); R = (st >> 1) * 16 + swz / 64; C = (st & 1) * 32 + (swz % 64) / 2; }
__host__ __device__ __forceinline__ int perm32(int rho) { const int n = rho >> 4, i = rho & 15; return 8 * (i >> 2) + 4 * n + (i & 3); }

struct Unit { int pm, pn; };
struct Gemm { const bf16_t* A; const bf16_t* Bt; int M, N, K; };

struct StaticOrder {
    int nM, nN, nwg, G, c;
    __host__ __device__ void init(int M, int N, int G_, int c_) { nM = M / BM; nN = N / BM; nwg = nM * nN; G = G_; c = c_; }
    __host__ __device__ bool next(int i, Unit& u) const {
        const long L = (long)i * G + c; if (L >= nwg) return false;
        int wgid = (int)L; { const int q = nwg / NXCD, r = nwg % NXCD, xcd = wgid % NXCD, off = wgid / NXCD; wgid = (xcd < r ? xcd * (q + 1) : r * (q + 1) + (xcd - r) * q) + off; }
        const int nig = WGM * nN, gid = wgid / nig, fm = gid * WGM, gsz = (nM - fm) < WGM ? (nM - fm) : WGM;
        u.pm = fm + ((wgid % nig) % gsz); u.pn = (wgid % nig) / gsz; return true;
    }
    __device__ __forceinline__ void a_ready(const Unit&) const {}
    __device__ __forceinline__ void done(const Unit&) const {}
};

__device__ __forceinline__ unsigned cvt_pk_bf16(float lo, float hi) { unsigned r; asm volatile("v_cvt_pk_bf16_f32 %0, %1, %2" : "=v"(r) : "v"(lo), "v"(hi)); return r; }
typedef float f32x2 __attribute__((ext_vector_type(2)));
template <int WG> struct StaticOrderG {
    int nM, nN, nwg, G, c;
    __host__ __device__ void init(int M, int N, int G_, int c_) { nM = M / BM; nN = N / BM; nwg = nM * nN; G = G_; c = c_; }
    __host__ __device__ bool next(int i, Unit& u) const {
        const long L = (long)i * G + c; if (L >= nwg) return false;
        int wgid = (int)L; { const int q = nwg / NXCD, r = nwg % NXCD, xcd = wgid % NXCD, off = wgid / NXCD; wgid = (xcd < r ? xcd * (q + 1) : r * (q + 1) + (xcd - r) * q) + off; }
        const int nig = WG * nN, gid = wgid / nig, fm = gid * WG, gsz = (nM - fm) < WG ? (nM - fm) : WG;
        u.pm = fm + ((wgid % nig) % gsz); u.pn = (wgid % nig) / gsz; return true;
    }
    __device__ __forceinline__ void a_ready(const Unit&) const {}
    __device__ __forceinline__ void done(const Unit&) const {}
};
__device__ __forceinline__ float silu_f(float g) { return g * __builtin_amdgcn_rcpf(1.0f + __builtin_amdgcn_exp2f(-1.4426950408889634f * g)); }
struct EpiSwiGLU {
    static constexpr bool PERM = true, AFTER_DRAIN = false;
    bf16_t* O; int ldc;
    __device__ __forceinline__ void operator()(const f32x4 (&acc)[2][2][4][2], const Unit& u, int wr, int wc, int fr, int fq) const {
        const int r0 = wr * 64 + fr, col0 = u.pn * HALF + wc * 32 + 8 * fq;
        bf16_t* base = O + (size_t)u.pm * BM * ldc + (size_t)(col0 >> 6) * (BM * BK) + (col0 & 63);
#pragma unroll
        for (int ai = 0; ai < 2; ++ai)
#pragma unroll
            for (int m = 0; m < 4; ++m) { bf16_t* rowp = base + (r0 + ai * HALF + m * 16) * BK;
                const f32x4 g0 = acc[ai][0][m][0], g1 = acc[ai][0][m][1], u0 = acc[ai][1][m][0], u1 = acc[ai][1][m][1];
                u32x4 w;
                w.x = cvt_pk_bf16(silu_f(g0[0]) * u0[0], silu_f(g0[1]) * u0[1]); w.y = cvt_pk_bf16(silu_f(g0[2]) * u0[2], silu_f(g0[3]) * u0[3]);
                w.z = cvt_pk_bf16(silu_f(g1[0]) * u1[0], silu_f(g1[1]) * u1[1]); w.w = cvt_pk_bf16(silu_f(g1[2]) * u1[2], silu_f(g1[3]) * u1[3]);
                *(u32x4*)rowp = w; }
    }
};
struct EpiNull {
    static constexpr bool PERM = false, AFTER_DRAIN = false;
    __device__ __forceinline__ void operator()(const f32x4 (&acc)[2][2][4][2], const Unit&, int, int, int, int) const {
#pragma unroll
        for (int ai = 0; ai < 2; ++ai)
#pragma unroll
            for (int bj = 0; bj < 2; ++bj)
#pragma unroll
                for (int m = 0; m < 4; ++m)
#pragma unroll
                    for (int n = 0; n < 2; ++n) { f32x4 v = acc[ai][bj][m][n]; asm volatile("" :: "v"(v)); }
    }
};
template <bool DO_LOAD = true, bool DO_STORE = true> struct EpiResidT {
    static constexpr bool PERM = false, AFTER_DRAIN = false;
    const float* xp; const float* xs;
    float* y; int ldc; const float* gate;
    float coef, alpha;
    static constexpr int STG_OFF = 131072 + 512;
    __device__ __forceinline__ void operator()(const f32x4 (&acc)[2][2][4][2], const Unit& u, int wr, int wc, int fr, int fq) const {
        const int lane = fq * 16 + fr, wid = wr * 4 + wc;
        extern __shared__ __attribute__((aligned(16))) unsigned char pg8_dyn_lds[];
        PG8_LAS float* sw = (PG8_LAS float*)((PG8_LAS unsigned char*)pg8_dyn_lds + STG_OFF) + wid * 576;
        PG8_LAS float* swr = sw + fr * 36 + fq * 4;
        const int rr = lane >> 3, c4 = (lane & 7) * 4;
        const PG8_LAS float* srd = sw + rr * 36 + c4;
        const int trow = u.pm * BM; const bool samp = trow >= 32768;
        const int bidx = samp ? 8 + ((trow - 32768) >> 14) : (trow >> 12);
        const float* xb = samp ? xs + (size_t)(trow - 32768) * ldc : xp + (size_t)trow * ldc;
        float* yb = y + (size_t)trow * ldc;
        const int colw = u.pn * BM + wc * 32 + c4;
        const float* gp = gate + (size_t)bidx * 18432 + colw;
        f32x4 gv[2];
#pragma unroll
        for (int bj = 0; bj < 2; ++bj) gv[bj] = (*(const f32x4*)(gp + bj * HALF) + 1.0f) * coef;
        const int loff = rr * ldc + c4 + u.pn * BM + wc * 32;
#pragma unroll
        for (int am = 0; am < 4; ++am) { const int ai = am >> 1, m0 = (am & 1) * 2;
            f32x4 xv[2][2][2];
#pragma unroll
            for (int mm = 0; mm < 2; ++mm)
#pragma unroll
                for (int k = 0; k < 2; ++k) { const float* xrow = xb + (size_t)(ai * HALF + wr * 64 + (m0 + mm) * 16 + 8 * k) * ldc;
#pragma unroll
                    for (int bj = 0; bj < 2; ++bj) xv[mm][bj][k] = DO_LOAD ? __builtin_nontemporal_load((const f32x4*)(xrow + loff + bj * HALF)) : (f32x4){1.f, 1.f, 1.f, 1.f}; }
#pragma unroll
            for (int mm = 0; mm < 2; ++mm)
#pragma unroll
                for (int bj = 0; bj < 2; ++bj) { const int m = m0 + mm;
                    *(PG8_LAS f32x4*)(swr) = acc[ai][bj][m][0]; *(PG8_LAS f32x4*)(swr + 16) = acc[ai][bj][m][1];
                    const f32x4 v0 = *(const PG8_LAS f32x4*)(srd), v1 = *(const PG8_LAS f32x4*)(srd + 288);
                    float* yrow = yb + (size_t)(ai * HALF + wr * 64 + m * 16) * ldc;
                    const f32x4 o0 = xv[mm][bj][0] * alpha + gv[bj] * v0, o1 = xv[mm][bj][1] * alpha + gv[bj] * v1;
                    if (DO_STORE) { __builtin_nontemporal_store(o0, (f32x4*)(yrow + loff + bj * HALF)); __builtin_nontemporal_store(o1, (f32x4*)(yrow + (size_t)8 * ldc + loff + bj * HALF)); }
                    else { asm volatile("" :: "v"(o0), "v"(o1)); } }
            asm volatile("" ::: "memory");
        }
    }
};
typedef EpiResidT<true, true> EpiResid;
struct EpiRope {
    static constexpr bool PERM = true, AFTER_DRAIN = false;
    bf16_t* O; int ldc; const float* ropeC; const float* ropeS;
    float qscale;
    __device__ __forceinline__ void operator()(const f32x4 (&acc)[2][2][4][2], const Unit& u, int wr, int wc, int fr, int fq) const {
        const int row0 = u.pm * BM + wr * 64 + fr, col0 = u.pn * BM + wc * 32 + 8 * fq;
        const bool rot = u.pn < 8; const int i0 = (wc & 1) * 16 + 4 * fq;
        const float qs = u.pn < 4 ? qscale : 1.0f;
        f32x4 cs[2][4], sn[2][4];
#pragma unroll
        for (int ai = 0; ai < 2; ++ai)
#pragma unroll
            for (int m = 0; m < 4; ++m) { const int row = row0 + ai * HALF + m * 16; const int t = row < 32768 ? (row & 4095) : (row & 16383);
                cs[ai][m] = (f32x4){1.f, 1.f, 1.f, 1.f}; sn[ai][m] = (f32x4){0.f, 0.f, 0.f, 0.f};
                if (rot) { cs[ai][m] = *(const f32x4*)(ropeC + (size_t)t * 32 + i0); sn[ai][m] = *(const f32x4*)(ropeS + (size_t)t * 32 + i0); } }
#pragma unroll
        for (int ai = 0; ai < 2; ++ai)
#pragma unroll
            for (int m = 0; m < 4; ++m) { const int row = row0 + ai * HALF + m * 16;
                const f32x4 c4 = cs[ai][m], s4 = sn[ai][m];
                bf16_t* rowp = O + (size_t)row * ldc + col0;
#pragma unroll
                for (int bj = 0; bj < 2; ++bj) { const f32x4 v0 = acc[ai][bj][m][0], v1 = acc[ai][bj][m][1];
                    const float a0 = v0[0] * c4[0] - v0[1] * s4[0], b0 = v0[1] * c4[0] + v0[0] * s4[0];
                    const float a1 = v0[2] * c4[1] - v0[3] * s4[1], b1 = v0[3] * c4[1] + v0[2] * s4[1];
                    const float a2 = v1[0] * c4[2] - v1[1] * s4[2], b2 = v1[1] * c4[2] + v1[0] * s4[2];
                    const float a3 = v1[2] * c4[3] - v1[3] * s4[3], b3 = v1[3] * c4[3] + v1[2] * s4[3];
                    u32x4 w; w.x = cvt_pk_bf16(a0 * qs, b0 * qs); w.y = cvt_pk_bf16(a1 * qs, b1 * qs); w.z = cvt_pk_bf16(a2 * qs, b2 * qs); w.w = cvt_pk_bf16(a3 * qs, b3 * qs);
                    *(u32x4*)(rowp + bj * HALF) = w; } }
    }
};

template <class Epi, class Sched, bool ALIGN_EPI = false, bool SP2 = false, bool ABLK = false, bool BBLK = false>
__device__ __forceinline__ void gemm_phase(PG8_LAS unsigned char* lds, const Gemm g, const Sched& S, const Epi& E) {
    int tid_ = threadIdx.x; asm volatile("" : "+v"(tid_));
    const int tid = tid_, wid = __builtin_amdgcn_readfirstlane(tid >> 6), lane = tid & 63, wr = wid >> 2, wc = wid & 3, fr = lane & 15, fq = lane >> 4;
    const int K = g.K, nt = K / BK;
    unsigned voffA[2], voffB[2];
#pragma unroll
    for (int i = 0; i < 2; ++i) { int R, C; stage_rc(tid * 16 + i * 8192, R, C); const int Rb = Epi::PERM ? ((R & ~31) + perm32(R & 31)) : R;
        voffA[i] = ABLK ? (unsigned)(R * BK + C) * 2u : (unsigned)(R * K + C) * 2u; voffB[i] = BBLK ? (unsigned)(Rb * BK + C) * 2u : (unsigned)(Rb * K + C) * 2u; }
    const size_t kstep = (size_t)(BK * 2);
    const size_t hstep = (size_t)HALF * K * 2;
    const size_t tstep = 2 * hstep;
    const size_t kstepB = BBLK ? (size_t)(BM * BK * 2) : kstep, hstepB = BBLK ? (size_t)(HALF * BK * 2) : hstep;
    const size_t kstepA = ABLK ? (size_t)(BM * BK * 2) : kstep, hstepA = ABLK ? (size_t)(HALF * BK * 2) : hstep;
    const unsigned ldsw = (unsigned)wid * 1024u;
    const int aoff = lds_byte(wr * 64 + fr, fq * 8), boff = lds_byte(wc * 32 + fr, fq * 8);
#define PG8_SA(b, h) (((b) * 2 + (h)) * HTB)
#define PG8_SB(b, h) ((4 + (b) * 2 + (h)) * HTB)
#define PG8_STAGE(bufoff, gbase, voff) do { _Pragma("unroll") for (int _i = 0; _i < 2; ++_i) \
        __builtin_amdgcn_global_load_lds((const unsigned*)((const char*)(gbase) + (voff)[_i]), (PG8_LAS unsigned*)(lds + (bufoff) + ldsw + _i * 8192), 16, 0, 0); } while (0)
#define PG8_LDA(dst, b, h) do { _Pragma("unroll") for (int m = 0; m < 4; ++m) _Pragma("unroll") for (int k = 0; k < 2; ++k) dst[m][k] = *(const PG8_LAS bf16x8*)(lds + PG8_SA(b, h) + aoff + m * 2048 + k * 1024); } while (0)
#define PG8_LDB(dst, b, h) do { _Pragma("unroll") for (int n = 0; n < 2; ++n) _Pragma("unroll") for (int k = 0; k < 2; ++k) dst[n][k] = *(const PG8_LAS bf16x8*)(lds + PG8_SB(b, h) + boff + n * 2048 + k * 1024); } while (0)
#define PG8_MMA(ai, bj, At, Bt) do { __builtin_amdgcn_s_setprio(1); _Pragma("unroll") for (int m = 0; m < 4; ++m) _Pragma("unroll") for (int n = 0; n < 2; ++n) _Pragma("unroll") for (int k = 0; k < 2; ++k) \
        acc[ai][bj][m][n] = __builtin_amdgcn_mfma_f32_16x16x32_bf16(Bt[n][k], At[m][k], acc[ai][bj][m][n], 0, 0, 0); __builtin_amdgcn_s_setprio(0); } while (0)
#define PG8_WAIT_V(n) asm volatile("s_waitcnt vmcnt(" #n ")" ::: "memory")
#define PG8_WAIT_L(n) asm volatile("s_waitcnt lgkmcnt(" #n ")" ::: "memory")
#define PG8_BAR __builtin_amdgcn_s_barrier()
#define PG8_SCHED __builtin_amdgcn_sched_barrier(0)
    Unit cur, nxt; int ui = 0;
    if (!S.next(0, cur)) return;
    f32x4 acc[2][2][4][2];
#pragma unroll
    for (int a = 0; a < 2; ++a)
#pragma unroll
        for (int b = 0; b < 2; ++b)
#pragma unroll
            for (int m = 0; m < 4; ++m)
#pragma unroll
                for (int n = 0; n < 2; ++n) acc[a][b][m][n] = (f32x4){0.f, 0.f, 0.f, 0.f};
    bf16x8 At[4][2], B0[2][2], B1[2][2];
    const char* cA = (const char*)g.A + (size_t)cur.pm * tstep; const char* cB = (const char*)g.Bt + (size_t)cur.pn * tstep;
    S.a_ready(cur);
    if constexpr (SP2) {
        PG8_STAGE(PG8_SB(0, 0), cB, voffB); PG8_STAGE(PG8_SB(0, 1), cB + hstepB, voffB); PG8_STAGE(PG8_SA(0, 0), cA, voffA); PG8_STAGE(PG8_SA(0, 1), cA + hstepA, voffA);
        if (wr == 1) PG8_BAR;
        PG8_WAIT_V(2); PG8_BAR;
        PG8_STAGE(PG8_SB(1, 0), cB + kstepB, voffB); PG8_STAGE(PG8_SA(1, 0), cA + kstepA, voffA); PG8_STAGE(PG8_SB(1, 1), cB + hstepB + kstepB, voffB);
        PG8_WAIT_V(6); PG8_BAR;
    } else {
        PG8_STAGE(PG8_SB(0, 0), cB, voffB); PG8_STAGE(PG8_SA(0, 0), cA, voffA); PG8_STAGE(PG8_SB(0, 1), cB + hstepB, voffB); PG8_STAGE(PG8_SA(0, 1), cA + hstepA, voffA);
        if (wr == 1) PG8_BAR;
        PG8_WAIT_V(4); PG8_BAR;
        PG8_STAGE(PG8_SB(1, 0), cB + kstepB, voffB); PG8_STAGE(PG8_SA(1, 0), cA + kstepA, voffA); PG8_STAGE(PG8_SB(1, 1), cB + hstepB + kstepB, voffB);
        PG8_WAIT_V(6); PG8_BAR;
    }
    for (;;) {
        const bool has_next = S.next(ui + 1, nxt);
        const char* nA = has_next ? (const char*)g.A + (size_t)nxt.pm * tstep : cA; const char* nB = has_next ? (const char*)g.Bt + (size_t)nxt.pn * tstep : cB;
        for (int t = 0; t < nt; t += 2) {
            const bool last = (t == nt - 2);
            const char* a1 = cA + (size_t)(t + 1) * kstepA;
            const char* a2 = last ? nA : cA + (size_t)(t + 2) * kstepA; const char* b2 = last ? nB : cB + (size_t)(t + 2) * kstepB;
            const char* a3 = a2 + kstepA; const char* b3 = b2 + kstepB;
            if (last && has_next) S.a_ready(nxt);
            if constexpr (SP2) {
            PG8_LDB(B0, 0, 0); PG8_LDB(B1, 0, 1); PG8_SCHED; PG8_LDA(At, 0, 0); PG8_STAGE(PG8_SA(1, 1), a1 + hstepA, voffA);
            PG8_WAIT_V(8); PG8_WAIT_L(0); PG8_BAR; PG8_MMA(0, 0, At, B0); PG8_MMA(0, 1, At, B1); PG8_BAR; PG8_SCHED;
            PG8_LDA(At, 0, 1); PG8_STAGE(PG8_SB(0, 0), b2, voffB); PG8_STAGE(PG8_SB(0, 1), b2 + hstepB, voffB); PG8_STAGE(PG8_SA(0, 0), a2, voffA);
            PG8_WAIT_V(8); PG8_WAIT_L(0); PG8_BAR; PG8_MMA(1, 0, At, B0); PG8_MMA(1, 1, At, B1); PG8_BAR; PG8_SCHED;
            PG8_LDB(B0, 1, 0); PG8_LDB(B1, 1, 1); PG8_SCHED; PG8_LDA(At, 1, 0); PG8_STAGE(PG8_SA(0, 1), a2 + hstepA, voffA);
            PG8_WAIT_V(8); PG8_WAIT_L(0); PG8_BAR; PG8_MMA(0, 0, At, B0); PG8_MMA(0, 1, At, B1); PG8_BAR; PG8_SCHED;
            PG8_LDA(At, 1, 1); PG8_STAGE(PG8_SB(1, 0), b3, voffB); PG8_STAGE(PG8_SB(1, 1), b3 + hstepB, voffB); PG8_STAGE(PG8_SA(1, 0), a3, voffA);
            PG8_WAIT_V(8); PG8_WAIT_L(0); PG8_BAR; PG8_MMA(1, 0, At, B0); PG8_MMA(1, 1, At, B1); PG8_BAR; PG8_SCHED;
            } else {
            PG8_LDB(B0, 0, 0); PG8_SCHED; PG8_LDA(At, 0, 0); PG8_STAGE(PG8_SA(1, 1), a1 + hstepA, voffA);
            PG8_WAIT_L(8); PG8_BAR; PG8_WAIT_L(0); PG8_MMA(0, 0, At, B0); PG8_BAR; PG8_SCHED;
            PG8_LDB(B1, 0, 1); PG8_STAGE(PG8_SB(0, 0), b2, voffB);
            PG8_BAR; PG8_WAIT_L(0); PG8_MMA(0, 1, At, B1); PG8_BAR;
            PG8_LDA(At, 0, 1); PG8_STAGE(PG8_SA(0, 0), a2, voffA);
            PG8_BAR; PG8_WAIT_L(0); PG8_MMA(1, 0, At, B0); PG8_BAR; PG8_SCHED;
            PG8_STAGE(PG8_SB(0, 1), b2 + hstepB, voffB);
            PG8_WAIT_V(6); PG8_BAR; PG8_MMA(1, 1, At, B1); PG8_BAR;
            PG8_LDB(B0, 1, 0); PG8_SCHED; PG8_LDA(At, 1, 0); PG8_STAGE(PG8_SA(0, 1), a2 + hstepA, voffA);
            PG8_WAIT_L(8); PG8_BAR; PG8_WAIT_L(0); PG8_MMA(0, 0, At, B0); PG8_BAR; PG8_SCHED;
            PG8_LDB(B1, 1, 1); PG8_STAGE(PG8_SB(1, 0), b3, voffB);
            PG8_BAR; PG8_WAIT_L(0); PG8_MMA(0, 1, At, B1); PG8_BAR;
            PG8_LDA(At, 1, 1); PG8_STAGE(PG8_SA(1, 0), a3, voffA);
            PG8_BAR; PG8_WAIT_L(0); PG8_MMA(1, 0, At, B0); PG8_BAR; PG8_SCHED;
            PG8_STAGE(PG8_SB(1, 1), b3 + hstepB, voffB);
            PG8_WAIT_V(6); PG8_BAR; PG8_MMA(1, 1, At, B1); PG8_BAR;
            }
        }
        if constexpr (ALIGN_EPI) { if (wr == 0) PG8_BAR; }
        if constexpr (!Epi::AFTER_DRAIN) { E(acc, cur, wr, wc, fr, fq); S.done(cur); }
        if (!has_next) break;
#pragma unroll
        for (int a = 0; a < 2; ++a)
#pragma unroll
            for (int b = 0; b < 2; ++b)
#pragma unroll
                for (int m = 0; m < 4; ++m)
#pragma unroll
                    for (int n = 0; n < 2; ++n) acc[a][b][m][n] = (f32x4){0.f, 0.f, 0.f, 0.f};
        cur = nxt; cA = nA; cB = nB; ++ui;
        if constexpr (ALIGN_EPI) { if (wr == 1) PG8_BAR; }
    }
    PG8_WAIT_V(0);
    if constexpr (!ALIGN_EPI) { if (wr == 0) PG8_BAR; }
    PG8_BAR;
    if constexpr (Epi::AFTER_DRAIN) { E.fused(acc, cur, wr, wc, fr, fq, lds, wid, lane); S.done(cur); }
#undef PG8_SA
#undef PG8_SB
#undef PG8_STAGE
#undef PG8_LDA
#undef PG8_LDB
#undef PG8_MMA
#undef PG8_WAIT_V
#undef PG8_WAIT_L
#undef PG8_BAR
#undef PG8_SCHED
}
}
namespace att {
#define AGAS __attribute__((address_space(1)))
typedef unsigned short bf16;
using bf16x8 = __attribute__((ext_vector_type(8))) short;
using s16x4  = __attribute__((ext_vector_type(4))) short;
using f32x16 = __attribute__((ext_vector_type(16))) float;
using u32x4  = __attribute__((ext_vector_type(4))) unsigned;
constexpr int LDP = 6144, LDO = 2048;
constexpr int SHM_V = 64 * 128 * 2, SHM_K = 64 * 128 * 2;
constexpr int OFF_V = 0, OFF_K = 2 * SHM_V, OFF_WS = 2 * SHM_V + 2 * SHM_K, OFF_BT = OFF_WS + 8 * 64 * 4, ATT_LDS = OFF_BT + 2048;
constexpr float LOG2E = 1.4426950408889634f;
#define KSWZ128(row, colB) ((row) * 256 + ((colB) ^ (((row) & 7) << 4)))
#define KSWZ64(row, colB)  ((row) * 128 + ((colB) ^ ((((row) >> 1) & 7) << 4)))
#define SBAR() __builtin_amdgcn_sched_barrier(0)
__device__ __forceinline__ int crow(int r, int hi) { return (r & 3) + 8 * (r >> 2) + 4 * hi; }
__device__ __forceinline__ unsigned cvtpk(float lo, float hi) { unsigned r; asm volatile("v_cvt_pk_bf16_f32 %0, %1, %2" : "=v"(r) : "v"(lo), "v"(hi)); return r; }
__device__ __forceinline__ bf16x8 ld8(const AGAS bf16* p) { return *(const AGAS bf16x8*)(p); }
__device__ __forceinline__ unsigned short f2bf1(float f) { return (unsigned short)(cvtpk(f, 0.f) & 0xffffu); }

__device__ __forceinline__ int v_st(int k, int c) { const int kk = (k & ~0xC) | ((k & 4) << 1) | ((k & 8) >> 1); return ((kk >> 3) * 4 + (c >> 5)) * 512 + ((kk & 7) * 32 + (c & 31)) * 2; }
__device__ __forceinline__ int v_rd_base(int lane) { return ((lane & 3) << 3) | (((lane >> 2) & 3) << 6) | (((lane >> 4) & 1) << 5) | (((lane >> 5) & 1) << 8); }
constexpr int v_rd_off(int d0, int ks, int half) { return d0 * 512 + ks * 4096 + half * 2048; }
template <int OFF> __device__ __forceinline__ s16x4 tr_read(int vb) {
  s16x4 r; asm volatile("ds_read_b64_tr_b16 %0, %1 offset:%2" : "=&v"(r) : "v"(vb), "i"(OFF) : "memory"); return r;
}
template <int D0> __device__ __forceinline__ void pv_one(f32x16& od, int vb, bf16x8 pa0, bf16x8 pa1, bf16x8 pa2, bf16x8 pa3) {
  const s16x4 l0 = tr_read<v_rd_off(D0, 0, 0)>(vb), h0 = tr_read<v_rd_off(D0, 0, 1)>(vb), l1 = tr_read<v_rd_off(D0, 1, 0)>(vb), h1 = tr_read<v_rd_off(D0, 1, 1)>(vb);
  const s16x4 l2 = tr_read<v_rd_off(D0, 2, 0)>(vb), h2 = tr_read<v_rd_off(D0, 2, 1)>(vb), l3 = tr_read<v_rd_off(D0, 3, 0)>(vb), h3 = tr_read<v_rd_off(D0, 3, 1)>(vb);
  asm volatile("s_waitcnt lgkmcnt(0)" ::: "memory"); SBAR();
#define PK(L, H) (bf16x8){L[0], L[1], L[2], L[3], H[0], H[1], H[2], H[3]}
  od = __builtin_amdgcn_mfma_f32_32x32x16_bf16(pa0, PK(l0, h0), od, 0, 0, 0);
  od = __builtin_amdgcn_mfma_f32_32x32x16_bf16(pa1, PK(l1, h1), od, 0, 0, 0);
  od = __builtin_amdgcn_mfma_f32_32x32x16_bf16(pa2, PK(l2, h2), od, 0, 0, 0);
  od = __builtin_amdgcn_mfma_f32_32x32x16_bf16(pa3, PK(l3, h3), od, 0, 0, 0);
#undef PK
}
__device__ __forceinline__ void pv_d0(f32x16* o, int vb, bf16x8 pa0, bf16x8 pa1, bf16x8 pa2, bf16x8 pa3) {
  pv_one<0>(o[0], vb, pa0, pa1, pa2, pa3); pv_one<1>(o[1], vb, pa0, pa1, pa2, pa3); pv_one<2>(o[2], vb, pa0, pa1, pa2, pa3); pv_one<3>(o[3], vb, pa0, pa1, pa2, pa3);
}
#define ATT_PK4(P, BASE, OUT) do { unsigned a0_ = cvtpk(P[BASE + 0], P[BASE + 1]), a1_ = cvtpk(P[BASE + 2], P[BASE + 3]);   \
    unsigned b0_ = cvtpk(P[BASE + 4], P[BASE + 5]), b1_ = cvtpk(P[BASE + 6], P[BASE + 7]);                              \
    auto r0_ = __builtin_amdgcn_permlane32_swap(a0_, b0_, false, false); auto r1_ = __builtin_amdgcn_permlane32_swap(a1_, b1_, false, false); \
    u32x4 w_ = {r0_[0], r1_[0], r0_[1], r1_[1]}; OUT = *reinterpret_cast<bf16x8*>(&w_); } while (0)

constexpr float DSCALE = 0.125f, DTHR = 8.f;
__device__ __forceinline__ void d_partialSM(f32x16& p0, f32x16& p1, float& m_reg, float& mn, float& alpha) {
  constexpr float C = DSCALE * LOG2E;
  float pmax = p0[0];
#pragma unroll
  for (int r = 1; r < 16; ++r) pmax = fmaxf(pmax, p0[r]);
#pragma unroll
  for (int r = 0; r < 16; ++r) pmax = fmaxf(pmax, p1[r]);
  { auto rr = __builtin_amdgcn_permlane32_swap(__float_as_uint(pmax), __float_as_uint(pmax), false, false);
    pmax = fmaxf(__uint_as_float(rr[0]), __uint_as_float(rr[1])); }
  if (__builtin_expect(__all(pmax - m_reg <= DTHR / DSCALE), 1)) { mn = m_reg; alpha = 1.f; }
  else { mn = fmaxf(m_reg, pmax); alpha = __builtin_amdgcn_exp2f((m_reg - mn) * C); m_reg = mn; }
  const float mnC = -mn * C;
#pragma unroll
  for (int r = 0; r < 16; ++r) p0[r] = fmaf(p0[r], C, mnC);
#pragma unroll
  for (int r = 0; r < 16; ++r) p1[r] = fmaf(p1[r], C, mnC);
#pragma unroll
  for (int r = 0; r < 16; ++r) p0[r] = __builtin_amdgcn_exp2f(p0[r]);
}
__device__ __forceinline__ void d_finishSM(f32x16& p0, f32x16& p1, float alpha, float& l_reg, bf16x8& pa0, bf16x8& pa1, bf16x8& pa2, bf16x8& pa3) {
#pragma unroll
  for (int r = 0; r < 16; ++r) p1[r] = __builtin_amdgcn_exp2f(p1[r]);
  float ps = 0;
#pragma unroll
  for (int r = 0; r < 16; ++r) ps += p0[r];
#pragma unroll
  for (int r = 0; r < 16; ++r) ps += p1[r];
  { auto rr = __builtin_amdgcn_permlane32_swap(__float_as_uint(ps), __float_as_uint(ps), false, false);
    ps = __uint_as_float(rr[0]) + __uint_as_float(rr[1]); }
  l_reg = l_reg * alpha + ps;
  ATT_PK4(p0, 0, pa0); ATT_PK4(p0, 8, pa1); ATT_PK4(p1, 0, pa2); ATT_PK4(p1, 8, pa3);
}
__device__ __forceinline__ void d_qkt(f32x16& p0, f32x16& p1, const char* Ks, const bf16x8* qr, int r32, int hi) {
  p0 = f32x16{}; p1 = f32x16{};
#pragma unroll
  for (int d0 = 0; d0 < 4; ++d0) { const int cb = (d0 * 16 + hi * 8) * 2;
    const bf16x8 b0 = *reinterpret_cast<const bf16x8*>(Ks + KSWZ64(r32, cb));
    const bf16x8 b1 = *reinterpret_cast<const bf16x8*>(Ks + KSWZ64(32 + r32, cb));
    p0 = __builtin_amdgcn_mfma_f32_32x32x16_bf16(b0, qr[d0], p0, 0, 0, 0);
    p1 = __builtin_amdgcn_mfma_f32_32x32x16_bf16(b1, qr[d0], p1, 0, 0, 0); }
}
__device__ __forceinline__ void diff_unit(const AGAS bf16* __restrict__ proj, long row0, int T, int h, int q0, float lam, float gscale,
                                          const AGAS float* __restrict__ ng, AGAS bf16* __restrict__ out, AGAS float* __restrict__ stash, char* lds) {
  int tid_ = threadIdx.x; asm volatile("" : "+v"(tid_));
  const int tid = tid_, wid = __builtin_amdgcn_readfirstlane(tid >> 6), lane = tid & 63, r32 = lane & 31, hi = lane >> 5;
  char* V_lds = lds + OFF_V; char* K_lds = lds + OFF_K;
  float* ws = (float*)(lds + OFF_WS) + wid * 64; float* li_l = ws; float* al_l = ws + 32;
  const int ksr = tid >> 3, ksc = (tid & 7) * 8;
  const int sr = tid >> 4, sc = (tid & 15) * 8, vst0 = v_st(sr, sc), vst1 = v_st(32 + sr, sc);
  const int kst = KSWZ64(ksr, ksc * 2);
  const int vb0 = (int)(uintptr_t)V_lds + v_rd_base(lane);
  const int NT = T / 64;
  typedef float f32x4v __attribute__((ext_vector_type(4)));
#pragma unroll 1
  for (int c = 0; c < 2; ++c) {
    const AGAS bf16* pj = proj; asm volatile("" : "+s"(pj));
    const AGAS bf16* Qw = pj + (row0 + q0 + wid * 32 + r32) * LDP + h * 128 + c * 64 + hi * 8;
    const AGAS bf16* Kh = pj + row0 * LDP + 1024 + h * 128 + c * 64;
    const AGAS bf16* Vh = pj + row0 * LDP + 2048 + h * 128;
    float m_reg = -1e30f, l_reg = 0.f; f32x16 o[4] = {}; bf16x8 qr[4];
#pragma unroll
    for (int d0 = 0; d0 < 4; ++d0) qr[d0] = ld8(Qw + d0 * 16);
    struct { bf16x8 vs0, vs1, ks0; } sr_[2];
#define SLOAD(i, k0) do { sr_[i].vs0 = ld8(&Vh[(long)((k0) + sr) * LDP + sc]); sr_[i].vs1 = ld8(&Vh[(long)((k0) + 32 + sr) * LDP + sc]); \
      sr_[i].ks0 = ld8(&Kh[(long)((k0) + ksr) * LDP + ksc]); } while (0)
#define SWRITE(b, i) do { *(bf16x8*)(V_lds + (b) * SHM_V + vst0) = sr_[i].vs0; *(bf16x8*)(V_lds + (b) * SHM_V + vst1) = sr_[i].vs1; \
      *(bf16x8*)(K_lds + (b) * SHM_K + kst) = sr_[i].ks0; } while (0)
#define SWAIT() asm volatile("s_waitcnt vmcnt(3)" ::: "memory")
#define RESC(a) do { if (__any((a) < 1.f)) { if (hi == 0) al_l[r32] = (a); asm volatile("s_waitcnt lgkmcnt(0)" ::: "memory"); \
      _Pragma("unroll") for (int d = 0; d < 4; ++d) _Pragma("unroll") for (int r = 0; r < 16; ++r) o[d][r] *= al_l[crow(r, hi)]; } } while (0)
    f32x16 pA0, pA1, pB0, pB1; float mnA, mnB, alA, alB; bf16x8 pa0, pa1, pa2, pa3;
    __syncthreads();
    SLOAD(0, 0); asm volatile("s_waitcnt vmcnt(0)" ::: "memory"); SWRITE(0, 0); __syncthreads();
    d_qkt(pA0, pA1, K_lds, qr, r32, hi); d_partialSM(pA0, pA1, m_reg, mnA, alA);
    SLOAD(1, 64); if (2 < NT) SLOAD(0, 128);
    SWAIT(); SWRITE(1, 1); __syncthreads();
    for (int j = 1; j + 1 < NT; j += 2) {
      SBAR(); d_qkt(pB0, pB1, K_lds + SHM_K, qr, r32, hi);
      d_finishSM(pA0, pA1, alA, l_reg, pa0, pa1, pa2, pa3); SBAR();
      SLOAD(1, (j + 2) * 64); SBAR();
      pv_d0(o, vb0, pa0, pa1, pa2, pa3); d_partialSM(pB0, pB1, m_reg, mnB, alB);
      __syncthreads(); SWAIT(); SWRITE(0, 0);
      RESC(alB); __syncthreads();
      SBAR(); d_qkt(pA0, pA1, K_lds, qr, r32, hi);
      d_finishSM(pB0, pB1, alB, l_reg, pa0, pa1, pa2, pa3); SBAR();
      if (j + 3 < NT) SLOAD(0, (j + 3) * 64); SBAR();
      pv_d0(o, vb0 + SHM_V, pa0, pa1, pa2, pa3); d_partialSM(pA0, pA1, m_reg, mnA, alA);
      __syncthreads(); SWAIT(); SWRITE(1, 1);
      RESC(alA); __syncthreads();
    }
    SBAR(); d_qkt(pB0, pB1, K_lds + SHM_K, qr, r32, hi);
    d_finishSM(pA0, pA1, alA, l_reg, pa0, pa1, pa2, pa3); SBAR();
    pv_d0(o, vb0, pa0, pa1, pa2, pa3); d_partialSM(pB0, pB1, m_reg, mnB, alB);
    __syncthreads(); RESC(alB);
    d_finishSM(pB0, pB1, alB, l_reg, pa0, pa1, pa2, pa3); SBAR();
    pv_d0(o, vb0 + SHM_V, pa0, pa1, pa2, pa3);
#undef SLOAD
#undef SWRITE
#undef SWAIT
#undef RESC
    if (hi == 0) li_l[r32] = l_reg; asm volatile("s_waitcnt lgkmcnt(0)" ::: "memory");
    float rli[16];
#pragma unroll
    for (int r = 0; r < 16; ++r) rli[r] = __builtin_amdgcn_rcpf(li_l[crow(r, hi)]);
    AGAS float* stash_l = stash; asm volatile("" : "+s"(stash_l));
    AGAS f32x4v* st4 = (AGAS f32x4v*)(stash_l + ((size_t)wid * 64 + lane) * 64);
    if (c == 0) {
#pragma unroll
      for (int d0 = 0; d0 < 4; ++d0)
#pragma unroll
        for (int r4 = 0; r4 < 4; ++r4) st4[d0 * 4 + r4] = (f32x4v){o[d0][4 * r4] * rli[4 * r4], o[d0][4 * r4 + 1] * rli[4 * r4 + 1], o[d0][4 * r4 + 2] * rli[4 * r4 + 2], o[d0][4 * r4 + 3] * rli[4 * r4 + 3]};
    } else {
      AGAS bf16* out_l = out; asm volatile("" : "+s"(out_l));
      AGAS bf16* Ow = out_l + (row0 + q0 + wid * 32) * LDO + h * 128 + r32;
      float gv[4];
#pragma unroll
      for (int d0 = 0; d0 < 4; ++d0) gv[d0] = ng[d0 * 32 + r32] * gscale;
#pragma unroll
      for (int r4 = 0; r4 < 4; ++r4) {
        f32x4v s4[4];
#pragma unroll
        for (int d0 = 0; d0 < 4; ++d0) s4[d0] = st4[d0 * 4 + r4];
#pragma unroll
        for (int e = 0; e < 4; ++e) { const int r = 4 * r4 + e;
          float v[4]; float ss = 0.f;
#pragma unroll
          for (int d0 = 0; d0 < 4; ++d0) { v[d0] = s4[d0][e] - lam * (o[d0][r] * rli[r]); ss += v[d0] * v[d0]; }
          ss += __shfl_xor(ss, 1); ss += __shfl_xor(ss, 2); ss += __shfl_xor(ss, 4); ss += __shfl_xor(ss, 8); ss += __shfl_xor(ss, 16);
          const float rstd = 1.0f / sqrtf(ss * (1.0f / 128.0f) + 1e-5f);
          AGAS bf16* ob = Ow; asm volatile("" : "+v"(ob)); AGAS bf16* op = ob + (long)crow(r, hi) * LDO;
#pragma unroll
          for (int d0 = 0; d0 < 4; ++d0) op[d0 * 32] = f2bf1(v[d0] * rstd * gv[d0]);
        }
      }
    }
  }
}

__device__ __forceinline__ void na_qkt(f32x16& p0, f32x16& p1, const char* Ks, const bf16x8* qr, int r32, int hi) {
  p0 = f32x16{}; p1 = f32x16{};
#pragma unroll
  for (int d0 = 0; d0 < 8; ++d0) { const int cb = (d0 * 16 + hi * 8) * 2;
    const bf16x8 b0 = *reinterpret_cast<const bf16x8*>(Ks + KSWZ128(r32, cb));
    const bf16x8 b1 = *reinterpret_cast<const bf16x8*>(Ks + KSWZ128(32 + r32, cb));
    p0 = __builtin_amdgcn_mfma_f32_32x32x16_bf16(b0, qr[d0], p0, 0, 0, 0);
    p1 = __builtin_amdgcn_mfma_f32_32x32x16_bf16(b1, qr[d0], p1, 0, 0, 0); }
}
__device__ __forceinline__ void na_unit(const AGAS bf16* __restrict__ proj, long row0, int rows, int h, int r0, const AGAS float* __restrict__ rpb_h,
                                        AGAS bf16* __restrict__ out, char* lds) {
  int tid_ = threadIdx.x; asm volatile("" : "+v"(tid_));
  const int tid = tid_, wid = __builtin_amdgcn_readfirstlane(tid >> 6), lane = tid & 63, r32 = lane & 31, hi = lane >> 5;
  char* V_lds = lds + OFF_V; char* K_lds = lds + OFF_K;
  float* ws = (float*)(lds + OFF_WS) + wid * 64; float* li_l = ws; float* al_l = ws + 32;
  float* bt = (float*)(lds + OFF_BT);
  constexpr float C = 0.08838834764831845f * LOG2E;
  __syncthreads();
  for (int i = tid; i < 15 * 31; i += 512) bt[i] = rpb_h[i] * LOG2E;
  const int r = r0 + (wid >> 1), cq = (wid & 1) * 32 + r32;
  const int cs = min(max(cq - 8, 0), 48);
  const int rs_w = min(max(r - 4, 0), rows - 8);
  const int kr_lo = min(max(r0 - 4, 0), rows - 8), kr_hi = min(max(r0 - 1, 0), rows - 8) + 8;
  const AGAS bf16* Qw = proj + (row0 + (long)r * 64 + cq) * LDP + 3072 + h * 128 + hi * 8;
  bf16x8 qr[8];
#pragma unroll
  for (int d0 = 0; d0 < 8; ++d0) qr[d0] = ld8(Qw + d0 * 16);
  const int sr = tid >> 4, sc = (tid & 15) * 8, vst0 = v_st(sr, sc), vst1 = v_st(32 + sr, sc);
  const int kst0 = KSWZ128(sr, sc * 2), kst1 = KSWZ128(32 + sr, sc * 2);
  const int vb0 = (int)(uintptr_t)V_lds + v_rd_base(lane);
  const AGAS bf16* Kh = proj + row0 * LDP + 4096 + h * 128; const AGAS bf16* Vh = proj + row0 * LDP + 5120 + h * 128;
  float m_reg = -1e30f, l_reg = 0.f; f32x16 o[4] = {};
  for (int kr = kr_lo; kr < kr_hi; ++kr) {
    const long kb = (long)kr * 64;
    const bf16x8 vs0 = ld8(&Vh[(kb + sr) * LDP + sc]), vs1 = ld8(&Vh[(kb + 32 + sr) * LDP + sc]);
    const bf16x8 ks0 = ld8(&Kh[(kb + sr) * LDP + sc]), ks1 = ld8(&Kh[(kb + 32 + sr) * LDP + sc]);
    __syncthreads();
    *(bf16x8*)(V_lds + vst0) = vs0; *(bf16x8*)(V_lds + vst1) = vs1; *(bf16x8*)(K_lds + kst0) = ks0; *(bf16x8*)(K_lds + kst1) = ks1;
    __syncthreads();
    if (kr >= rs_w && kr < rs_w + 8) {
      f32x16 p0, p1; na_qkt(p0, p1, K_lds, qr, r32, hi);
      const float* btr = bt + (kr - r + 7) * 31;
      float pmax = -INFINITY;
#pragma unroll
      for (int rr = 0; rr < 16; ++rr) {
        const int ck0 = crow(rr, hi), ck1 = ck0 + 32;
        const int ci0 = min(max(ck0 - cq, -15), 15) + 15, ci1 = min(max(ck1 - cq, -15), 15) + 15;
        const float s0 = fmaf(p0[rr], C, btr[ci0]), s1 = fmaf(p1[rr], C, btr[ci1]);
        p0[rr] = (ck0 >= cs && ck0 < cs + 16) ? s0 : -INFINITY; p1[rr] = (ck1 >= cs && ck1 < cs + 16) ? s1 : -INFINITY;
        pmax = fmaxf(pmax, fmaxf(p0[rr], p1[rr]));
      }
      { auto rr = __builtin_amdgcn_permlane32_swap(__float_as_uint(pmax), __float_as_uint(pmax), false, false);
        pmax = fmaxf(__uint_as_float(rr[0]), __uint_as_float(rr[1])); }
      const float mn = fmaxf(m_reg, pmax); const float alpha = __builtin_amdgcn_exp2f(m_reg - mn); m_reg = mn;
      float ps = 0.f;
#pragma unroll
      for (int rr = 0; rr < 16; ++rr) { p0[rr] = __builtin_amdgcn_exp2f(p0[rr] - mn); p1[rr] = __builtin_amdgcn_exp2f(p1[rr] - mn); ps += p0[rr] + p1[rr]; }
      { auto rr = __builtin_amdgcn_permlane32_swap(__float_as_uint(ps), __float_as_uint(ps), false, false);
        ps = __uint_as_float(rr[0]) + __uint_as_float(rr[1]); }
      l_reg = l_reg * alpha + ps;
      if (hi == 0) al_l[r32] = alpha; asm volatile("s_waitcnt lgkmcnt(0)" ::: "memory");
#pragma unroll
      for (int d = 0; d < 4; ++d)
#pragma unroll
        for (int rr = 0; rr < 16; ++rr) o[d][rr] *= al_l[crow(rr, hi)];
      bf16x8 pa0, pa1, pa2, pa3;
      ATT_PK4(p0, 0, pa0); ATT_PK4(p0, 8, pa1); ATT_PK4(p1, 0, pa2); ATT_PK4(p1, 8, pa3);
      SBAR(); pv_d0(o, vb0, pa0, pa1, pa2, pa3);
    }
  }
  if (hi == 0) li_l[r32] = l_reg; asm volatile("s_waitcnt lgkmcnt(0)" ::: "memory");
  float rli[16];
#pragma unroll
  for (int rr = 0; rr < 16; ++rr) rli[rr] = __builtin_amdgcn_rcpf(li_l[crow(rr, hi)]);
  AGAS bf16* out_l = out; asm volatile("" : "+s"(out_l));
  AGAS bf16* Ow = out_l + (row0 + (long)r * 64 + (wid & 1) * 32) * LDO + 1024 + h * 128 + r32;
#pragma unroll
  for (int rr = 0; rr < 16; ++rr) { AGAS bf16* ob = Ow; asm volatile("" : "+v"(ob)); AGAS bf16* op = ob + (long)crow(rr, hi) * LDO;
#pragma unroll
    for (int d0 = 0; d0 < 4; ++d0) op[d0 * 32] = f2bf1(o[d0][rr] * rli[rr]); }
}
#undef SBAR
}

namespace att {
constexpr int D_SLOTK = 8192, D_LDS_K = 0, D_LDS_V = 3 * D_SLOTK, D_LDS_WS = D_LDS_V + 6 * D_SLOTK, D_LDS_END = D_LDS_WS + 8 * 256;
typedef __attribute__((address_space(3))) const char* lds_cptr;
typedef short v4i16_t __attribute__((ext_vector_type(4)));
#define SBAR() __builtin_amdgcn_sched_barrier(0)
#define WAIT_BAR(N) asm volatile("s_waitcnt vmcnt(" #N ") lgkmcnt(0)\n\ts_barrier" ::: "memory")
__device__ __forceinline__ void glds16(const AGAS void* gsrc, unsigned lds_dst) { unsigned keep;
  asm volatile("s_mov_b32 %0, m0\n\ts_mov_b32 m0, %2\n\ts_nop 0\n\tglobal_load_lds_dwordx4 %1, off\n\ts_mov_b32 m0, %0" : "=&s"(keep) : "v"(gsrc), "s"(lds_dst) : "memory"); }
__device__ __forceinline__ unsigned cvtpk_s(float lo, float hi) { typedef float f2_t __attribute__((ext_vector_type(2))); typedef __bf16 b2_t __attribute__((ext_vector_type(2)));
  f2_t v = {lo, hi}; b2_t b = __builtin_convertvector(v, b2_t); return __builtin_bit_cast(unsigned, b); }
__device__ __forceinline__ void kload8(bf16x8* kf, lds_cptr kp) {
  kf[0] = *(const __attribute__((address_space(3))) bf16x8*)(kp);        kf[1] = *(const __attribute__((address_space(3))) bf16x8*)(kp + 512);
  kf[2] = *(const __attribute__((address_space(3))) bf16x8*)(kp + 2048); kf[3] = *(const __attribute__((address_space(3))) bf16x8*)(kp + 2560);
  kf[4] = *(const __attribute__((address_space(3))) bf16x8*)(kp + 4096); kf[5] = *(const __attribute__((address_space(3))) bf16x8*)(kp + 4608);
  kf[6] = *(const __attribute__((address_space(3))) bf16x8*)(kp + 6144); kf[7] = *(const __attribute__((address_space(3))) bf16x8*)(kp + 6656);
}
__device__ __forceinline__ void kload2(bf16x8* kf, lds_cptr kp, int j) { kf[2 * j] = *(const __attribute__((address_space(3))) bf16x8*)(kp + j * 2048); kf[2 * j + 1] = *(const __attribute__((address_space(3))) bf16x8*)(kp + j * 2048 + 512); }
__device__ __forceinline__ s16x4 vtr(lds_cptr p) { return __builtin_bit_cast(s16x4, __builtin_amdgcn_ds_read_tr16_b64_v4i16((__attribute__((address_space(3))) v4i16_t*)p)); }
__device__ __forceinline__ void pv4(f32x16* o, int vb, bf16x8 pa0, bf16x8 pa1, bf16x8 pa2, bf16x8 pa3) {
#pragma unroll
  for (int d0 = 0; d0 < 4; ++d0) { s16x4 lo[4], hi[4];
#pragma unroll
    for (int ks = 0; ks < 4; ++ks) {
      asm volatile("ds_read_b64_tr_b16 %0,%1 offset:%c2" : "=&v"(lo[ks]) : "v"(vb), "i"(d0 * 4096 + ks * 1024) : "memory");
      asm volatile("ds_read_b64_tr_b16 %0,%1 offset:%c2" : "=&v"(hi[ks]) : "v"(vb), "i"(d0 * 4096 + ks * 1024 + 512) : "memory"); }
    asm volatile("s_waitcnt lgkmcnt(0)" ::: "memory"); SBAR();
#define PK(k) (bf16x8){lo[k][0], lo[k][1], lo[k][2], lo[k][3], hi[k][0], hi[k][1], hi[k][2], hi[k][3]}
    o[d0] = __builtin_amdgcn_mfma_f32_32x32x16_bf16(pa0, PK(0), o[d0], 0, 0, 0);
    o[d0] = __builtin_amdgcn_mfma_f32_32x32x16_bf16(pa1, PK(1), o[d0], 0, 0, 0);
    o[d0] = __builtin_amdgcn_mfma_f32_32x32x16_bf16(pa2, PK(2), o[d0], 0, 0, 0);
    o[d0] = __builtin_amdgcn_mfma_f32_32x32x16_bf16(pa3, PK(3), o[d0], 0, 0, 0);
#undef PK
  }
}
template <int THRL>
__device__ __forceinline__ void diff_unit2(const AGAS bf16* __restrict__ proj, long row0, int T, int h, int q0, float lam, float gscale,
                                           const AGAS float* __restrict__ ng, AGAS bf16* __restrict__ out, AGAS float* __restrict__ stash, char* shm) {
  int tid_ = threadIdx.x; asm volatile("" : "+v"(tid_));
  const int tid = tid_, lane = tid & 63, r32 = lane & 31, hi = lane >> 5; const int wid = __builtin_amdgcn_readfirstlane(tid >> 6);
  typedef float f32x4v __attribute__((ext_vector_type(4))); typedef float f32x2p __attribute__((ext_vector_type(2)));
  const unsigned lds0 = (unsigned)(uintptr_t)shm;
  float* wsf = (float*)(shm + D_LDS_WS) + wid * 64;
  const lds_cptr shm3 = (lds_cptr)shm;
  const int vlane = ((lane >> 4) & 1) * 32 + (lane & 3) * 8 + (4 * hi + ((lane & 15) >> 2)) * 64;
  const lds_cptr kp0 = shm3 + D_LDS_K + hi * 1024 + r32 * 16; const lds_cptr vp0 = shm3 + D_LDS_V + vlane;
  const int vb0 = (int)(lds0 + D_LDS_V) + vlane;
  const unsigned kdst = lds0 + D_LDS_K + wid * 1024, vdst = lds0 + D_LDS_V + wid * 1024;
  const int NT = T / 64;
#pragma unroll 1
  for (int c = 0; c < 2; ++c) {
    const AGAS bf16* pj = proj; asm volatile("" : "+s"(pj));
    const AGAS bf16* Qw = pj + (row0 + q0 + wid * 32) * LDP + h * 128 + c * 64;
    const AGAS bf16* ksrc = pj + (row0 + lane) * LDP + 1024 + h * 128 + c * 64 + wid * 8;
    const AGAS bf16* vsrc = pj + (row0 + 16 * (wid & 3) + (lane >> 2)) * LDP + 2048 + h * 128 + (wid >> 2) * 32 + (lane & 3) * 8;
#define DMA_K(t, slot) glds16(ksrc + (long)(t) * 64 * LDP, (unsigned)__builtin_amdgcn_readfirstlane(kdst + (slot)))
#define DMA_V(t, slot) do { glds16(vsrc + (long)(t) * 64 * LDP, (unsigned)__builtin_amdgcn_readfirstlane(vdst + 2 * (slot))); \
                            glds16(vsrc + (long)(t) * 64 * LDP + 64, (unsigned)__builtin_amdgcn_readfirstlane(vdst + 2 * (slot) + 8192)); } while (0)
    asm volatile("s_waitcnt lgkmcnt(0)\n\ts_barrier" ::: "memory");
    DMA_K(0, 0); DMA_V(0, 0); DMA_K(1, D_SLOTK);
    bf16x8 qr[4];
#pragma unroll
    for (int d0 = 0; d0 < 4; ++d0) qr[d0] = ld8(Qw + (long)r32 * LDP + d0 * 16 + hi * 8);
    float mhat = 0.f, l_reg = 0.f; f32x16 o[4]; o[0] = f32x16{}; o[1] = f32x16{}; o[2] = f32x16{}; o[3] = f32x16{};
    bool resc = false;
#define RESC() do { if (resc) { asm volatile("s_waitcnt lgkmcnt(0)" ::: "memory"); \
      _Pragma("unroll") for (int d_ = 0; d_ < 4; ++d_) _Pragma("unroll") for (int r = 0; r < 16; ++r) o[d_][r] *= wsf[crow(r, hi)]; } } while (0)
    f32x16 pA0, pA1, pB0, pB1; bf16x8 kf[8];
    int sl_prev = 0, sl_cur = 0, sl_next = D_SLOTK;
#define ROT() do { sl_prev = sl_cur; sl_cur = sl_next; sl_next = (sl_next == 2 * D_SLOTK) ? 0 : sl_next + D_SLOTK; } while (0)
    DMA_K(2, 2 * D_SLOTK);
    WAIT_BAR(3);
    { const lds_cptr kb = kp0;
      pA0 = f32x16{}; pA1 = f32x16{};
#pragma unroll
      for (int d0 = 0; d0 < 4; ++d0) {
        const bf16x8 b0 = *(const __attribute__((address_space(3))) bf16x8*)(kb + d0 * 2048), b1 = *(const __attribute__((address_space(3))) bf16x8*)(kb + d0 * 2048 + 512);
        pA0 = __builtin_amdgcn_mfma_f32_32x32x16_bf16(b0, qr[d0], pA0, 0, 0, 0); pA1 = __builtin_amdgcn_mfma_f32_32x32x16_bf16(b1, qr[d0], pA1, 0, 0, 0); }
      float rm = pA0[0];
#pragma unroll
      for (int r = 1; r < 16; ++r) rm = fmaxf(rm, pA0[r]);
#pragma unroll
      for (int r = 0; r < 16; ++r) rm = fmaxf(rm, pA1[r]);
      { auto rr = __builtin_amdgcn_permlane32_swap(__float_as_uint(rm), __float_as_uint(rm), false, false); rm = fmaxf(__uint_as_float(rr[0]), __uint_as_float(rr[1])); }
      mhat = rm;
#pragma unroll
      for (int r = 0; r < 16; ++r) { pA0[r] = __builtin_amdgcn_exp2f(pA0[r] - mhat); pA1[r] = __builtin_amdgcn_exp2f(pA1[r] - mhat); }
    }
    WAIT_BAR(0);
    DMA_K(3, 0); DMA_V(1, D_SLOTK);
    ROT();
    kload8(kf, kp0 + sl_cur);
    WAIT_BAR(3);
    s16x4 vlo[8], vhi[8]; u32x4 pw0, pw1, pw2, pw3;
#define PKW(P, B) cvtpk_s(P[B], P[B + 1])
#define PAF(k) __builtin_bit_cast(bf16x8, pw##k)
#define VFR(i) (bf16x8){vlo[i][0], vlo[i][1], vlo[i][2], vlo[i][3], vhi[i][0], vhi[i][1], vhi[i][2], vhi[i][3]}
#define PIN(x) asm volatile("" : "+v"(x))
#define MX3(a, b, c) __builtin_fmaxf(__builtin_fmaxf((a), (b)), (c))
#define EX(v) __builtin_amdgcn_exp2f(v)
#define MF(a, b, c) __builtin_amdgcn_mfma_f32_32x32x16_bf16(a, b, c, 0, 0, 0)
#define VRD(s, f) do { vlo[s] = vtr(vp_ + (((f) >> 2) * 4096 + ((f) & 3) * 1024)); vhi[s] = vtr(vp_ + (((f) >> 2) * 4096 + ((f) & 3) * 1024 + 512)); } while (0)
#define GAPA(MFS, A0, A1, A2, A3, W0, W1, PW) do { MFS; sacc += A0; sacc += A1; sacc += A2; sacc += A3; PIN(sacc); W0; W1; PIN(PW); SBAR(); } while (0)
#define GAPB(MFS, X, B) do { MFS; X[B] = EX(X[B] - mhat); X[B + 1] = EX(X[B + 1] - mhat); PIN(X); SBAR(); } while (0)
#define KRD(G, j) do { if (G) { kload2(kf, kp0 + sl_next, j); SBAR(); } } while (0)
#define STEP(C0, C1, P0, P1, t, GK, GV, GL) do { SBAR(); \
    const lds_cptr vp_ = vp0 + 2 * sl_prev; \
    VRD(0, 0); SBAR(); float sacc = (P0[0] + P0[1]); \
    GAPA(C0 = MF(kf[0], qr[0], (f32x16{})), P0[2], P0[3], P0[4], P0[5],     pw0[0] = PKW(P0, 0), pw0[1] = PKW(P0, 2), pw0); \
    VRD(1, 4); SBAR(); GAPA(C1 = MF(kf[1], qr[0], (f32x16{})), P0[6], P0[7], P0[8], P0[9],     pw0[2] = PKW(P0, 4), pw0[3] = PKW(P0, 6), pw0); \
    VRD(2, 8); SBAR(); GAPA(C0 = MF(kf[2], qr[1], C0),   P0[10], P0[11], P0[12], P0[13], pw1[0] = PKW(P0, 8), pw1[1] = PKW(P0, 10), pw1); \
    VRD(3, 12); SBAR(); GAPA(C1 = MF(kf[3], qr[1], C1),  P0[14], P0[15], P1[0], P1[1],   pw1[2] = PKW(P0, 12), pw1[3] = PKW(P0, 14), pw1); \
    VRD(4, 1); SBAR(); GAPA(C0 = MF(kf[4], qr[2], C0),   P1[2], P1[3], P1[4], P1[5],     pw2[0] = PKW(P1, 0), pw2[1] = PKW(P1, 2), pw2); \
    VRD(5, 5); SBAR(); GAPA(C1 = MF(kf[5], qr[2], C1),   P1[6], P1[7], P1[8], P1[9],     pw2[2] = PKW(P1, 4), pw2[3] = PKW(P1, 6), pw2); \
    VRD(6, 9); SBAR(); GAPA(C0 = MF(kf[6], qr[3], C0),   P1[10], P1[11], P1[12], P1[13], pw3[0] = PKW(P1, 8), pw3[1] = PKW(P1, 10), pw3); \
    VRD(7, 13); SBAR(); GAPA(C1 = MF(kf[7], qr[3], C1),  P1[14], P1[15], 0.f, 0.f,       pw3[2] = PKW(P1, 12), pw3[3] = PKW(P1, 14), pw3); \
    l_reg += sacc; \
    if (GK) { DMA_K((t) + 3, sl_cur); } if (GV) { DMA_V((t) + 1, sl_next); } \
    { float a = MX3(C0[0], C0[1], C1[0]), b = MX3(C0[2], C0[3], C1[1]); a = MX3(a, C1[2], C1[3]); \
      _Pragma("unroll") for (int r = 4; r < 16; r += 4) { a = MX3(a, C0[r], C0[r + 1]); b = MX3(b, C0[r + 2], C0[r + 3]); a = MX3(a, C1[r], C1[r + 1]); b = MX3(b, C1[r + 2], C1[r + 3]); } \
      float rm = __builtin_fmaxf(a, b); { auto rr = __builtin_amdgcn_permlane32_swap(__float_as_uint(rm), __float_as_uint(rm), false, false); rm = __builtin_fmaxf(__uint_as_float(rr[0]), __uint_as_float(rr[1])); } \
      resc = false; \
      if (__builtin_expect(__any(rm - mhat > (float)THRL), 0)) { const float dl = __builtin_fmaxf(rm - mhat, 0.f); mhat += dl; \
        const float f = __builtin_amdgcn_exp2f(-dl); l_reg *= f; if (hi == 0) wsf[r32] = f; resc = true; } } \
    SBAR(); \
    GAPB(o[0] = MF(PAF(0), VFR(0), o[0]), C0, 0);  VRD(0, 2); SBAR(); \
    GAPB(o[1] = MF(PAF(0), VFR(1), o[1]), C0, 2);  VRD(1, 6); SBAR(); \
    GAPB(o[2] = MF(PAF(0), VFR(2), o[2]), C0, 4);  VRD(2, 10); SBAR(); \
    GAPB(o[3] = MF(PAF(0), VFR(3), o[3]), C0, 6);  VRD(3, 14); SBAR(); \
    GAPB(o[0] = MF(PAF(1), VFR(4), o[0]), C0, 8);  VRD(4, 3); SBAR(); \
    GAPB(o[1] = MF(PAF(1), VFR(5), o[1]), C0, 10); VRD(5, 7); SBAR(); \
    GAPB(o[2] = MF(PAF(1), VFR(6), o[2]), C0, 12); VRD(6, 11); SBAR(); \
    GAPB(o[3] = MF(PAF(1), VFR(7), o[3]), C0, 14); VRD(7, 15); SBAR(); \
    GAPB(o[0] = MF(PAF(2), VFR(0), o[0]), C1, 0);  KRD(GL, 0); \
    GAPB(o[1] = MF(PAF(2), VFR(1), o[1]), C1, 2);  KRD(GL, 1); \
    GAPB(o[2] = MF(PAF(2), VFR(2), o[2]), C1, 4);  KRD(GL, 2); \
    GAPB(o[3] = MF(PAF(2), VFR(3), o[3]), C1, 6);  KRD(GL, 3); \
    GAPB(o[0] = MF(PAF(3), VFR(4), o[0]), C1, 8); \
    GAPB(o[1] = MF(PAF(3), VFR(5), o[1]), C1, 10); \
    GAPB(o[2] = MF(PAF(3), VFR(6), o[2]), C1, 12); \
    GAPB(o[3] = MF(PAF(3), VFR(7), o[3]), C1, 14); \
    } while (0)
#define ENDW(tt) do { if ((tt) + 3 < NT) { WAIT_BAR(3); } else if ((tt) + 2 < NT) { WAIT_BAR(2); } else { WAIT_BAR(0); } } while (0)
    int t = 1;
    for (; t + 5 < NT; t += 2) {
      STEP(pB0, pB1, pA0, pA1, t, true, true, true);       WAIT_BAR(3); RESC(); ROT();
      STEP(pA0, pA1, pB0, pB1, t + 1, true, true, true);   WAIT_BAR(3); RESC(); ROT();
    }
    for (; t + 1 < NT; t += 2) {
      STEP(pB0, pB1, pA0, pA1, t, (t + 3 < NT), (t + 1 < NT), (t + 1 < NT));         ENDW(t);     RESC(); ROT();
      STEP(pA0, pA1, pB0, pB1, t + 1, (t + 4 < NT), (t + 2 < NT), (t + 2 < NT));     ENDW(t + 1); RESC(); ROT();
    }
    STEP(pB0, pB1, pA0, pA1, NT - 1, false, false, false); RESC();
    { float sacc = pB0[0] + pB0[1];
#pragma unroll
      for (int r = 2; r < 16; ++r) sacc += pB0[r];
#pragma unroll
      for (int r = 0; r < 16; ++r) sacc += pB1[r];
      l_reg += sacc;
      pw0 = (u32x4){PKW(pB0, 0), PKW(pB0, 2), PKW(pB0, 4), PKW(pB0, 6)}; pw1 = (u32x4){PKW(pB0, 8), PKW(pB0, 10), PKW(pB0, 12), PKW(pB0, 14)};
      pw2 = (u32x4){PKW(pB1, 0), PKW(pB1, 2), PKW(pB1, 4), PKW(pB1, 6)}; pw3 = (u32x4){PKW(pB1, 8), PKW(pB1, 10), PKW(pB1, 12), PKW(pB1, 14)};
      SBAR(); pv4(o, vb0 + 2 * sl_cur, PAF(0), PAF(1), PAF(2), PAF(3)); }
#undef PKW
#undef PAF
#undef VFR
#undef PIN
#undef MX3
#undef EX
#undef MF
#undef VRD
#undef GAPA
#undef GAPB
#undef KRD
#undef STEP
#undef ENDW
#undef DMA_K
#undef DMA_V
#undef RESC
#undef ROT
    { auto rr = __builtin_amdgcn_permlane32_swap(__float_as_uint(l_reg), __float_as_uint(l_reg), false, false); l_reg = __uint_as_float(rr[0]) + __uint_as_float(rr[1]); }
    if (hi == 0) wsf[32 + r32] = l_reg; asm volatile("s_waitcnt lgkmcnt(0)" ::: "memory");
    float rli[16];
#pragma unroll
    for (int r = 0; r < 16; ++r) rli[r] = __builtin_amdgcn_rcpf(wsf[32 + crow(r, hi)]);
    AGAS float* stash_l = stash; asm volatile("" : "+s"(stash_l));
    AGAS f32x4v* st4 = (AGAS f32x4v*)(stash_l + ((size_t)wid * 64 + lane) * 64);
    if (c == 0) {
#pragma unroll
      for (int d0 = 0; d0 < 4; ++d0)
#pragma unroll
        for (int r4 = 0; r4 < 4; ++r4) st4[d0 * 4 + r4] = (f32x4v){o[d0][4 * r4] * rli[4 * r4], o[d0][4 * r4 + 1] * rli[4 * r4 + 1], o[d0][4 * r4 + 2] * rli[4 * r4 + 2], o[d0][4 * r4 + 3] * rli[4 * r4 + 3]};
    } else {
      AGAS bf16* out_l = out; asm volatile("" : "+s"(out_l));
      AGAS bf16* Ow = out_l + (row0 + q0 + wid * 32) * LDO + h * 128 + r32;
      float gv[4];
#pragma unroll
      for (int d0 = 0; d0 < 4; ++d0) gv[d0] = ng[d0 * 32 + r32] * gscale;
#pragma unroll
      for (int r4 = 0; r4 < 4; ++r4) {
        f32x4v s4[4];
#pragma unroll
        for (int d0 = 0; d0 < 4; ++d0) s4[d0] = st4[d0 * 4 + r4];
#pragma unroll
        for (int e = 0; e < 4; ++e) { const int r = 4 * r4 + e;
          float v[4]; float ss = 0.f;
#pragma unroll
          for (int d0 = 0; d0 < 4; ++d0) { v[d0] = s4[d0][e] - lam * (o[d0][r] * rli[r]); ss += v[d0] * v[d0]; }
          ss += __shfl_xor(ss, 1); ss += __shfl_xor(ss, 2); ss += __shfl_xor(ss, 4); ss += __shfl_xor(ss, 8); ss += __shfl_xor(ss, 16);
          const float rstd = 1.0f / sqrtf(ss * (1.0f / 128.0f) + 1e-5f);
          AGAS bf16* ob = Ow; asm volatile("" : "+v"(ob)); AGAS bf16* op = ob + (long)crow(r, hi) * LDO;
#pragma unroll
          for (int d0 = 0; d0 < 4; ++d0) op[d0 * 32] = f2bf1(v[d0] * rstd * gv[d0]);
        }
      }
    }
  }
  asm volatile("s_waitcnt lgkmcnt(0)\n\ts_barrier" ::: "memory");
}
#undef SBAR
#undef WAIT_BAR
}

#define GAS __attribute__((address_space(1)))
#define LAS __attribute__((address_space(3)))
typedef unsigned short bf16;
typedef unsigned v4u __attribute__((ext_vector_type(4)));
typedef float f32x4 __attribute__((ext_vector_type(4)));
typedef short bf16x8 __attribute__((ext_vector_type(8)));
typedef GAS unsigned gu32;
typedef GAS unsigned long long gu64;
#define RLX_AGENT __ATOMIC_RELAXED, __HIP_MEMORY_SCOPE_AGENT
#define LDS_WAIT() asm volatile("s_waitcnt lgkmcnt(0)" ::: "memory")
#define VM_WAIT() asm volatile("s_waitcnt vmcnt(0)" ::: "memory")
__device__ __forceinline__ unsigned long long rt() { return __builtin_amdgcn_s_memrealtime(); }
__device__ __forceinline__ unsigned f2bf(float f) { unsigned u = __builtin_bit_cast(unsigned, f); return (u + 0x7fffu + ((u >> 16) & 1u)) >> 16; }
__device__ __forceinline__ unsigned pk2(float lo, float hi) { return f2bf(lo) | (f2bf(hi) << 16); }
#define XB_TMO      128
#define XB_XCNT(j)  (256  + 64 * (j))
#define XB_XSUB(j)  (1280 + 64 * (j))
#define XB_XGEN(j)  (2304 + 64 * (j))
#define XB_TOP      3328
#define XB_TOPGEN   3392
#define XCD_BAR_WORDS 3456
#define XB_SPIN_CAP (1u << 18)

__device__ __forceinline__ unsigned xb_ld(unsigned* p)              { return __hip_atomic_load(p, __ATOMIC_RELAXED, __HIP_MEMORY_SCOPE_AGENT); }
__device__ __forceinline__ unsigned xb_add(unsigned* p, unsigned v) { return __hip_atomic_fetch_add(p, v, __ATOMIC_RELAXED, __HIP_MEMORY_SCOPE_AGENT); }
__device__ __forceinline__ unsigned xb_xcc_id() { return (unsigned)__builtin_amdgcn_s_getreg((3 << 11) | 20) & 0xFu; }
#define XB_SPIN(cond, bar) do { unsigned _sp = 0; while (cond) { __builtin_amdgcn_s_sleep(1); \
    if ((++_sp & 255u) == 0u) { if (xb_ld(&(bar)[XB_TMO])) break; if (_sp > XB_SPIN_CAP) { atomicAdd(&(bar)[XB_TMO], 1u); break; } } } } while (0)

struct XcdBarrier {
    unsigned* bar; unsigned x;
    volatile LAS unsigned* st;
};

__device__ __forceinline__ XcdBarrier xcd_barrier_post(unsigned* bar, volatile LAS unsigned* st) {
    XcdBarrier b; b.bar = bar; b.x = xb_xcc_id(); b.st = st;
    if (threadIdx.x == 0) (void)xb_add(&bar[XB_XCNT(b.x)], 1u);
    return b;
}
__device__ __forceinline__ void xcd_barrier_complete(unsigned* bar, unsigned x, unsigned& nloc, unsigned& nx) {
    const unsigned G = gridDim.x * gridDim.y * gridDim.z;
    unsigned sum, cnt, mine, sp = 0u;
    for (;;) {
        sum = 0u; cnt = 0u; mine = 0u;
#pragma unroll
        for (unsigned j = 0; j < 16; ++j) { const unsigned c = xb_ld(&bar[XB_XCNT(j)]); sum += c; cnt += (c > 0u) ? 1u : 0u; mine = (j == x) ? c : mine; }
        if (sum == G) break;
        __builtin_amdgcn_s_sleep(1);
        if ((++sp & 255u) == 0u) { if (xb_ld(&bar[XB_TMO])) break; if (sp > XB_SPIN_CAP) { atomicAdd(&bar[XB_TMO], 1u); break; } }
    }
    nloc = mine > 0u ? mine : 1u; nx = cnt > 0u ? cnt : 1u;
}

__device__ __forceinline__ void xcd_barrier(const XcdBarrier& b) {
    asm volatile("s_waitcnt vmcnt(0)" ::: "memory");
    __syncthreads();
    unsigned bx_ = b.x; asm volatile("" : "+s"(bx_));
    if (threadIdx.x == 0) {
        unsigned* bar = b.bar; asm volatile("" : "+s"(bar));
        __builtin_amdgcn_s_waitcnt(0);
        unsigned nloc = b.st[0], nx = b.st[1];
        if (nloc == 0u) { xcd_barrier_complete(bar, bx_, nloc, nx); b.st[0] = nloc; b.st[1] = nx; }
        const unsigned old = xb_add(&bar[XB_XSUB(bx_)], 1u);
        const unsigned gen = old / nloc;
        if (old + 1u == (gen + 1u) * nloc) {
            __builtin_amdgcn_fence(__ATOMIC_RELEASE, "agent");
            asm volatile("s_waitcnt vmcnt(0)" ::: "memory");
            const unsigned og = xb_add(&bar[XB_TOP], 1u);
            const unsigned tg = og / nx;
            if (og + 1u == (tg + 1u) * nx) xb_add(&bar[XB_TOPGEN], 1u);
            else XB_SPIN(xb_ld(&bar[XB_TOPGEN]) == tg, bar);
            __builtin_amdgcn_fence(__ATOMIC_ACQUIRE, "agent");
            xb_add(&bar[XB_XGEN(bx_)], 1u);
            asm volatile("s_waitcnt vmcnt(0)" ::: "memory");
        } else {
            XB_SPIN(xb_ld(&bar[XB_XGEN(bx_)]) == gen, bar);
            __builtin_amdgcn_fence(__ATOMIC_ACQUIRE, "agent");
            asm volatile("s_waitcnt vmcnt(0)" ::: "memory");
        }
    }
    __syncthreads();
}
constexpr int NWAVES = 8;
constexpr int DM = 2048, DFF = 5632, NGU = 2 * DFF, NIN = 6144, NLAYER = 2;
constexpr int MP = 8 * 4096, MS = 2 * 16384, M = MP + MS;
constexpr int NB = 10, MODW = 9 * DM;
constexpr float LN_EPS = 1e-5f;
constexpr float DN_ALPHA = 1.4142135623730951f;

constexpr size_t MiB = 1u << 20;
constexpr size_t WS_CTL = 0, CTL_ZERO_BYTES = 1 * MiB;
constexpr size_t WS_MODV = 1 * MiB;
constexpr size_t WS_ROPE = 3 * MiB;
constexpr size_t WS_MISC = 7 * MiB;
constexpr size_t WS_W = 8 * MiB;
constexpr size_t WO_GU1 = 0, WO_D1 = 44 * MiB, WO_IN = 66 * MiB, WO_OUT = 90 * MiB, WO_GU2 = 98 * MiB, WO_D2 = 142 * MiB, W_BYTES = 164 * MiB;
constexpr size_t WS_HA = WS_W + W_BYTES;
constexpr size_t WS_HB = WS_HA + 256 * MiB;
constexpr size_t WS_BIG = WS_HB + 256 * MiB;
constexpr size_t WS_END = WS_BIG + 768 * MiB;
static_assert((size_t)NGU * DM * 2 == 44 * MiB && (size_t)DM * DFF * 2 == 22 * MiB && (size_t)NIN * DM * 2 == 24 * MiB && (size_t)DM * DM * 2 == 8 * MiB, "weight map");
static_assert((size_t)M * NIN * 2 == 768 * MiB && (size_t)M * DM * 2 == 256 * MiB, "activation map");
constexpr int CW_BAR = 4096;

constexpr int RING_OFF = 0, RING_BYTES = 131072;
constexpr int LDSCTL_OFF = RING_BYTES, MISC_OFF = LDSCTL_OFF + 320;
constexpr int EPI_STG_OFF = LDSCTL_OFF + 512, EPI_STG_BYTES = 8 * 576 * 4;
constexpr int LDS_BYTES = 155648;
static_assert(EPI_STG_OFF + EPI_STG_BYTES <= LDS_BYTES && EPI_STG_OFF == pg8::EpiResid::STG_OFF, "LDS map");

__device__ __forceinline__ float wave_sum(float v) {
#pragma unroll
    for (int o = 1; o < 64; o <<= 1) v += __shfl_xor(v, o);
    return v;
}
template <int MODE> __device__ __forceinline__ int dest_row(int s) {
    if (MODE == 1) { const int half = s >= DFF ? 1 : 0; const int j = s - half * DFF; return 256 * (j >> 7) + 128 * half + (j & 127); }
    if (MODE == 2) { if (s < 2048) { const int d = s & 63; const int p = d < 32 ? 2 * d : 2 * (d - 32) + 1; return (s & ~63) + p; } return s; }
    return s;
}
template <int MODE> __device__ __forceinline__ void transpose_item(const float* W, int K, int N, bf16* WT, LAS float* scr, int item, int lane) {
    const int nblk = N / 32, kb = item / nblk, nb = item % nblk, k0 = 64 * kb, n0 = 32 * nb;
#pragma unroll 8
    for (int i = 0; i < 32; ++i) { const int kk = 2 * i + (lane >> 5); scr[kk * 33 + (lane & 31)] = W[(size_t)(k0 + kk) * N + n0 + (lane & 31)]; }
    LDS_WAIT(); asm volatile("" ::: "memory");
    const int c = lane & 7;
#pragma unroll
    for (int j = 0; j < 4; ++j) { const int n = (lane >> 3) + 8 * j; const LAS float* s = scr + (8 * c) * 33 + n;
        v4u o; o.x = pk2(s[0 * 33], s[1 * 33]); o.y = pk2(s[2 * 33], s[3 * 33]); o.z = pk2(s[4 * 33], s[5 * 33]); o.w = pk2(s[6 * 33], s[7 * 33]);
        const int dr = dest_row<MODE>(n0 + n);
        *(GAS v4u*)(WT + ((size_t)(dr >> 8) * (K >> 6) + (k0 >> 6)) * 16384 + (dr & 255) * 64 + 8 * c) = o; }
    LDS_WAIT(); asm volatile("" ::: "memory");
}
struct Args { const GAS float* in[20]; GAS float* out; GAS unsigned char* ws; };

typedef const __attribute__((address_space(4))) Args* KArgsT;
__device__ __forceinline__ void convert_layer(KArgsT a, int l, unsigned char* wsw, LAS float* scr, int gw, int NGW, int lane) {
    constexpr int I_GU = (DM / 64) * (NGU / 32), I_D = (DFF / 64) * (DM / 32), I_IN = (DM / 64) * (NIN / 32), I_O = (DM / 64) * (DM / 32);
    constexpr int NITEMS = 2 * I_GU + 2 * I_D + I_IN + I_O;
    asm volatile("" : "+v"(lane));
    for (int it = gw; it < NITEMS; it += NGW) {
        int r = it;
        if (r < I_GU) { transpose_item<1>(((const float*)a->in[8]) + (size_t)l * DM * NGU, DM, NGU, (bf16*)(wsw + WO_GU1), scr, r, lane); continue; } r -= I_GU;
        if (r < I_D)  { transpose_item<0>(((const float*)a->in[9]) + (size_t)l * DFF * DM, DFF, DM, (bf16*)(wsw + WO_D1), scr, r, lane); continue; } r -= I_D;
        if (r < I_IN) { transpose_item<2>(((const float*)a->in[10]) + (size_t)l * DM * NIN, DM, NIN, (bf16*)(wsw + WO_IN), scr, r, lane); continue; } r -= I_IN;
        if (r < I_O)  { transpose_item<0>(((const float*)a->in[11]) + (size_t)l * DM * DM, DM, DM, (bf16*)(wsw + WO_OUT), scr, r, lane); continue; } r -= I_O;
        if (r < I_GU) { transpose_item<1>(((const float*)a->in[18]) + (size_t)l * DM * NGU, DM, NGU, (bf16*)(wsw + WO_GU2), scr, r, lane); continue; } r -= I_GU;
        transpose_item<0>(((const float*)a->in[19]) + (size_t)l * DFF * DM, DFF, DM, (bf16*)(wsw + WO_D2), scr, r, lane);
    }
}
__device__ __forceinline__ int batch_of_row(int m) { return m < MP ? (m >> 12) : 8 + ((m - MP) >> 14); }
__device__ __forceinline__ void mod_rows(const float* xp, const float* xs, bf16* hout, const float* modl, int sh_idx, int gw, int NGW, int lane) {
    asm volatile("" : "+v"(lane));
    for (int m = gw; m < M; m += NGW) {
        const float* xr = m < MP ? xp + (size_t)m * DM : xs + (size_t)(m - MP) * DM;
        const float* mb = modl + (size_t)batch_of_row(m) * MODW;
        GAS unsigned long long* o8 = (GAS unsigned long long*)(hout + (size_t)m * DM) + lane;
#pragma unroll
        for (int j = 0; j < 8; ++j) { const int col = 4 * lane + 256 * j;
            const f32x4 v = *(const GAS f32x4*)(xr + col), sh = *(const GAS f32x4*)(mb + sh_idx * DM + col), sc = *(const GAS f32x4*)(mb + (sh_idx + 1) * DM + col);
            const f32x4 hv = v * (sc + 1.0f) + sh;
            o8[64 * j] = (unsigned long long)pk2(hv.x, hv.y) | ((unsigned long long)pk2(hv.z, hv.w) << 32); }
    }
}
__device__ __forceinline__ void ln_rows(float* y, bf16* hout, const float* lng, const float* lnb, const float* modl, int sh_idx, int gw, int NGW, int lane) {
    asm volatile("" : "+v"(lane));
    for (int m = gw; m < M; m += NGW) {
        GAS f32x4* yr = (GAS f32x4*)(y + (size_t)m * DM) + lane;
        f32x4 v[8]; float s = 0.f;
#pragma unroll
        for (int j = 0; j < 8; ++j) { v[j] = yr[64 * j]; s += (v[j].x + v[j].y) + (v[j].z + v[j].w); }
        const float mean = wave_sum(s) * (1.f / DM); float s2 = 0.f;
#pragma unroll
        for (int j = 0; j < 8; ++j) { v[j] = v[j] - mean; s2 += (v[j].x * v[j].x + v[j].y * v[j].y) + (v[j].z * v[j].z + v[j].w * v[j].w); }
        const float rstd = 1.f / sqrtf(wave_sum(s2) * (1.f / DM) + LN_EPS);
        const float* mb = modl + (size_t)batch_of_row(m) * MODW;
        GAS unsigned long long* o8 = (GAS unsigned long long*)(hout + (size_t)m * DM) + lane;
#pragma unroll
        for (int j = 0; j < 8; ++j) { const int col = 4 * lane + 256 * j;
            const f32x4 g = *(const GAS f32x4*)(lng + col), b = *(const GAS f32x4*)(lnb + col);
            const f32x4 xv = v[j] * rstd * g + b;
            yr[64 * j] = xv;
            if (hout) { const f32x4 sh = *(const GAS f32x4*)(mb + sh_idx * DM + col), sc = *(const GAS f32x4*)(mb + (sh_idx + 1) * DM + col);
                const f32x4 hv = xv * (sc + 1.0f) + sh;
                o8[64 * j] = (unsigned long long)pk2(hv.x, hv.y) | ((unsigned long long)pk2(hv.z, hv.w) << 32); } }
    }
}
#ifdef PROBE_LN_REP
__device__ __forceinline__ void ln_dummy(float* y, bf16* hout, const float* modl, int sh_idx, int gw, int NGW, int lane) {
    asm volatile("" : "+v"(lane));
    for (int m = gw; m < M; m += NGW) {
        GAS f32x4* yr = (GAS f32x4*)(y + (size_t)m * DM) + lane;
        f32x4 v[8]; float s = 0.f;
#pragma unroll
        for (int j = 0; j < 8; ++j) { v[j] = yr[64 * j]; s += (v[j].x + v[j].y) + (v[j].z + v[j].w); }
        const float mean = wave_sum(s) * (1.f / DM); float s2 = 0.f;
#pragma unroll
        for (int j = 0; j < 8; ++j) { const f32x4 d = v[j] - mean; s2 += (d.x * d.x + d.y * d.y) + (d.z * d.z + d.w * d.w); }
        const float rstd = 1.f / sqrtf(wave_sum(s2) * (1.f / DM) + LN_EPS);
        const float keep = rstd > 1e30f ? 0.f : 1.f;
        const float* mb = modl + (size_t)batch_of_row(m) * MODW;
        GAS unsigned long long* o8 = (GAS unsigned long long*)(hout + (size_t)m * DM) + lane;
#pragma unroll
        for (int j = 0; j < 8; ++j) { const int col = 4 * lane + 256 * j;
            const f32x4 xv = v[j] * keep;
            yr[64 * j] = xv;
            const f32x4 sh = *(const GAS f32x4*)(mb + sh_idx * DM + col), sc = *(const GAS f32x4*)(mb + (sh_idx + 1) * DM + col);
            const f32x4 hv = xv * (sc + 1.0f) + sh;
            o8[64 * j] = (unsigned long long)pk2(hv.x, hv.y) | ((unsigned long long)pk2(hv.z, hv.w) << 32); }
    }
}
#endif
__device__ __forceinline__ void modv_phase(KArgsT a, float* modv, LAS unsigned char* lds, int G, int tid, int wave, int lane) {
    LAS float* sc = (LAS float*)lds;
    LAS float* red = (LAS float*)(lds + NB * DM * 4);
    constexpr int NCH = MODW / 128, NIT = NLAYER * NCH;
    if ((int)blockIdx.x >= NIT) return;
    for (int i = tid; i < NB * DM; i += NWAVES * 64) { const int b = i / DM, k = i % DM; const float cv = b < 8 ? ((const float*)a->in[2])[b * DM + k] : ((const float*)a->in[3])[(b - 8) * DM + k];
        sc[i] = cv / (1.0f + __expf(-cv)); }
    __syncthreads();
    for (int it = blockIdx.x; it < NIT; it += G) {
        const int l = it / NCH, ch = it % NCH;
        const float* wp = ((const float*)a->in[4]) + ((size_t)l * DM + wave * 256) * MODW + ch * 128 + 2 * lane;
        float ax[NB], ay[NB];
#pragma unroll
        for (int b = 0; b < NB; ++b) { ax[b] = 0.f; ay[b] = 0.f; }
        for (int k = 0; k < 256; k += 4) {
            typedef float f32x2v __attribute__((ext_vector_type(2)));
            const f32x2v w0 = *(const GAS f32x2v*)(wp + (size_t)(k + 0) * MODW), w1 = *(const GAS f32x2v*)(wp + (size_t)(k + 1) * MODW);
            const f32x2v w2 = *(const GAS f32x2v*)(wp + (size_t)(k + 2) * MODW), w3 = *(const GAS f32x2v*)(wp + (size_t)(k + 3) * MODW);
#pragma unroll
            for (int b = 0; b < NB; ++b) { const f32x4 s4 = *(const LAS f32x4*)(sc + b * DM + wave * 256 + k);
                ax[b] += s4.x * w0.x + s4.y * w1.x + s4.z * w2.x + s4.w * w3.x; ay[b] += s4.x * w0.y + s4.y * w1.y + s4.z * w2.y + s4.w * w3.y; }
        }
#pragma unroll
        for (int b = 0; b < NB; ++b) { red[(wave * NB + b) * 128 + 2 * lane] = ax[b]; red[(wave * NB + b) * 128 + 2 * lane + 1] = ay[b]; }
        __syncthreads();
        for (int o = tid; o < NB * 128; o += NWAVES * 64) { const int b = o / 128, cc = o % 128; float s = 0.f;
#pragma unroll
            for (int w = 0; w < NWAVES; ++w) s += red[(w * NB + b) * 128 + cc];
            modv[((size_t)l * NB + b) * MODW + ch * 128 + cc] = s + ((const float*)a->in[5])[(size_t)l * MODW + ch * 128 + cc]; }
        __syncthreads();
    }
}
__device__ const double ROPE_INVF[32] = {1.0,0.7498942093324559,0.5623413251903491,0.4216965034285822,0.31622776601683794,0.23713737056616552,0.1778279410038923,0.1333521432163324,0.1,0.07498942093324558,0.05623413251903491,0.042169650342858224,0.03162277660168379,0.023713737056616554,0.01778279410038923,0.01333521432163324,0.01,0.007498942093324558,0.005623413251903491,0.004216965034285823,0.0031622776601683794,0.0023713737056616554,0.0017782794100389228,0.001333521432163324,0.001,0.0007498942093324559,0.0005623413251903491,0.00042169650342858224,0.00031622776601683794,0.00023713737056616554,0.00017782794100389227,0.0001333521432163324};
__device__ __forceinline__ void rope_tables(float* ropeC, float* ropeS, int gtid, int nthr) {
    for (int idx = gtid; idx < 16384 * 32; idx += nthr) {
        const int t = idx >> 5, i = idx & 31; const double x = (double)t * ROPE_INVF[i];
        const double q = __builtin_rint(x * 0.63661977236758134308);
        double r = __builtin_fma(-q, 1.57079632679489655800e+00, x); r = __builtin_fma(-q, 6.12323399573676603587e-17, r);
        const double r2 = r * r;
        const double sp = r + r * r2 * (-1.0 / 6 + r2 * (1.0 / 120 + r2 * (-1.0 / 5040 + r2 * (1.0 / 362880 + r2 * (-1.0 / 39916800 + r2 * (1.0 / 6227020800.0))))));
        const double cp = 1.0 + r2 * (-0.5 + r2 * (1.0 / 24 + r2 * (-1.0 / 720 + r2 * (1.0 / 40320 + r2 * (-1.0 / 3628800 + r2 * (1.0 / 479001600.0 + r2 * (-1.0 / 87178291200.0)))))));
        const int qi = ((int)q) & 3;
        const double sv = qi == 0 ? sp : qi == 1 ? cp : qi == 2 ? -sp : -cp;
        const double cv = qi == 0 ? cp : qi == 1 ? -sp : qi == 2 ? -cp : sp;
        ropeC[idx] = (float)cv; ropeS[idx] = (float)sv;
    }
}

#ifndef PH
#define PH 0xFFFF
#endif
#define LAUNDER_S(p) asm volatile("" : "+s"(p))
typedef const __attribute__((address_space(4))) Args* KArgs;
__device__ __forceinline__ KArgs kargs() { KArgs p = (KArgs)__builtin_amdgcn_kernarg_segment_ptr(); LAUNDER_S(p); return p; }
constexpr float LAM_INIT0 = 0.2f, LAM_INIT1 = 0.35550906759096926f;

__global__ void __launch_bounds__(NWAVES * 64, 2) mega_fwd(Args args_unused) {
    extern __shared__ __attribute__((aligned(16))) unsigned char lds[];
    LAS unsigned char* L = (LAS unsigned char*)lds;
    volatile LAS unsigned* MISC = (volatile LAS unsigned*)(L + MISC_OFF);
    const int tid = threadIdx.x, lane = tid & 63, wave = __builtin_amdgcn_readfirstlane(tid >> 6);
    const int G = gridDim.x; const int bx = blockIdx.x; const int vcu = (G % 8 == 0) ? (bx % 8) * (G / 8) + bx / 8 : bx;
    const int gw = vcu * NWAVES + wave, NGW = G * NWAVES;
    for (int u = tid; u < (LDS_BYTES - LDSCTL_OFF) / 4; u += NWAVES * 64) ((LAS unsigned*)(L + LDSCTL_OFF))[u] = 0u;
    __syncthreads();
    XcdBarrier bar;
    { KArgs ap = kargs(); bar = xcd_barrier_post((unsigned*)(((unsigned char*)ap->ws) + WS_CTL) + CW_BAR, MISC + 8); }
#ifdef PROBE_BAR_REP
#define GRID_BAR() do { _Pragma("unroll 1") for (int rep_ = 0; rep_ < PROBE_BAR_REP; ++rep_) xcd_barrier(bar); } while (0)
#else
#define GRID_BAR() xcd_barrier(bar)
#endif
    LAS float* scr = (LAS float*)(L + RING_OFF + wave * 16384);

    {
        KArgs ap = kargs(); unsigned char* ws = ((unsigned char*)ap->ws);
#if PH & 1
        modv_phase(ap, (float*)(ws + WS_MODV), L, G, tid, wave, lane);
        rope_tables((float*)(ws + WS_ROPE), (float*)(ws + WS_ROPE) + 16384 * 32, bx * (NWAVES * 64) + tid, G * NWAVES * 64);
#endif
        if (bx == 0 && wave == 0) {
            float* lamv = (float*)(ws + WS_MISC);
#pragma unroll
            for (int l = 0; l < NLAYER; ++l) {
                const float s1 = wave_sum(((const float*)ap->in[12])[l * 64 + lane] * ((const float*)ap->in[13])[l * 64 + lane]), s2 = wave_sum(((const float*)ap->in[14])[l * 64 + lane] * ((const float*)ap->in[15])[l * 64 + lane]);
                if (lane == 0) lamv[l] = expf(s1) - expf(s2) + (l == 0 ? LAM_INIT0 : LAM_INIT1);
            }
        }
        __syncthreads();
#if PH & 2
#ifdef PROBE_CONV_REP
#pragma unroll 1
        for (int rep = 1; rep < PROBE_CONV_REP; ++rep) convert_layer(ap, 0, ws + WS_W, scr, gw, NGW, lane);
#endif
        convert_layer(ap, 0, ws + WS_W, scr, gw, NGW, lane);
#endif
    }
    GRID_BAR();
    {
        KArgs ap = kargs(); unsigned char* ws = ((unsigned char*)ap->ws);
#if PH & 4
        mod_rows(((const float*)ap->in[0]), ((const float*)ap->in[1]), (bf16*)(ws + WS_HA), (const float*)(ws + WS_MODV), 0, gw, NGW, lane);
#endif
    }
    GRID_BAR();

#pragma unroll 1
    for (int l = 0; l < NLAYER; ++l) {
        { KArgs ap = kargs(); unsigned char* ws = ((unsigned char*)ap->ws);
          pg8::Gemm g{(const bf16*)(ws + WS_HA), (const bf16*)(ws + WS_W + WO_GU1), M, NGU, DM}; pg8::StaticOrder S; { int g_ = G, c_ = bx; LAUNDER_S(g_); LAUNDER_S(c_); S.init(M, NGU, g_, c_); }
          pg8::EpiSwiGLU E{(bf16*)(ws + WS_BIG), DFF};
#if PH & 8
#ifdef PROBE_G1_REP
#pragma unroll 1
          for (int rep = 0; rep < PROBE_G1_REP; ++rep)
#endif
          pg8::gemm_phase<pg8::EpiSwiGLU, pg8::StaticOrder, true, true, false, true>(L + RING_OFF, g, S, E);
#endif
        }
        GRID_BAR();
        { KArgs ap = kargs(); unsigned char* ws = ((unsigned char*)ap->ws); float* out = ((float*)ap->out);
          const float* xsrc_p = l == 0 ? ((const float*)ap->in[0]) : out; const float* xsrc_s = l == 0 ? ((const float*)ap->in[1]) : out + (size_t)MP * DM;
          pg8::Gemm g{(const bf16*)(ws + WS_BIG), (const bf16*)(ws + WS_W + WO_D1), M, DM, DFF}; pg8::StaticOrderG<4> S; { int g_ = G, c_ = bx; LAUNDER_S(g_); LAUNDER_S(c_); S.init(M, DM, g_, c_); }
          pg8::EpiResid E{xsrc_p, xsrc_s, out, DM, (const float*)(ws + WS_MODV) + (size_t)l * NB * MODW + 2 * DM, 0.5f, DN_ALPHA};
#if PH & 16
#ifndef STAG_TICKS
#define STAG_TICKS 0
#endif
          if (STAG_TICKS) { const unsigned long long t0_ = __builtin_amdgcn_s_memrealtime(); const unsigned long long dly_ = (unsigned long long)(((bx >> 3) & 3) * 8 * STAG_TICKS + (bx & 7) * STAG_TICKS);
            while (__builtin_amdgcn_s_memrealtime() - t0_ < dly_) __builtin_amdgcn_s_sleep(8); }
#ifdef PROBE_G2_REP
#pragma unroll 1
          for (int rep = 0; rep < (l == 0 ? PROBE_G2_REP : 1); ++rep)
#endif
#ifdef PROBE_G2_NULL
          { pg8::EpiNull EN;
#pragma unroll 1
            for (int rep = 0; rep < PROBE_G2_NULL; ++rep) pg8::gemm_phase<pg8::EpiNull, pg8::StaticOrderG<4>, true, true, true, true>(L + RING_OFF, g, S, EN); }
#endif
#ifdef PROBE_G2_VAR
          { typedef pg8::EpiResidT<(PROBE_G2_VAR & 1) != 0, (PROBE_G2_VAR & 2) != 0> EV; EV E2{xsrc_p, xsrc_s, out, DM, (const float*)(ws + WS_MODV) + (size_t)l * NB * MODW + 2 * DM, 0.5f, DN_ALPHA};
            if (l == 0) pg8::gemm_phase<EV, pg8::StaticOrderG<4>, true, true, true, true>(L + RING_OFF, g, S, E2); }
#endif
          pg8::gemm_phase<pg8::EpiResid, pg8::StaticOrderG<4>, true, true, true, true>(L + RING_OFF, g, S, E);
#endif
        }
        GRID_BAR();
        { KArgs ap = kargs(); unsigned char* ws = ((unsigned char*)ap->ws);
#if PH & 4
          ln_rows(((float*)ap->out), (bf16*)(ws + WS_HB), ((const float*)ap->in[6]) + (size_t)l * 3 * DM, ((const float*)ap->in[7]) + (size_t)l * 3 * DM, (const float*)(ws + WS_MODV) + (size_t)l * NB * MODW, 3, gw, NGW, lane);
#ifdef PROBE_LN_REP
#pragma unroll 1
          for (int rep = 1; rep < PROBE_LN_REP; ++rep) ln_dummy(((float*)ap->out), (bf16*)(ws + WS_HB), (const float*)(ws + WS_MODV) + (size_t)l * NB * MODW, 3, gw, NGW, lane);
#endif
#endif
        }
        GRID_BAR();
        { KArgs ap = kargs(); unsigned char* ws = ((unsigned char*)ap->ws);
          pg8::Gemm g{(const bf16*)(ws + WS_HB), (const bf16*)(ws + WS_W + WO_IN), M, NIN, DM}; pg8::StaticOrder S; { int g_ = G, c_ = bx; LAUNDER_S(g_); LAUNDER_S(c_); S.init(M, NIN, g_, c_); }
          #ifdef USE_DIFF1
          pg8::EpiRope E{(bf16*)(ws + WS_BIG), NIN, (const float*)(ws + WS_ROPE), (const float*)(ws + WS_ROPE) + 16384 * 32, 1.0f};
#else
          pg8::EpiRope E{(bf16*)(ws + WS_BIG), NIN, (const float*)(ws + WS_ROPE), (const float*)(ws + WS_ROPE) + 16384 * 32, 0.125f * 1.4426950408889634f};
#endif
#if PH & 32
#ifdef PROBE_G3_REP
#pragma unroll 1
          for (int rep = 0; rep < PROBE_G3_REP; ++rep)
#endif
          pg8::gemm_phase<pg8::EpiRope, pg8::StaticOrder, true, true, false, true>(L + RING_OFF, g, S, E);
#endif
        }
        GRID_BAR();
        {
            KArgs ap = kargs(); unsigned char* ws = ((unsigned char*)ap->ws);
            const GAS bf16* BIG = (const GAS bf16*)(ap->ws + WS_BIG); GAS bf16* HA = (GAS bf16*)(ap->ws + WS_HA);
            const float lam = ((const float*)(ws + WS_MISC))[l]; const float gscale = 1.0f - (l == 0 ? LAM_INIT0 : LAM_INIT1);
            const GAS float* ng = ap->in[16] + l * 128; const GAS float* rpb = ap->in[17] + (size_t)l * 8 * 15 * 31;
            GAS float* stash = (GAS float*)(ap->ws + WS_HB) + (size_t)bx * 32768;
#ifndef PROBE_ATT_REP
#define PROBE_ATT_REP 1
#endif
#pragma unroll 1
            for (int rep = 0; rep < PROBE_ATT_REP; ++rep)
#pragma unroll 1
            for (int i = 0;; ++i) {
                const int u = i * G + vcu; if (u >= 4096) break;
#ifdef PROBE_NA_ONLY_REP
                if (rep > 0 && u < 2048) continue;
#endif
                if (u < 2048) {
                    long row0; int T, h, q0;
                    if (u < 1024) { const int bh = u >> 6, qt = u & 63; row0 = MP + (long)(bh >> 3) * 16384; T = 16384; h = bh & 7; q0 = qt * 256; }
                    else { const int v = u - 1024, bh = v >> 4, qt = v & 15; row0 = (long)(bh >> 3) * 4096; T = 4096; h = bh & 7; q0 = qt * 256; }
#if PH & 64
#ifdef USE_DIFF1
                    att::diff_unit(BIG, row0, T, h, q0, lam, gscale, ng, HA, stash, (char*)lds);
#else
                    att::diff_unit2<8>(BIG, row0, T, h, q0, lam, gscale, ng, HA, stash, (char*)lds);
#endif
#endif
                } else {
                    long row0; int rows, h, r0; int v = u - 2048;
                    if (v < 1024) { const int bh = v >> 4, rg = v & 15; row0 = (long)(bh >> 3) * 4096; rows = 64; h = bh & 7; r0 = rg * 4; }
                    else { v -= 1024; const int bh = v >> 6, rg = v & 63; row0 = MP + (long)(bh >> 3) * 16384; rows = 256; h = bh & 7; r0 = rg * 4; }
#if PH & 128
                    att::na_unit(BIG, row0, rows, h, r0, rpb + h * 15 * 31, HA, (char*)lds);
#endif
                }
            }
        }
        GRID_BAR();
        { KArgs ap = kargs(); unsigned char* ws = ((unsigned char*)ap->ws); float* out = ((float*)ap->out);
          pg8::Gemm g{(const bf16*)(ws + WS_HA), (const bf16*)(ws + WS_W + WO_OUT), M, DM, DM}; pg8::StaticOrderG<4> S; { int g_ = G, c_ = bx; LAUNDER_S(g_); LAUNDER_S(c_); S.init(M, DM, g_, c_); }
          pg8::EpiResid E{out, out + (size_t)MP * DM, out, DM, (const float*)(ws + WS_MODV) + (size_t)l * NB * MODW + 5 * DM, 1.0f, DN_ALPHA};
#if PH & 16
          if (STAG_TICKS) { const unsigned long long t0_ = __builtin_amdgcn_s_memrealtime(); const unsigned long long dly_ = (unsigned long long)(((bx >> 3) & 3) * 8 * STAG_TICKS + (bx & 7) * STAG_TICKS);
            while (__builtin_amdgcn_s_memrealtime() - t0_ < dly_) __builtin_amdgcn_s_sleep(8); }
          pg8::gemm_phase<pg8::EpiResid, pg8::StaticOrderG<4>, true, true, false, true>(L + RING_OFF, g, S, E);
#endif
        }
        GRID_BAR();
        { KArgs ap = kargs(); unsigned char* ws = ((unsigned char*)ap->ws);
#if PH & 4
          ln_rows(((float*)ap->out), (bf16*)(ws + WS_HB), ((const float*)ap->in[6]) + (size_t)l * 3 * DM + DM, ((const float*)ap->in[7]) + (size_t)l * 3 * DM + DM, (const float*)(ws + WS_MODV) + (size_t)l * NB * MODW, 6, gw, NGW, lane);
#endif
        }
        GRID_BAR();
        { KArgs ap = kargs(); unsigned char* ws = ((unsigned char*)ap->ws);
          pg8::Gemm g{(const bf16*)(ws + WS_HB), (const bf16*)(ws + WS_W + WO_GU2), M, NGU, DM}; pg8::StaticOrder S; { int g_ = G, c_ = bx; LAUNDER_S(g_); LAUNDER_S(c_); S.init(M, NGU, g_, c_); }
          pg8::EpiSwiGLU E{(bf16*)(ws + WS_BIG), DFF};
#if PH & 8
#ifdef PROBE_G1_REP
#pragma unroll 1
          for (int rep = 0; rep < PROBE_G1_REP; ++rep)
#endif
          pg8::gemm_phase<pg8::EpiSwiGLU, pg8::StaticOrder, true, true, false, true>(L + RING_OFF, g, S, E);
#endif
        }
        GRID_BAR();
        { KArgs ap = kargs(); unsigned char* ws = ((unsigned char*)ap->ws); float* out = ((float*)ap->out);
          pg8::Gemm g{(const bf16*)(ws + WS_BIG), (const bf16*)(ws + WS_W + WO_D2), M, DM, DFF}; pg8::StaticOrderG<4> S; { int g_ = G, c_ = bx; LAUNDER_S(g_); LAUNDER_S(c_); S.init(M, DM, g_, c_); }
          pg8::EpiResid E{out, out + (size_t)MP * DM, out, DM, (const float*)(ws + WS_MODV) + (size_t)l * NB * MODW + 8 * DM, 0.5f, DN_ALPHA};
#if PH & 16
          if (STAG_TICKS) { const unsigned long long t0_ = __builtin_amdgcn_s_memrealtime(); const unsigned long long dly_ = (unsigned long long)(((bx >> 3) & 3) * 8 * STAG_TICKS + (bx & 7) * STAG_TICKS);
            while (__builtin_amdgcn_s_memrealtime() - t0_ < dly_) __builtin_amdgcn_s_sleep(8); }
          pg8::gemm_phase<pg8::EpiResid, pg8::StaticOrderG<4>, true, true, true, true>(L + RING_OFF, g, S, E);
#endif
        }
        GRID_BAR();
        { KArgs ap = kargs(); unsigned char* ws = ((unsigned char*)ap->ws);
          const float* lng = ((const float*)ap->in[6]) + (size_t)l * 3 * DM + 2 * DM; const float* lnb = ((const float*)ap->in[7]) + (size_t)l * 3 * DM + 2 * DM;
          if (l + 1 < NLAYER) {
#if PH & 4
            ln_rows(((float*)ap->out), (bf16*)(ws + WS_HA), lng, lnb, (const float*)(ws + WS_MODV) + (size_t)(l + 1) * NB * MODW, 0, gw, NGW, lane);
#endif
#if PH & 2
            convert_layer(ap, l + 1, ws + WS_W, scr, gw, NGW, lane);
#endif
          } else {
#if PH & 4
            ln_rows(((float*)ap->out), nullptr, lng, lnb, (const float*)(ws + WS_MODV), 0, gw, NGW, lane);
#endif
          }
        }
        if (l + 1 < NLAYER) GRID_BAR();
    }
#undef GRID_BAR
}

extern "C" void kernel_launch(void* const* d_in, const int* in_sizes, int n_in, void* d_out, int out_size, void* d_ws, size_t ws_size, hipStream_t stream) {
    static int grid = 0;
    if (grid == 0) {
        if (n_in != 20 || out_size != M * DM || ws_size < WS_END) { fprintf(stderr, "kernel_launch: unexpected shapes: n_in %d out %d ws %zu (need %zu)\n", n_in, out_size, ws_size, (size_t)WS_END); grid = -1; return; }
        int dev = 0, cus = 0, per_cu = 0;
        if (hipGetDevice(&dev) != hipSuccess || hipDeviceGetAttribute(&cus, hipDeviceAttributeMultiprocessorCount, dev) != hipSuccess) { grid = -1; return; }
        if (hipFuncSetAttribute((const void*)mega_fwd, hipFuncAttributeMaxDynamicSharedMemorySize, LDS_BYTES) != hipSuccess) { fprintf(stderr, "kernel_launch: hipFuncSetAttribute failed\n"); grid = -1; return; }
        if (hipOccupancyMaxActiveBlocksPerMultiprocessor(&per_cu, (const void*)mega_fwd, NWAVES * 64, LDS_BYTES) != hipSuccess || per_cu < 1)
            fprintf(stderr, "kernel_launch: note: occupancy query reports %d workgroups per CU\n", per_cu);
        (void)hipGetLastError();
        grid = cus;
    }
    if (grid < 0) return;
    if (hipMemsetAsync((char*)d_ws + WS_CTL, 0, CTL_ZERO_BYTES, stream) != hipSuccess) return;
    Args a{};
    for (int i = 0; i < 20; ++i) a.in[i] = (const GAS float*)d_in[i];
    a.out = (GAS float*)d_out; a.ws = (GAS unsigned char*)d_ws;
    hipLaunchKernelGGL(mega_fwd, dim3(grid), dim3(NWAVES * 64), LDS_BYTES, stream, a);
    const hipError_t le = hipPeekAtLastError();
    if (le != hipSuccess) fprintf(stderr, "kernel_launch: launch failed: %s\n", hipGetErrorName(le));
}
```
